# Optimizing an MI355X kernel written in HIP

```python
import jax
import jax.numpy as jnp
from jax import lax
import numpy as np

D_MODEL = 1024
BATCH = 4
SEQ = 4096
DEPTH = 4

N_BRANCHES = 4
BRANCH_WIDTH = D_MODEL // 4
HEAD_DIM = 64
N_HEADS = BRANCH_WIDTH // HEAD_DIM
HGRN_CHUNK = 64
IDX_HEADS = 8
IDX_DIM = 32
TOPK_MAX = 256
Q_BLOCK = 128
ROPE_THETA = 10000.0
RWKV_W_LORA = 32
RWKV_A_LORA = 32
RWKV_V_LORA = 32
RWKV_G_LORA = 64
RWKV_COLS = 3 * BRANCH_WIDTH + RWKV_W_LORA + RWKV_A_LORA + RWKV_G_LORA
D_FF = 4 * D_MODEL
NORM_EPS = 1e-6
RWKV_GN_EPS = 64e-5
MASK_VALUE = -1e30
COL_SIZES = (
    BRANCH_WIDTH, BRANCH_WIDTH, BRANCH_WIDTH, BRANCH_WIDTH,
    BRANCH_WIDTH, BRANCH_WIDTH, BRANCH_WIDTH,
    IDX_HEADS * IDX_DIM, IDX_DIM, IDX_HEADS,
    RWKV_COLS,
    BRANCH_WIDTH, BRANCH_WIDTH, BRANCH_WIDTH, N_HEADS,
    N_BRANCHES * D_MODEL,
)
IN_COLS = sum(COL_SIZES)

kernel_name = 'hybrid_gated_hgrn2_dsa_rwkv7_fox'

F32 = jnp.float32


def rms_norm(t, g, eps=NORM_EPS):
    tf = t.astype(F32)
    y = tf * lax.rsqrt(jnp.mean(tf * tf, axis=-1, keepdims=True) + eps)
    return (y * g.astype(F32)).astype(t.dtype)


def split_cols(t, sizes):
    out, off = [], 0
    for s in sizes:
        out.append(t[..., off:off + s])
        off += s
    return out


def rope_tables(seq_len, dim):
    inv = 1.0 / (ROPE_THETA ** (jnp.arange(0, dim, 2, dtype=F32) / dim))
    ang = jnp.arange(seq_len, dtype=F32)[:, None] * inv[None, :]
    return jnp.cos(ang), jnp.sin(ang)


def apply_rope(t, cos, sin):
    half = t.shape[-1] // 2
    tf = t.astype(F32)
    t1, t2 = tf[..., :half], tf[..., half:]
    c, s = cos[None, :, None, :], sin[None, :, None, :]
    return jnp.concatenate([t1 * c - t2 * s, t2 * c + t1 * s], axis=-1).astype(t.dtype)


def hgrn2_mixer(q, f_logit, i_in, g_out, lb, norm_w):
    dt = q.dtype
    B_, T, _ = q.shape
    H, d, C = N_HEADS, HEAD_DIM, HGRN_CHUNK
    nc = T // C
    fl = f_logit.astype(F32)
    f = lb + (1.0 - lb) * jax.nn.sigmoid(fl)
    logf = jnp.log(f)
    k = (1.0 - lb) * jax.nn.sigmoid(-fl)

    def to_chunks(t):
        return t.astype(F32).reshape(B_, nc, C, H, d).transpose(1, 0, 3, 2, 4)

    qc = to_chunks(q) * (d ** -0.5)
    kc, vc, gc = to_chunks(k), to_chunks(i_in), to_chunks(logf)
    causal = jnp.tril(jnp.ones((C, C), dtype=bool))[:, :, None]

    def step(S, inp):
        qb, kb, vb, gb = inp
        b = jnp.cumsum(gb, axis=2)
        diff = b[:, :, :, None, :] - b[:, :, None, :, :]
        decay = jnp.where(causal, jnp.exp(jnp.where(causal, diff, 0.0)), 0.0)
        attn = jnp.einsum('bhtd,bhtsd,bhsd->bhts', qb, decay, kb)
        o = jnp.einsum('bhts,bhsv->bhtv', attn, vb) + jnp.einsum('bhtd,bhdv->bhtv', qb * jnp.exp(b), S)
        b_last = b[:, :, -1:, :]
        S = S * jnp.exp(b_last[:, :, 0, :, None]) + jnp.einsum('bhsd,bhsv->bhdv', kb * jnp.exp(b_last - b), vb)
        return S, o

    S0 = jnp.zeros((B_, H, d, d), F32)
    _, o = lax.scan(step, S0, (qc, kc, vc, gc))
    o = o.transpose(1, 0, 3, 2, 4).reshape(B_, T, H, d)
    o = o * lax.rsqrt(jnp.mean(o * o, axis=-1, keepdims=True) + NORM_EPS) * norm_w.astype(F32)
    gate = jax.nn.silu(g_out.astype(F32)).reshape(B_, T, H, d)
    return (o * gate).reshape(B_, T, H * d).astype(dt)


def dsa_mixer(q, k, v, q_idx, k_idx, w_idx, cos_h, sin_h, cos_i, sin_i):
    dt = q.dtype
    B_, T, _ = q.shape
    H, d = N_HEADS, HEAD_DIM
    qh = apply_rope(q.reshape(B_, T, H, d), cos_h, sin_h)
    kh = apply_rope(k.reshape(B_, T, H, d), cos_h, sin_h)
    vh = v.reshape(B_, T, H, d)
    qi = apply_rope(q_idx.reshape(B_, T, IDX_HEADS, IDX_DIM), cos_i, sin_i).astype(F32) * (IDX_DIM ** -0.5)
    ki = apply_rope(k_idx[:, :, None, :], cos_i, sin_i)[:, :, 0, :].astype(F32)
    wi = w_idx.astype(F32) * (IDX_HEADS ** -0.5)
    topk = min(TOPK_MAX, T // 4)
    key_pos = jnp.arange(T)

    def block(bi):
        start = bi * Q_BLOCK
        q_pos = start + jnp.arange(Q_BLOCK)
        qib = lax.dynamic_slice_in_dim(qi, start, Q_BLOCK, axis=1)
        wib = lax.dynamic_slice_in_dim(wi, start, Q_BLOCK, axis=1)
        qb = lax.dynamic_slice_in_dim(qh, start, Q_BLOCK, axis=1)
        score = jnp.einsum('bqhd,bsd->bqhs', qib, ki)
        score = jnp.einsum('bqhs,bqh->bqs', jax.nn.relu(score), wib)
        score = jnp.where((key_pos[None, :] <= q_pos[:, None])[None], score, MASK_VALUE)
        _, idx = lax.top_k(score, topk)
        valid = idx <= q_pos[None, :, None]
        k_sel = jax.vmap(lambda kk_, ii: kk_[ii])(kh, idx)
        v_sel = jax.vmap(lambda vv_, ii: vv_[ii])(vh, idx)
        logits = jnp.einsum('bqhd,bqkhd->bqhk', qb, k_sel).astype(F32) * (d ** -0.5)
        logits = jnp.where(valid[:, :, None, :], logits, MASK_VALUE)
        p = jax.nn.softmax(logits, axis=-1)
        return jnp.einsum('bqhk,bqkhd->bqhd', p.astype(v_sel.dtype), v_sel)

    out = lax.map(block, jnp.arange(T // Q_BLOCK))
    return out.transpose(1, 0, 2, 3, 4).reshape(B_, T, H * d).astype(dt)


def rwkv7_mixer(pc, mu, w0, w2, a0, a2, g2, k_k, k_a, r_k, ln_w, ln_b, v_first, v_gate):
    dt = pc.dtype
    B_, T, _ = pc.shape
    H, N = N_HEADS, HEAD_DIM
    p = pc.astype(F32)
    prev = jnp.pad(p, ((0, 0), (1, 0), (0, 0)))[:, :T]
    xm = p + (prev - p) * mu.astype(F32)
    r, k, v, w_in, a_in, g_in = split_cols(
        xm, (BRANCH_WIDTH, BRANCH_WIDTH, BRANCH_WIDTH, RWKV_W_LORA, RWKV_A_LORA, RWKV_G_LORA))
    w_log = -jax.nn.softplus(-(w0 + jnp.tanh(w_in) @ w2.astype(F32))) - 0.5
    decay = jnp.exp(-jnp.exp(w_log))
    a = jax.nn.sigmoid(a0 + a_in @ a2.astype(F32))
    g = jax.nn.sigmoid(g_in) @ g2.astype(F32)
    if v_gate is not None:
        v0, v1, v2 = v_gate
        v = v + (v_first - v) * jax.nn.sigmoid(v0 + (v @ v1.astype(F32)) @ v2.astype(F32))

    def heads(t):
        return t.reshape(B_, T, H, N)

    kk = heads(k * k_k)
    kk = kk * lax.rsqrt(jnp.maximum(jnp.sum(kk * kk, axis=-1, keepdims=True), 1e-24))
    k = k * (1.0 + (a - 1.0) * k_a)
    rh, wh, kh, vh, ah = heads(r), heads(decay), heads(k), heads(v), heads(a)
    xs = tuple(t.transpose(1, 0, 2, 3) for t in (rh, wh, kh, vh, kk, ah))

    def step(S, inp):
        rt, wt, kt, vt, kkt, at = inp
        sa = jnp.einsum('bhvi,bhi->bhv', S, -kkt)
        S = S * wt[:, :, None, :] + sa[..., None] * (kkt * at)[:, :, None, :] + vt[..., None] * kt[:, :, None, :]
        return S, jnp.einsum('bhvj,bhj->bhv', S, rt)

    S0 = jnp.zeros((B_, H, N, N), F32)
    _, y = lax.scan(step, S0, xs)
    y = y.transpose(1, 0, 2, 3)
    mean = jnp.mean(y, axis=-1, keepdims=True)
    var = jnp.mean(jnp.square(y - mean), axis=-1, keepdims=True)
    y = (y - mean) * lax.rsqrt(var + RWKV_GN_EPS) * ln_w.reshape(H, N) + ln_b.reshape(H, N)
    y = y + jnp.sum(rh * kh * r_k, axis=-1, keepdims=True) * vh
    return (y.reshape(B_, T, H * N) * g).astype(dt), v


def fox_mixer(q, k, v, f_logit, f_bias):
    dt = q.dtype
    B_, T, _ = q.shape
    H, d = N_HEADS, HEAD_DIM
    qh, kh, vh = q.reshape(B_, T, H, d), k.reshape(B_, T, H, d), v.reshape(B_, T, H, d)
    logf = jax.nn.log_sigmoid(f_logit.astype(F32) + f_bias.astype(F32))
    c = jnp.cumsum(logf, axis=1).transpose(0, 2, 1)
    key_pos = jnp.arange(T)

    def block(bi):
        start = bi * Q_BLOCK
        q_pos = start + jnp.arange(Q_BLOCK)
        qb = lax.dynamic_slice_in_dim(qh, start, Q_BLOCK, axis=1)
        cb = lax.dynamic_slice_in_dim(c, start, Q_BLOCK, axis=2)
        logits = jnp.einsum('bqhd,bshd->bhqs', qb, kh).astype(F32) * (d ** -0.5)
        logits = logits + cb[..., None] - c[:, :, None, :]
        logits = jnp.where(key_pos[None, :] <= q_pos[:, None], logits, MASK_VALUE)
        p = jax.nn.softmax(logits, axis=-1)
        return jnp.einsum('bhqs,bshd->bqhd', p.astype(vh.dtype), vh)

    out = lax.map(block, jnp.arange(T // Q_BLOCK))
    return out.transpose(1, 0, 2, 3, 4).reshape(B_, T, H * d).astype(dt)


def setup_inputs(seed: int = 0) -> dict:
    key = jax.random.key(seed)
    ks = jax.random.split(key, 32)
    W = BRANCH_WIDTH

    def nrm(k, shape, scale):
        return scale * jax.random.normal(k, shape, F32)

    def gain(k, n):
        return 1.0 + nrm(k, (DEPTH, n), 0.02)

    return {
        'x': nrm(ks[0], (BATCH, SEQ, D_MODEL), 1.0),
        'norm_mix_pre': gain(ks[1], D_MODEL),
        'norm_mix_post': gain(ks[2], D_MODEL),
        'norm_mlp_pre': gain(ks[3], D_MODEL),
        'norm_mlp_post': gain(ks[4], D_MODEL),
        'w_in': nrm(ks[5], (DEPTH, D_MODEL, IN_COLS), D_MODEL ** -0.5),
        'w_branch': nrm(ks[6], (DEPTH, N_BRANCHES, W, D_MODEL), W ** -0.5),
        'w_out': nrm(ks[7], (DEPTH, D_MODEL, D_MODEL), D_MODEL ** -0.5),
        'hgrn_lb_logits': nrm(ks[8], (DEPTH, W), 1.0),
        'hgrn_norm_w': gain(ks[9], HEAD_DIM),
        'fox_f_bias': 2.0 + nrm(ks[10], (DEPTH, N_HEADS), 0.5),
        'rwkv_mu': jax.random.uniform(ks[11], (DEPTH, RWKV_COLS), F32),
        'rwkv_w0': -3.0 + nrm(ks[12], (DEPTH, W), 1.0),
        'rwkv_w2': nrm(ks[13], (DEPTH, RWKV_W_LORA, W), 0.5 * RWKV_W_LORA ** -0.5),
        'rwkv_a0': nrm(ks[14], (DEPTH, W), 0.5),
        'rwkv_a2': nrm(ks[15], (DEPTH, RWKV_A_LORA, W), RWKV_A_LORA ** -0.5),
        'rwkv_g2': nrm(ks[16], (DEPTH, RWKV_G_LORA, W), RWKV_G_LORA ** -0.5),
        'rwkv_k_k': 0.85 + nrm(ks[17], (DEPTH, W), 0.05),
        'rwkv_k_a': 1.0 + nrm(ks[18], (DEPTH, W), 0.05),
        'rwkv_r_k': nrm(ks[19], (DEPTH, N_HEADS, HEAD_DIM), 0.1),
        'rwkv_ln_w': gain(ks[20], W),
        'rwkv_ln_b': nrm(ks[21], (DEPTH, W), 0.02),
        'rwkv_v0': nrm(ks[22], (DEPTH - 1, W), 0.5),
        'rwkv_v1': nrm(ks[23], (DEPTH - 1, W, RWKV_V_LORA), W ** -0.5),
        'rwkv_v2': nrm(ks[24], (DEPTH - 1, RWKV_V_LORA, W), RWKV_V_LORA ** -0.5),
        'w_up': nrm(ks[25], (DEPTH, D_MODEL, D_FF), D_MODEL ** -0.5),
        'w_down': nrm(ks[26], (DEPTH, D_FF, D_MODEL), D_FF ** -0.5),
    }


def reference(x, norm_mix_pre, norm_mix_post, norm_mlp_pre, norm_mlp_post, w_in, w_branch, w_out,
              hgrn_lb_logits, hgrn_norm_w, fox_f_bias, rwkv_mu, rwkv_w0, rwkv_w2, rwkv_a0, rwkv_a2,
              rwkv_g2, rwkv_k_k, rwkv_k_a, rwkv_r_k, rwkv_ln_w, rwkv_ln_b, rwkv_v0, rwkv_v1, rwkv_v2,
              w_up, w_down):
    B_, T, _ = x.shape
    cos_h, sin_h = rope_tables(T, HEAD_DIM)
    cos_i, sin_i = rope_tables(T, IDX_DIM)
    lb_soft = jax.nn.softmax(hgrn_lb_logits.astype(F32), axis=0)
    lower_bounds = jnp.cumsum(lb_soft, axis=0) - lb_soft[0:1]
    v_first = None
    for l in range(DEPTH):
        h = rms_norm(x, norm_mix_pre[l])
        proj = h @ w_in[l]
        (a_q, a_f, a_i, a_g, b_q, b_k, b_v, b_iq, b_ik, b_iw, c_all,
         d_q, d_k, d_v, d_f, gate_logits) = split_cols(proj, COL_SIZES)
        y_a = hgrn2_mixer(a_q, a_f, a_i, a_g, lower_bounds[l], hgrn_norm_w[l])
        y_b = dsa_mixer(b_q, b_k, b_v, b_iq, b_ik, b_iw, cos_h, sin_h, cos_i, sin_i)
        v_gate = None if l == 0 else (rwkv_v0[l - 1], rwkv_v1[l - 1], rwkv_v2[l - 1])
        y_c, v_c = rwkv7_mixer(c_all, rwkv_mu[l], rwkv_w0[l], rwkv_w2[l], rwkv_a0[l], rwkv_a2[l], rwkv_g2[l],
                               rwkv_k_k[l], rwkv_k_a[l], rwkv_r_k[l], rwkv_ln_w[l], rwkv_ln_b[l],
                               v_first, v_gate)
        if l == 0:
            v_first = v_c
        y_d = fox_mixer(d_q, d_k, d_v, d_f, fox_f_bias[l])
        gates = jax.nn.sigmoid(gate_logits.astype(F32)).reshape(B_, T, N_BRANCHES, D_MODEL)
        merged = (gates[:, :, 0] * (y_a @ w_branch[l, 0]).astype(F32)
                  + gates[:, :, 1] * (y_b @ w_branch[l, 1]).astype(F32)
                  + gates[:, :, 2] * (y_c @ w_branch[l, 2]).astype(F32)
                  + gates[:, :, 3] * (y_d @ w_branch[l, 3]).astype(F32))
        mix = merged.astype(x.dtype) @ w_out[l]
        x = x + rms_norm(mix, norm_mix_post[l])
        hm = rms_norm(x, norm_mlp_pre[l])
        u = jax.nn.relu(hm @ w_up[l])
        x = x + rms_norm(jnp.square(u) @ w_down[l], norm_mlp_post[l])
    return x
```

```cpp
#include <hip/hip_runtime.h>
#include <cstdio>
#include <cstdint>
namespace pg8 {
#define PG8_LAS __attribute__((address_space(3)))
typedef unsigned short bf16_t;
typedef short bf16x8 __attribute__((ext_vector_type(8)));
typedef float f32x4 __attribute__((ext_vector_type(4)));
typedef unsigned u32x4 __attribute__((ext_vector_type(4)));
constexpr int BM = 256, BK = 64, HALF = 128, HTB = HALF * BK * 2  , STAGE_BYTES = 8 * HTB, NXCD = 8, WGM = 8;

__host__ __device__ __forceinline__ int lds_byte(int r, int c) { const int st = (r >> 4) * 2 + (c >> 5), rr = r & 15, cc = c & 31, ob = rr * 64 + cc * 2; return st * 1024 + (ob ^ (((ob >> 9) & 1) << 5)); }
__host__ __device__ __forceinline__ void stage_rc(int b, int& R, int& C) { const int st = b / 1024, sb = b % 1024, swz = sb ^ (((sb >> 9) & 1) << 5); R = (st >> 1) * 16 + swz / 64; C = (st & 1) * 32 + (swz % 64) / 2; }
__host__ __device__ __forceinline__ int perm32(int rho) { const int n = rho >> 4, i = rho & 15; return 8 * (i >> 2) + 4 * n + (i & 3); }

struct Unit { int pm, pn; };
struct Gemm { const bf16_t* A; const bf16_t* Bt; int M, N, K; int lda, ldb; int agrp, astep; };

struct StaticOrder {
    int nM, nN, nwg, G, c;
    __host__ __device__ void init(int M, int N, int G_, int c_) { nM = M / BM; nN = N / BM; nwg = nM * nN; G = G_; c = c_; }
    __host__ __device__ bool next(int i, Unit& u) const {
        const long L = (long)i * G + c; if (L >= nwg) return false;
        int wgid = (int)L; { const int q = nwg / NXCD, r = nwg % NXCD, xcd = wgid % NXCD, off = wgid / NXCD; wgid = (xcd < r ? xcd * (q + 1) : r * (q + 1) + (xcd - r) * q) + off; }
        const int nig = WGM * nN, gid = wgid / nig, fm = gid * WGM, gsz = (nM - fm) < WGM ? (nM - fm) : WGM;
        u.pm = fm + ((wgid % nig) % gsz); u.pn = (wgid % nig) / gsz; return true;
    }
    __device__ __forceinline__ void a_ready(const Unit&) const {}
    __device__ __forceinline__ void done(const Unit&) const {}
};

typedef float cvt_f32x2_t __attribute__((ext_vector_type(2))); typedef __bf16 cvt_bf16x2_t __attribute__((ext_vector_type(2)));
__device__ __forceinline__ unsigned cvt_pk_bf16(float lo, float hi) { cvt_f32x2_t v = {lo, hi}; cvt_bf16x2_t b = __builtin_convertvector(v, cvt_bf16x2_t); return __builtin_bit_cast(unsigned, b); }
typedef float f32x2 __attribute__((ext_vector_type(2)));
__device__ __forceinline__ f32x2 gelu_pk(f32x2 v) {
    const f32x2 av = __builtin_elementwise_abs(v), d = av * 0.2316418882f + 1.0f;
    f32x2 t; t.x = __builtin_amdgcn_rcpf(d.x); t.y = __builtin_amdgcn_rcpf(d.y);
    f32x2 q = t * 0.5307027145f + (-0.7265760135f); q = q * t + 0.7107068705f; q = q * t + (-0.142248368f); q = q * t + 0.127414796f; q = q * t;
    const f32x2 s = (v * v) * (-0.72134752044f);
    f32x2 e; e.x = __builtin_amdgcn_exp2f(s.x); e.y = __builtin_amdgcn_exp2f(s.y);
    const f32x2 m = v * (q * e), r = v - m;
    f32x2 o; o.x = v.x < 0.f ? m.x : r.x; o.y = v.y < 0.f ? m.y : r.y; return o;
}

template <int ACT  > struct EpiBf16 {
    static constexpr bool PERM = true, AFTER_DRAIN = false; static_assert(ACT == 0 || ACT == 1, "EpiBf16: ACT is 0 (none) or 1 (gelu_pk)");
    bf16_t* O; int ldc; const float* bias; int split_cols; size_t split_stride; float scale0;
    __device__ __forceinline__ void operator()(const f32x4 (&acc)[2][2][4][2], const Unit& u, int wr, int wc, int fr, int fq) const {
        const int row0 = u.pm * BM + wr * 64 + fr; int colt = u.pn * BM; bf16_t* base = O;
        float sc = 1.f; if (split_cols) { const int t = colt / split_cols; base += (size_t)t * split_stride; colt -= t * split_cols; if (t == 0) sc = scale0; }
        const int col0 = colt + wc * 32 + 8 * fq, bcol0 = u.pn * BM + wc * 32 + 8 * fq;
        f32x4 bv[2][2];
#pragma unroll
        for (int bj = 0; bj < 2; ++bj)
#pragma unroll
            for (int n = 0; n < 2; ++n) bv[bj][n] = bias ? *(const f32x4*)(bias + bcol0 + bj * HALF + 4 * n) : (f32x4){0.f, 0.f, 0.f, 0.f};
#pragma unroll
        for (int ai = 0; ai < 2; ++ai)
#pragma unroll
            for (int m = 0; m < 4; ++m) { bf16_t* rowp = base + (size_t)(row0 + ai * HALF + m * 16) * ldc + col0;
#pragma unroll
                for (int bj = 0; bj < 2; ++bj) { f32x4 v0 = acc[ai][bj][m][0] + bv[bj][0], v1 = acc[ai][bj][m][1] + bv[bj][1];
                    if (ACT == 1) { f32x2 a = gelu_pk((f32x2){v0[0], v0[1]}), b = gelu_pk((f32x2){v0[2], v0[3]}), c = gelu_pk((f32x2){v1[0], v1[1]}), d = gelu_pk((f32x2){v1[2], v1[3]});
                        v0 = (f32x4){a.x, a.y, b.x, b.y}; v1 = (f32x4){c.x, c.y, d.x, d.y}; }
                    v0 = v0 * sc; v1 = v1 * sc; u32x4 w; w.x = cvt_pk_bf16(v0[0], v0[1]); w.y = cvt_pk_bf16(v0[2], v0[3]); w.z = cvt_pk_bf16(v1[0], v1[1]); w.w = cvt_pk_bf16(v1[2], v1[3]);
                    *(u32x4*)(rowp + bj * HALF) = w; } }
    }
};

template <class Epi, class Sched, bool ALIGN_EPI = false, bool SP2 = false>
__device__ __forceinline__ void gemm_phase(PG8_LAS unsigned char* lds, const Gemm g, const Sched& S, const Epi& E, const int tid) {
    const int wid = __builtin_amdgcn_readfirstlane(tid >> 6), lane = tid & 63, wr = wid >> 2, wc = wid & 3, fr = lane & 15, fq = lane >> 4;
    const int K = g.K, nt = K / BK;
    unsigned voffA[2], voffB[2];
#pragma unroll
    for (int i = 0; i < 2; ++i) { int R, C; stage_rc(tid * 16 + i * 8192, R, C); const int Rb = Epi::PERM ? ((R & ~31) + perm32(R & 31)) : R;
        voffA[i] = (unsigned)(R * g.lda + C) * 2u; voffB[i] = (unsigned)(Rb * g.ldb + C) * 2u; }
    const size_t kstep = (size_t)(BK * 2);
    const size_t hstepA = (size_t)HALF * g.lda * 2, hstepB = (size_t)HALF * g.ldb * 2;
    const size_t tstepA = 2 * hstepA, tstepB = 2 * hstepB;
    const unsigned ldsw = (unsigned)wid * 1024u;
    const int aoff = lds_byte(wr * 64 + fr, fq * 8), boff = lds_byte(wc * 32 + fr, fq * 8);
#define PG8_SA(b, h) (((b) * 2 + (h)) * HTB)
#define PG8_SB(b, h) ((4 + (b) * 2 + (h)) * HTB)
#define PG8_STAGE(bufoff, gbase, voff) do { _Pragma("unroll") for (int _i = 0; _i < 2; ++_i) \
        __builtin_amdgcn_global_load_lds((const unsigned*)((const char*)(gbase) + (voff)[_i]), (PG8_LAS unsigned*)(lds + (bufoff) + ldsw + _i * 8192), 16, 0, 0); } while (0)
#define PG8_LDA(dst, b, h) do { _Pragma("unroll") for (int m = 0; m < 4; ++m) _Pragma("unroll") for (int k = 0; k < 2; ++k) dst[m][k] = *(const PG8_LAS bf16x8*)(lds + PG8_SA(b, h) + aoff + m * 2048 + k * 1024); } while (0)
#define PG8_LDB(dst, b, h) do { _Pragma("unroll") for (int n = 0; n < 2; ++n) _Pragma("unroll") for (int k = 0; k < 2; ++k) dst[n][k] = *(const PG8_LAS bf16x8*)(lds + PG8_SB(b, h) + boff + n * 2048 + k * 1024); } while (0)
#define PG8_MMA(ai, bj, At, Bt) do { __builtin_amdgcn_s_setprio(1); _Pragma("unroll") for (int m = 0; m < 4; ++m) _Pragma("unroll") for (int n = 0; n < 2; ++n) _Pragma("unroll") for (int k = 0; k < 2; ++k) \
        acc[ai][bj][m][n] = __builtin_amdgcn_mfma_f32_16x16x32_bf16(Bt[n][k], At[m][k], acc[ai][bj][m][n], 0, 0, 0); __builtin_amdgcn_s_setprio(0); } while (0)
#define PG8_WAIT_V(n) asm volatile("s_waitcnt vmcnt(" #n ")" ::: "memory")
#define PG8_WAIT_L(n) asm volatile("s_waitcnt lgkmcnt(" #n ")" ::: "memory")
#define PG8_BAR __builtin_amdgcn_s_barrier()
#define PG8_SCHED __builtin_amdgcn_sched_barrier(0)
    Unit cur, nxt; int ui = 0;
    if (!S.next(0, cur)) return;
    f32x4 acc[2][2][4][2];
#pragma unroll
    for (int a = 0; a < 2; ++a)
#pragma unroll
        for (int b = 0; b < 2; ++b)
#pragma unroll
            for (int m = 0; m < 4; ++m)
#pragma unroll
                for (int n = 0; n < 2; ++n) acc[a][b][m][n] = (f32x4){0.f, 0.f, 0.f, 0.f};
    bf16x8 At[4][2], B0[2][2], B1[2][2];
    const char* cA = (const char*)g.A + (size_t)cur.pm * tstepA + (g.agrp ? (size_t)(cur.pn / g.agrp) * g.astep : (size_t)0); const char* cB = (const char*)g.Bt + (size_t)cur.pn * tstepB;
    S.a_ready(cur);
    if constexpr (SP2) {
        PG8_STAGE(PG8_SB(0, 0), cB, voffB); PG8_STAGE(PG8_SB(0, 1), cB + hstepB, voffB); PG8_STAGE(PG8_SA(0, 0), cA, voffA); PG8_STAGE(PG8_SA(0, 1), cA + hstepA, voffA);
        if (wr == 1) PG8_BAR;
        PG8_WAIT_V(2); PG8_BAR;
        PG8_STAGE(PG8_SB(1, 0), cB + kstep, voffB); PG8_STAGE(PG8_SA(1, 0), cA + kstep, voffA); PG8_STAGE(PG8_SB(1, 1), cB + hstepB + kstep, voffB);
        PG8_WAIT_V(6); PG8_BAR;
    } else {
        PG8_STAGE(PG8_SB(0, 0), cB, voffB); PG8_STAGE(PG8_SA(0, 0), cA, voffA); PG8_STAGE(PG8_SB(0, 1), cB + hstepB, voffB); PG8_STAGE(PG8_SA(0, 1), cA + hstepA, voffA);
        if (wr == 1) PG8_BAR;
        PG8_WAIT_V(4); PG8_BAR;
        PG8_STAGE(PG8_SB(1, 0), cB + kstep, voffB); PG8_STAGE(PG8_SA(1, 0), cA + kstep, voffA); PG8_STAGE(PG8_SB(1, 1), cB + hstepB + kstep, voffB);
        PG8_WAIT_V(6); PG8_BAR;
    }
    for (;;) {
        const bool has_next = S.next(ui + 1, nxt);
        const char* nA = has_next ? (const char*)g.A + (size_t)nxt.pm * tstepA + (g.agrp ? (size_t)(nxt.pn / g.agrp) * g.astep : (size_t)0) : cA; const char* nB = has_next ? (const char*)g.Bt + (size_t)nxt.pn * tstepB : cB;
        for (int t = 0; t < nt; t += 2) {
            const bool last = (t == nt - 2);
            const char* a1 = cA + (size_t)(t + 1) * kstep;
            const char* a2 = last ? nA : cA + (size_t)(t + 2) * kstep; const char* b2 = last ? nB : cB + (size_t)(t + 2) * kstep;
            const char* a3 = a2 + kstep; const char* b3 = b2 + kstep;
            if (last && has_next) S.a_ready(nxt);
            if constexpr (SP2) {
            PG8_LDB(B0, 0, 0); PG8_LDB(B1, 0, 1); PG8_SCHED; PG8_LDA(At, 0, 0); PG8_STAGE(PG8_SA(1, 1), a1 + hstepA, voffA);
            PG8_WAIT_V(8); PG8_WAIT_L(0); PG8_BAR; PG8_MMA(0, 0, At, B0); PG8_MMA(0, 1, At, B1); PG8_BAR; PG8_SCHED;
            PG8_LDA(At, 0, 1); PG8_STAGE(PG8_SB(0, 0), b2, voffB); PG8_STAGE(PG8_SB(0, 1), b2 + hstepB, voffB); PG8_STAGE(PG8_SA(0, 0), a2, voffA);
            PG8_WAIT_V(8); PG8_WAIT_L(0); PG8_BAR; PG8_MMA(1, 0, At, B0); PG8_MMA(1, 1, At, B1); PG8_BAR; PG8_SCHED;
            PG8_LDB(B0, 1, 0); PG8_LDB(B1, 1, 1); PG8_SCHED; PG8_LDA(At, 1, 0); PG8_STAGE(PG8_SA(0, 1), a2 + hstepA, voffA);
            PG8_WAIT_V(8); PG8_WAIT_L(0); PG8_BAR; PG8_MMA(0, 0, At, B0); PG8_MMA(0, 1, At, B1); PG8_BAR; PG8_SCHED;
            PG8_LDA(At, 1, 1); PG8_STAGE(PG8_SB(1, 0), b3, voffB); PG8_STAGE(PG8_SB(1, 1), b3 + hstepB, voffB); PG8_STAGE(PG8_SA(1, 0), a3, voffA);
            PG8_WAIT_V(8); PG8_WAIT_L(0); PG8_BAR; PG8_MMA(1, 0, At, B0); PG8_MMA(1, 1, At, B1); PG8_BAR; PG8_SCHED;
            } else {
            PG8_LDB(B0, 0, 0); PG8_SCHED; PG8_LDA(At, 0, 0); PG8_STAGE(PG8_SA(1, 1), a1 + hstepA, voffA);
            PG8_WAIT_L(8); PG8_BAR; PG8_WAIT_L(0); PG8_MMA(0, 0, At, B0); PG8_BAR; PG8_SCHED;
            PG8_LDB(B1, 0, 1); PG8_STAGE(PG8_SB(0, 0), b2, voffB);
            PG8_BAR; PG8_WAIT_L(0); PG8_MMA(0, 1, At, B1); PG8_BAR;
            PG8_LDA(At, 0, 1); PG8_STAGE(PG8_SA(0, 0), a2, voffA);
            PG8_BAR; PG8_WAIT_L(0); PG8_MMA(1, 0, At, B0); PG8_BAR; PG8_SCHED;
            PG8_STAGE(PG8_SB(0, 1), b2 + hstepB, voffB);
            PG8_WAIT_V(6); PG8_BAR; PG8_MMA(1, 1, At, B1); PG8_BAR;
            PG8_LDB(B0, 1, 0); PG8_SCHED; PG8_LDA(At, 1, 0); PG8_STAGE(PG8_SA(0, 1), a2 + hstepA, voffA);
            PG8_WAIT_L(8); PG8_BAR; PG8_WAIT_L(0); PG8_MMA(0, 0, At, B0); PG8_BAR; PG8_SCHED;
            PG8_LDB(B1, 1, 1); PG8_STAGE(PG8_SB(1, 0), b3, voffB);
            PG8_BAR; PG8_WAIT_L(0); PG8_MMA(0, 1, At, B1); PG8_BAR;
            PG8_LDA(At, 1, 1); PG8_STAGE(PG8_SA(1, 0), a3, voffA);
            PG8_BAR; PG8_WAIT_L(0); PG8_MMA(1, 0, At, B0); PG8_BAR; PG8_SCHED;
            PG8_STAGE(PG8_SB(1, 1), b3 + hstepB, voffB);
            PG8_WAIT_V(6); PG8_BAR; PG8_MMA(1, 1, At, B1); PG8_BAR;
            }
        }
        if constexpr (ALIGN_EPI) { if (wr == 0) PG8_BAR; }
        if constexpr (!Epi::AFTER_DRAIN) { E(acc, cur, wr, wc, fr, fq); S.done(cur); }
        if (!has_next) break;
#pragma unroll
        for (int a = 0; a < 2; ++a)
#pragma unroll
            for (int b = 0; b < 2; ++b)
#pragma unroll
                for (int m = 0; m < 4; ++m)
#pragma unroll
                    for (int n = 0; n < 2; ++n) acc[a][b][m][n] = (f32x4){0.f, 0.f, 0.f, 0.f};
        cur = nxt; cA = nA; cB = nB; ++ui;
        if constexpr (ALIGN_EPI) { if (wr == 1) PG8_BAR; }
    }
    PG8_WAIT_V(0);
    if constexpr (!ALIGN_EPI) { if (wr == 0) PG8_BAR; }
    PG8_BAR;
    if constexpr (Epi::AFTER_DRAIN) { E.fused(acc, cur, wr, wc, fr, fq, lds, wid, lane); S.done(cur); }
#undef PG8_SA
#undef PG8_SB
#undef PG8_STAGE
#undef PG8_LDA
#undef PG8_LDB
#undef PG8_MMA
#undef PG8_WAIT_V
#undef PG8_WAIT_L
#undef PG8_BAR
#undef PG8_SCHED
}
}
#define GAS __attribute__((address_space(1)))
#define LAS __attribute__((address_space(3)))
typedef unsigned short bf16;
typedef unsigned v4u __attribute__((ext_vector_type(4)));
typedef float f32x4 __attribute__((ext_vector_type(4)));
typedef short bf16x8 __attribute__((ext_vector_type(8)));
typedef GAS unsigned gu32;
typedef GAS unsigned long long gu64;
#define RLX_AGENT __ATOMIC_RELAXED, __HIP_MEMORY_SCOPE_AGENT
#define LDS_WAIT() asm volatile("s_waitcnt lgkmcnt(0)" ::: "memory")
#define VM_WAIT() asm volatile("s_waitcnt vmcnt(0)" ::: "memory")
__device__ __forceinline__ unsigned long long rt() { return __builtin_amdgcn_s_memrealtime(); }
__device__ __forceinline__ unsigned f2bf(float f) { unsigned u = __builtin_bit_cast(unsigned, f); return (u + 0x7fffu + ((u >> 16) & 1u)) >> 16; }
__device__ __forceinline__ unsigned pk2(float lo, float hi) { return pg8::cvt_pk_bf16(lo, hi); }

#define XB_TMO      128
#define XB_XCNT(j)  (256  + 64 * (j))
#define XB_XSUB(j)  (1280 + 64 * (j))
#define XB_XGEN(j)  (2304 + 64 * (j))
#define XB_TOP      3328
#define XB_TOPGEN   3392
#define XCD_BAR_WORDS 3456
#define XB_SPIN_CAP (1u << 18)

__device__ __forceinline__ unsigned xb_ld(unsigned* p)              { return __hip_atomic_load(p, __ATOMIC_RELAXED, __HIP_MEMORY_SCOPE_AGENT); }
__device__ __forceinline__ unsigned xb_add(unsigned* p, unsigned v) { return __hip_atomic_fetch_add(p, v, __ATOMIC_RELAXED, __HIP_MEMORY_SCOPE_AGENT); }
__device__ __forceinline__ unsigned xb_xcc_id() { return (unsigned)__builtin_amdgcn_s_getreg((3 << 11) | 20) & 0xFu; }
#define XB_SPIN(cond, bar) do { unsigned _sp = 0; while (cond) { __builtin_amdgcn_s_sleep(1); \
    if ((++_sp & 255u) == 0u) { if (xb_ld(&(bar)[XB_TMO])) break; if (_sp > XB_SPIN_CAP) { atomicAdd(&(bar)[XB_TMO], 1u); break; } } } } while (0)

struct XcdBarrier {
    unsigned* bar; unsigned x;
    volatile LAS unsigned* st;
};

__device__ __forceinline__ XcdBarrier xcd_barrier_post(unsigned* bar, volatile LAS unsigned* st) {
    XcdBarrier b; b.bar = bar; b.x = xb_xcc_id(); b.st = st;
    if (threadIdx.x == 0) (void)xb_add(&bar[XB_XCNT(b.x)], 1u);
    return b;
}
__device__ __forceinline__ void xcd_barrier_complete(unsigned* bar, unsigned x, unsigned& nloc, unsigned& nx) {
    const unsigned G = gridDim.x * gridDim.y * gridDim.z;
    unsigned sum, cnt, mine, sp = 0u;
    for (;;) {
        sum = 0u; cnt = 0u; mine = 0u;
#pragma unroll
        for (unsigned j = 0; j < 16; ++j) { const unsigned c = xb_ld(&bar[XB_XCNT(j)]); sum += c; cnt += (c > 0u) ? 1u : 0u; mine = (j == x) ? c : mine; }
        if (sum == G) break;
        __builtin_amdgcn_s_sleep(1);
        if ((++sp & 255u) == 0u) { if (xb_ld(&bar[XB_TMO])) break; if (sp > XB_SPIN_CAP) { atomicAdd(&bar[XB_TMO], 1u); break; } }
    }
    nloc = mine > 0u ? mine : 1u; nx = cnt > 0u ? cnt : 1u;
}

__device__ __forceinline__ void xcd_barrier(const XcdBarrier& b) {
    asm volatile("s_waitcnt vmcnt(0)" ::: "memory");
    __syncthreads();
    if (threadIdx.x == 0) {
        unsigned* bar = b.bar;
        __builtin_amdgcn_s_waitcnt(0);
        unsigned nloc = b.st[0], nx = b.st[1];
        if (nloc == 0u) { xcd_barrier_complete(bar, b.x, nloc, nx); b.st[0] = nloc; b.st[1] = nx; }
        const unsigned old = xb_add(&bar[XB_XSUB(b.x)], 1u);
        const unsigned gen = old / nloc;
        if (old + 1u == (gen + 1u) * nloc) {
            __builtin_amdgcn_fence(__ATOMIC_RELEASE, "agent");
            asm volatile("s_waitcnt vmcnt(0)" ::: "memory");
            const unsigned og = xb_add(&bar[XB_TOP], 1u);
            const unsigned tg = og / nx;
            if (og + 1u == (tg + 1u) * nx) xb_add(&bar[XB_TOPGEN], 1u);
            else XB_SPIN(xb_ld(&bar[XB_TOPGEN]) == tg, bar);
            __builtin_amdgcn_fence(__ATOMIC_ACQUIRE, "agent");
            xb_add(&bar[XB_XGEN(b.x)], 1u);
            asm volatile("s_waitcnt vmcnt(0)" ::: "memory");
        } else {
            XB_SPIN(xb_ld(&bar[XB_XGEN(b.x)]) == gen, bar);
            __builtin_amdgcn_fence(__ATOMIC_ACQUIRE, "agent");
            asm volatile("s_waitcnt vmcnt(0)" ::: "memory");
        }
    }
    __syncthreads();
}

constexpr int NB = 4, T = 4096, D = 1024, M = NB * T, NH = 4, HD = 64, BW = 256, FF = 4096, DEPTH = 4;
constexpr int IN_COLS = 7852, PP = 3840, NG = 4096;
constexpr int NWAVES = 8;
#ifndef DBG_MERGE
#define DBG_MERGE 0
#endif
#ifndef DBG_ZERO
#define DBG_ZERO 0
#endif
constexpr float C2 = 0.125f * 1.4426950408889634f;
constexpr float LOG2E = 1.4426950408889634f;
constexpr float NEGBIG = -30000.f;
typedef float f32x16 __attribute__((ext_vector_type(16)));
typedef float f32x2 __attribute__((ext_vector_type(2)));
typedef unsigned u32x2 __attribute__((ext_vector_type(2)));
typedef unsigned u32x4 __attribute__((ext_vector_type(4)));
typedef const __attribute__((address_space(4))) f32x2* c4f2;
typedef const __attribute__((address_space(4))) unsigned* c4u;
typedef const __attribute__((address_space(4))) float* c4f;

constexpr size_t MiB = 1u << 20;
constexpr size_t WS_CTL = 0, CTL_ZERO_BYTES = 1 * MiB;
constexpr size_t WS_WIN = 1 * MiB, WS_WG = 9 * MiB, WS_WB = 17 * MiB, WS_WO = 19 * MiB, WS_WUP = 21 * MiB, WS_WDN = 29 * MiB;
constexpr size_t WS_XN = 37 * MiB, WS_SMALL = 69 * MiB, WS_VFIRST = 85 * MiB, WS_Y = 101 * MiB;
constexpr size_t WS_P = 133 * MiB, WS_SC = 133 * MiB, WS_MASK = 263 * MiB, WS_HGF = 271 * MiB;
constexpr size_t WS_BQ = 287 * MiB, WS_BK = 295 * MiB, WS_BVT = 303 * MiB, WS_QI = 311 * MiB, WS_KI = 319 * MiB, WS_DQ = 320 * MiB, WS_DK = 328 * MiB, WS_DVT = 336 * MiB;
constexpr size_t WS_FL = 344 * MiB, WS_FB = WS_FL + 256 * 1024, WS_RB = WS_FB + 256 * 1024;
constexpr size_t WS_RW = 345 * MiB, WS_RV = 425 * MiB, WS_RG = 441 * MiB, WS_END = 457 * MiB;
constexpr size_t WS_G = 133 * MiB, WS_Z = 261 * MiB, WS_MIX = 293 * MiB, WS_U = 133 * MiB;
constexpr size_t SC_PB = (size_t)4096 * 2080;
static_assert(WS_SC + 4 * SC_PB * 4 <= WS_MASK, "scores fit");
constexpr int CW_BAR = 4096;

__device__ __forceinline__ float bf2f(unsigned short v) { return __uint_as_float((unsigned)v << 16); }
__device__ __forceinline__ float bflo(unsigned w) { return __uint_as_float(w << 16); }
__device__ __forceinline__ float bfhi(unsigned w) { return __uint_as_float(w & 0xffff0000u); }
template <int O> __device__ __forceinline__ float swz_xor(float v) { return __int_as_float(__builtin_amdgcn_ds_swizzle(__float_as_int(v), (O << 10) | 0x1f)); }
__device__ __forceinline__ float half_sum(float v) { auto rr = __builtin_amdgcn_permlane32_swap(__float_as_uint(v), __float_as_uint(v), false, false); return __uint_as_float(rr[0]) + __uint_as_float(rr[1]); }
__device__ __forceinline__ float half_max(float v) { auto rr = __builtin_amdgcn_permlane32_swap(__float_as_uint(v), __float_as_uint(v), false, false); return fmaxf(__uint_as_float(rr[0]), __uint_as_float(rr[1])); }
__device__ __forceinline__ float wave_sum(float v) {
    v += swz_xor<1>(v); v += swz_xor<2>(v); v += swz_xor<4>(v); v += swz_xor<8>(v); v += swz_xor<16>(v);
    return half_sum(v);
}
__device__ __forceinline__ float sigmoidf_(float x) { return 1.f / (1.f + __expf(-x)); }
__device__ __forceinline__ int crow(int r, int hi) { return (r & 3) + 8 * (r >> 2) + 4 * hi; }
__device__ __forceinline__ size_t sc_rowoff(int b, int t) { const int k = t >> 6; return (size_t)b * SC_PB + (size_t)64 * ((size_t)32 * k * (k + 1) + (size_t)(t - 64 * k) * (k + 1)); }

namespace pg8 {
struct EpiIn {
    static constexpr bool PERM = true, AFTER_DRAIN = false;
    bf16_t* P; float* SM;
    __device__ __forceinline__ void operator()(const f32x4 (&acc)[2][2][4][2], const Unit& u, int wr, int wc, int fr, int fq) const {
        const int row0 = u.pm * BM + wr * 64 + fr; const int col0 = wc * 32 + 8 * fq;
        if (u.pn == 11) {
#pragma unroll
            for (int ai = 0; ai < 2; ++ai)
#pragma unroll
                for (int m = 0; m < 4; ++m) { float* rowp = SM + (size_t)(row0 + ai * HALF + m * 16) * 256 + col0;
#pragma unroll
                    for (int bj = 0; bj < 2; ++bj) { *(f32x4*)(rowp + bj * HALF) = acc[ai][bj][m][0]; *(f32x4*)(rowp + bj * HALF + 4) = acc[ai][bj][m][1]; } }
        } else {
#pragma unroll
            for (int ai = 0; ai < 2; ++ai)
#pragma unroll
                for (int m = 0; m < 4; ++m) { bf16_t* rowp = P + (size_t)(row0 + ai * HALF + m * 16) * PP + u.pn * BM + col0;
#pragma unroll
                    for (int bj = 0; bj < 2; ++bj) { const f32x4 v0 = acc[ai][bj][m][0], v1 = acc[ai][bj][m][1];
                        u32x4 w; w.x = cvt_pk_bf16(v0[0], v0[1]); w.y = cvt_pk_bf16(v0[2], v0[3]); w.z = cvt_pk_bf16(v1[0], v1[1]); w.w = cvt_pk_bf16(v1[2], v1[3]);
                        *(u32x4*)(rowp + bj * HALF) = w; } }
        }
    }
};
template <int ACT> struct EpiAct {
    static constexpr bool PERM = true, AFTER_DRAIN = false;
    bf16_t* O; int ldc;
    __device__ __forceinline__ float f(float x) const { if (ACT == 0 && DBG_MERGE == 3) return 1.f; if (ACT == 0) return __builtin_amdgcn_rcpf(1.f + __builtin_amdgcn_exp2f(-1.4426950408889634f * x)); const float r = x > 0.f ? x : 0.f; return r * r; }
    __device__ __forceinline__ void operator()(const f32x4 (&acc)[2][2][4][2], const Unit& u, int wr, int wc, int fr, int fq) const {
        const int row0 = u.pm * BM + wr * 64 + fr; const int col0 = u.pn * BM + wc * 32 + 8 * fq;
#pragma unroll
        for (int ai = 0; ai < 2; ++ai)
#pragma unroll
            for (int m = 0; m < 4; ++m) { bf16_t* rowp = O + (size_t)(row0 + ai * HALF + m * 16) * ldc + col0;
#pragma unroll
                for (int bj = 0; bj < 2; ++bj) { const f32x4 v0 = acc[ai][bj][m][0], v1 = acc[ai][bj][m][1];
                    u32x4 w; w.x = cvt_pk_bf16(f(v0[0]), f(v0[1])); w.y = cvt_pk_bf16(f(v0[2]), f(v0[3])); w.z = cvt_pk_bf16(f(v1[0]), f(v1[1])); w.w = cvt_pk_bf16(f(v1[2]), f(v1[3]));
                    *(u32x4*)(rowp + bj * HALF) = w; } }
    }
};
struct EpiMerge {
    static constexpr bool PERM = true, AFTER_DRAIN = false;
    const bf16_t* G; bf16_t* Z;
    __device__ __forceinline__ void operator()(const f32x4 (&acc)[2][2][4][2], const Unit& u, int wr, int wc, int fr, int fq) const {
        const int n = u.pn >> 2, ct = u.pn & 3;
        asm volatile("" : "+v"(fr), "+v"(fq));
        const int row0 = u.pm * BM + wr * 64 + fr; const int col0 = wc * 32 + 8 * fq;
#pragma unroll
        for (int ai = 0; ai < 2; ++ai)
#pragma unroll
            for (int m = 0; m < 4; ++m) { const size_t row = (size_t)(row0 + ai * HALF + m * 16);
                const bf16_t* gp = G + row * NG + u.pn * BM + col0; bf16_t* zp = Z + row * D + ct * BM + col0;
#pragma unroll
                for (int bj = 0; bj < 2; ++bj) { const f32x4 v0 = acc[ai][bj][m][0], v1 = acc[ai][bj][m][1];
                    u32x4 gw = *(const u32x4*)(gp + bj * HALF);
                    if (DBG_MERGE == 1) gw = (u32x4){0x3f803f80u, 0x3f803f80u, 0x3f803f80u, 0x3f803f80u};
                    if (DBG_MERGE == 2 && n > 0) continue;
                    float o[8];
                    o[0] = v0[0] * __uint_as_float(gw.x << 16); o[1] = v0[1] * __uint_as_float(gw.x & 0xffff0000u);
                    o[2] = v0[2] * __uint_as_float(gw.y << 16); o[3] = v0[3] * __uint_as_float(gw.y & 0xffff0000u);
                    o[4] = v1[0] * __uint_as_float(gw.z << 16); o[5] = v1[1] * __uint_as_float(gw.z & 0xffff0000u);
                    o[6] = v1[2] * __uint_as_float(gw.w << 16); o[7] = v1[3] * __uint_as_float(gw.w & 0xffff0000u);
                    if (n > 0) { const u32x4 zw = *(const u32x4*)(zp + bj * HALF);
                        o[0] += __uint_as_float(zw.x << 16); o[1] += __uint_as_float(zw.x & 0xffff0000u); o[2] += __uint_as_float(zw.y << 16); o[3] += __uint_as_float(zw.y & 0xffff0000u);
                        o[4] += __uint_as_float(zw.z << 16); o[5] += __uint_as_float(zw.z & 0xffff0000u); o[6] += __uint_as_float(zw.w << 16); o[7] += __uint_as_float(zw.w & 0xffff0000u); }
                    u32x4 w; w.x = cvt_pk_bf16(o[0], o[1]); w.y = cvt_pk_bf16(o[2], o[3]); w.z = cvt_pk_bf16(o[4], o[5]); w.w = cvt_pk_bf16(o[6], o[7]);
                    *(u32x4*)(zp + bj * HALF) = w; }
                asm volatile("" ::: "memory"); }
    }
};
struct EpiF32 {
    static constexpr bool PERM = false, AFTER_DRAIN = false;
    float* O; int ldc;
    __device__ __forceinline__ void operator()(const f32x4 (&acc)[2][2][4][2], const Unit& u, int wr, int wc, int fr, int fq) const {
        const int row0 = u.pm * BM + wr * 64 + fr; const int col0 = u.pn * BM + wc * 32 + 4 * fq;
#pragma unroll
        for (int ai = 0; ai < 2; ++ai)
#pragma unroll
            for (int m = 0; m < 4; ++m) { float* rowp = O + (size_t)(row0 + ai * HALF + m * 16) * ldc + col0;
#pragma unroll
                for (int bj = 0; bj < 2; ++bj)
#pragma unroll
                    for (int n = 0; n < 2; ++n) *(f32x4*)(rowp + bj * HALF + n * 16) = acc[ai][bj][m][n]; }
    }
};
struct MergeOrder {
    int G, c;
    __host__ __device__ bool next(int i, Unit& u) const { const int ot = c + (i >> 2) * G; if (ot >= 256) return false; u.pm = ot >> 2; u.pn = (i & 3) * 4 + (ot & 3); return true; }
    __device__ __forceinline__ void a_ready(const Unit&) const {}
    __device__ __forceinline__ void done(const Unit&) const {}
};
}

__device__ __forceinline__ int in_src(int c, float& sc) {
    const int t = c >> 8, j = c & 255; sc = 1.f;
    switch (t) {
        case 0: sc = 0.125f; return j;
        case 1: return 256 + j;
        case 2: return 512 + j;
        case 3: return 768 + j;
        case 4: sc = C2; return 1024 + j;
        case 5: return 1280 + j;
        case 6: return 1536 + j;
        case 7: sc = 0.17677669529663687f; return 1792 + j;
        case 8: return 2088 + j;
        case 9: return 2344 + j;
        case 10: return 2600 + j;
        case 11: if (j < 128) return 2856 + j; if (j < 160) return 2048 + (j - 128); if (j < 168) { sc = 0.35355339059327373f; return 2080 + (j - 160); } if (j < 172) return 3752 + (j - 168); return -1;
        case 12: sc = C2; return 2984 + j;
        case 13: return 3240 + j;
        default: return 3496 + j;
    }
}
__device__ __forceinline__ void wt_item(const float* W, int ldw, int kind, int coff, const float* gk, bf16* WT, int K, int kb, int nb, LAS float* scr, int lane) {
    const int k0 = 64 * kb, n0 = 32 * nb;
    const int c = n0 + (lane & 31); float sc = 1.f; const int src = (kind == 1) ? in_src(c, sc) : coff + c;
#pragma unroll 8
    for (int i = 0; i < 32; ++i) { const int kk = 2 * i + (lane >> 5); float v = 0.f; if (src >= 0) v = W[(size_t)(k0 + kk) * ldw + src] * sc; if (gk) v *= gk[k0 + kk]; scr[kk * 33 + (lane & 31)] = v; }
    LDS_WAIT(); asm volatile("" ::: "memory");
    const int cc = lane & 7;
#pragma unroll
    for (int j = 0; j < 4; ++j) { const int n = (lane >> 3) + 8 * j; const LAS float* s = scr + (8 * cc) * 33 + n;
        v4u o; o.x = pk2(s[0 * 33], s[1 * 33]); o.y = pk2(s[2 * 33], s[3 * 33]); o.z = pk2(s[4 * 33], s[5 * 33]); o.w = pk2(s[6 * 33], s[7 * 33]);
        *(GAS v4u*)(WT + (size_t)(n0 + n) * K + k0 + 8 * cc) = o; }
    LDS_WAIT(); asm volatile("" ::: "memory");
}
__device__ __forceinline__ void rms_row_to_bf16(const float* xrow, bf16* orow, int lane) {
    const GAS f32x4* xr = (const GAS f32x4*)xrow + lane;
    f32x4 v[4]; float s = 0.f;
#pragma unroll
    for (int j = 0; j < 4; ++j) { v[j] = xr[64 * j]; s += (v[j].x * v[j].x + v[j].y * v[j].y) + (v[j].z * v[j].z + v[j].w * v[j].w); }
    const float rstd = 1.f / sqrtf(wave_sum(s) * (1.f / D) + 1e-6f);
    GAS unsigned long long* o8 = (GAS unsigned long long*)orow + lane;
#pragma unroll
    for (int j = 0; j < 4; ++j) o8[64 * j] = (unsigned long long)pk2(v[j].x * rstd, v[j].y * rstd) | ((unsigned long long)pk2(v[j].z * rstd, v[j].w * rstd) << 32);
}
__device__ __forceinline__ void post_row(const float* mixrow, const float* xold, const float* g, float* xout, bf16* xn, int lane) {
    const GAS f32x4* mr = (const GAS f32x4*)mixrow + lane; const GAS f32x4* xr = (const GAS f32x4*)xold + lane; const GAS f32x4* gr = (const GAS f32x4*)g + lane;
    f32x4 v[4]; float s = 0.f;
#pragma unroll
    for (int j = 0; j < 4; ++j) { v[j] = mr[64 * j]; s += (v[j].x * v[j].x + v[j].y * v[j].y) + (v[j].z * v[j].z + v[j].w * v[j].w); }
    const float rstd = 1.f / sqrtf(wave_sum(s) * (1.f / D) + 1e-6f);
    float s2 = 0.f;
#pragma unroll
    for (int j = 0; j < 4; ++j) { const f32x4 xo = xr[64 * j], gg = gr[64 * j]; v[j] = xo + v[j] * rstd * gg; s2 += (v[j].x * v[j].x + v[j].y * v[j].y) + (v[j].z * v[j].z + v[j].w * v[j].w); }
    GAS f32x4* orow = (GAS f32x4*)xout + lane;
#pragma unroll
    for (int j = 0; j < 4; ++j) orow[64 * j] = v[j];
    if (xn) {
        const float rstd2 = 1.f / sqrtf(wave_sum(s2) * (1.f / D) + 1e-6f);
        GAS unsigned long long* o8 = (GAS unsigned long long*)xn + lane;
#pragma unroll
        for (int j = 0; j < 4; ++j) o8[64 * j] = (unsigned long long)pk2(v[j].x * rstd2, v[j].y * rstd2) | ((unsigned long long)pk2(v[j].z * rstd2, v[j].w * rstd2) << 32);
    }
}

struct Args { const float* in[27]; float* out; unsigned char* ws; int l_lo, l_hi; };

__device__ __forceinline__ void rope_pair(float a, float b, float ang, float& oa, float& ob) {
    float rev = ang * 0.15915494309189535f; rev -= floorf(rev);
    const float sn = __builtin_amdgcn_sinf(rev), cs = __builtin_amdgcn_cosf(rev);
    oa = a * cs - b * sn; ob = b * cs + a * sn;
}
__device__ __forceinline__ void prep_token(const Args& A, unsigned char* ws, int l, int m, int lane) {
    const bf16* prow = (const bf16*)(ws + WS_P) + (size_t)m * PP; const float* srow = (const float*)(ws + WS_SMALL) + (size_t)m * 256;
    const int t = m & (T - 1);
    {
        const u32x2 w = *(const u32x2*)(prow + 256 + 4 * lane);
        const float fl[4] = {bflo(w.x), bfhi(w.x), bflo(w.y), bfhi(w.y)};
        f32x4 e[4]; const float* lbl = A.in[8];
#pragma unroll
        for (int q = 0; q < 4; ++q) e[q] = *(const f32x4*)(lbl + q * 256 + 4 * lane);
        f32x4 o;
#pragma unroll
        for (int i = 0; i < 4; ++i) { const float mx = fmaxf(fmaxf(e[0][i], e[1][i]), fmaxf(e[2][i], e[3][i]));
            float ex[4], sum = 0.f, part = 0.f;
#pragma unroll
            for (int q = 0; q < 4; ++q) { ex[q] = __expf(e[q][i] - mx); sum += ex[q]; }
#pragma unroll
            for (int q = 1; q < 4; ++q) if (q <= l) part += ex[q];
            const float lb = part / sum; o[i] = lb + (1.f - lb) * sigmoidf_(fl[i]); }
        *(f32x4*)((float*)(ws + WS_HGF) + (size_t)m * 256 + 4 * lane) = o;
    }
    {
        const int hh = lane >> 4, j0 = (lane & 15) * 2;
        const float tf = (float)t;
        const float a0 = tf * exp2f(-(float)j0 * (13.287712379549449f / 32.f)), a1 = tf * exp2f(-(float)(j0 + 1) * (13.287712379549449f / 32.f));
#pragma unroll
        for (int which = 0; which < 2; ++which) {
            const bf16* src = prow + (which ? 1280 : 1024) + hh * 64 + j0;
            bf16* dst = (bf16*)(ws + (which ? WS_BK : WS_BQ)) + (size_t)m * 256 + hh * 64 + j0;
            const unsigned w1 = *(const unsigned*)src, w2 = *(const unsigned*)(src + 32);
            float o1a, o2a, o1b, o2b; rope_pair(bflo(w1), bflo(w2), a0, o1a, o2a); rope_pair(bfhi(w1), bfhi(w2), a1, o1b, o2b);
            *(unsigned*)dst = pk2(o1a, o1b); *(unsigned*)(dst + 32) = pk2(o2a, o2b);
        }
    }
    {
        const int ih = lane >> 3, j0 = (lane & 7) * 2; const float tf = (float)t;
        const float a0 = tf * exp2f(-(float)j0 * (13.287712379549449f / 16.f)), a1 = tf * exp2f(-(float)(j0 + 1) * (13.287712379549449f / 16.f));
        const bf16* src = prow + 1792 + ih * 32 + j0; bf16* dst = (bf16*)(ws + WS_QI) + (size_t)m * 256 + ih * 32 + j0;
        const unsigned w1 = *(const unsigned*)src, w2 = *(const unsigned*)(src + 16);
        float o1a, o2a, o1b, o2b; rope_pair(bflo(w1), bflo(w2), a0, o1a, o2a); rope_pair(bfhi(w1), bfhi(w2), a1, o1b, o2b);
        *(unsigned*)dst = pk2(o1a, o1b); *(unsigned*)(dst + 16) = pk2(o2a, o2b);
        if (lane < 16) {
            const float ang = tf * exp2f(-(float)lane * (13.287712379549449f / 16.f));
            float oa, ob; rope_pair(srow[128 + lane], srow[128 + lane + 16], ang, oa, ob);
            bf16* kd = (bf16*)(ws + WS_KI) + (size_t)m * 32; kd[lane] = (bf16)f2bf(oa); kd[lane + 16] = (bf16)f2bf(ob);
        }
        if (lane < 4) {
            const float x = srow[168 + lane] + A.in[10][l * 4 + lane];
            ((float*)(ws + WS_FL))[(size_t)m * 4 + lane] = fminf(x, 0.f) - log1pf(__expf(-fabsf(x)));
        }
    }
    {
        *(u32x2*)((bf16*)(ws + WS_DQ) + (size_t)m * 256 + 4 * lane) = *(const u32x2*)(prow + 3072 + 4 * lane);
        *(u32x2*)((bf16*)(ws + WS_DK) + (size_t)m * 256 + 4 * lane) = *(const u32x2*)(prow + 3328 + 4 * lane);
    }
}
__device__ __forceinline__ void prep_vt(unsigned char* ws, int item, LAS unsigned char* scr, int lane) {
    const int which = item >> 10, r = item & 1023, b = r >> 8, tb = (r >> 2) & 63, hh = r & 3;
    const bf16* src = (const bf16*)(ws + WS_P) + (size_t)(b * T + 64 * tb) * PP + (which ? 3584 : 1536) + hh * 64;
    bf16* dst = (bf16*)(ws + (which ? WS_DVT : WS_BVT)) + (size_t)((b * NH + hh) * 64) * T + 64 * tb;
#pragma unroll
    for (int i = 0; i < 8; ++i) { const int rr = 8 * i + (lane >> 3), ch = lane & 7; const v4u v = *(const v4u*)(src + (size_t)rr * PP + ch * 8);
        LAS unsigned* p = (LAS unsigned*)(scr + rr * 132 + ch * 16); p[0] = v.x; p[1] = v.y; p[2] = v.z; p[3] = v.w; }
    LDS_WAIT(); asm volatile("" ::: "memory");
#pragma unroll
    for (int i = 0; i < 8; ++i) { const int d = 8 * i + (lane >> 3), tc = lane & 7; unsigned short e[8];
#pragma unroll
        for (int k = 0; k < 8; ++k) e[k] = *(const LAS unsigned short*)(scr + (tc * 8 + k) * 132 + d * 2);
        v4u o; o.x = e[0] | ((unsigned)e[1] << 16); o.y = e[2] | ((unsigned)e[3] << 16); o.z = e[4] | ((unsigned)e[5] << 16); o.w = e[6] | ((unsigned)e[7] << 16);
        *(v4u*)(dst + (size_t)d * T + tc * 8) = o; }
    LDS_WAIT(); asm volatile("" ::: "memory");
}
__device__ __forceinline__ void prep_rwkv(const Args& A, unsigned char* ws, int l, LAS unsigned char* lds, const int tid, const int bx, const int G) {
    const int c = tid & 255, grp = tid >> 8, lane = tid & 63, hh = c >> 6;
    LAS float* g2s = (LAS float*)lds;
    LAS float* w2s = (LAS float*)(lds + 65536);
    LAS float* a2s = (LAS float*)(lds + 98304);
    LAS float* tws = (LAS float*)(lds + 131072 + 1024);
    LAS float* ains = tws + 64;
    LAS float* sgs = ains + 64;
    LAS float* vs = sgs + 128;
    LAS float* vvp = vs + 512;
    LAS float* vvs = vvp + 512;
    const float* mu = A.in[11] + l * 896; const float* w2 = A.in[13] + (size_t)l * 32 * 256; const float* a2 = A.in[15] + (size_t)l * 32 * 256; const float* g2 = A.in[16] + (size_t)l * 64 * 256;
    for (int i = tid; i < 64 * 256; i += 512) g2s[i] = g2[i];
    for (int i = tid; i < 32 * 256; i += 512) { w2s[i] = w2[i]; a2s[i] = a2[i]; }
    float v2c[32], v1p[32];
    const int jq = c & 31, sq = c >> 5;
    if (l > 0) { const float* v1 = A.in[23] + (size_t)(l - 1) * 256 * 32; const float* v2 = A.in[24] + (size_t)(l - 1) * 32 * 256;
#pragma unroll
        for (int j = 0; j < 32; ++j) { v2c[j] = v2[j * 256 + c]; v1p[j] = v1[(32 * sq + j) * 32 + jq]; } }
    else {
#pragma unroll
        for (int j = 0; j < 32; ++j) { v2c[j] = 0.f; v1p[j] = 0.f; } }
    const float mur = mu[c], muk = mu[256 + c], muv = mu[512 + c], mus = (c < 128) ? mu[768 + c] : 0.f;
    const float w0 = A.in[12][l * 256 + c], a0 = A.in[14][l * 256 + c], v0 = (l > 0) ? A.in[22][(l - 1) * 256 + c] : 0.f;
    const float kkc = A.in[17][l * 256 + c], kac = A.in[18][l * 256 + c], rkc = A.in[19][l * 256 + c];
    __syncthreads();
    const bf16* P = (const bf16*)(ws + WS_P); const float* SM = (const float*)(ws + WS_SMALL);
    float* VF = (float*)(ws + WS_VFIRST); float* RW = (float*)(ws + WS_RW); float* RV = (float*)(ws + WS_RV); float* RG = (float*)(ws + WS_RG); float* RB = (float*)(ws + WS_RB);
    for (int p = bx; p < M / 2; p += G) {
        const int m = 2 * p + grp, t = m & (T - 1), b = m >> 12;
        const bf16* pr = P + (size_t)m * PP + 2048; const float* sr = SM + (size_t)m * 256;
        float r = bf2f(pr[c]), k = bf2f(pr[256 + c]), v = bf2f(pr[512 + c]);
        float rp = 0.f, kp = 0.f, vp = 0.f, sp = 0.f, scur = (c < 128) ? sr[c] : 0.f;
        if (t > 0) { rp = bf2f(pr[c - PP]); kp = bf2f(pr[256 + c - PP]); vp = bf2f(pr[512 + c - PP]); if (c < 128) sp = sr[c - 256]; }
        r += (rp - r) * mur; k += (kp - k) * muk; v += (vp - v) * muv;
        if (c < 128) { const float xs = scur + (sp - scur) * mus;
            if (c < 32) tws[grp * 32 + c] = tanhf(xs); else if (c < 64) ains[grp * 32 + (c - 32)] = xs; else sgs[grp * 64 + (c - 64)] = sigmoidf_(xs); }
        if (l > 0) vs[grp * 256 + c] = v;
        __syncthreads();
        float wl = w0, al = a0, g = 0.f;
#pragma unroll 8
        for (int j = 0; j < 32; ++j) { wl += tws[grp * 32 + j] * w2s[j * 256 + c]; al += ains[grp * 32 + j] * a2s[j * 256 + c]; }
#pragma unroll 16
        for (int j = 0; j < 64; ++j) g += sgs[grp * 64 + j] * g2s[j * 256 + c];
        if (l > 0) { float part = 0.f;
#pragma unroll
            for (int j = 0; j < 32; ++j) part += vs[grp * 256 + 32 * sq + j] * v1p[j];
            vvp[(grp * 8 + sq) * 32 + jq] = part; }
        __syncthreads();
        if (l > 0) {
            if (c < 32) { float s = 0.f;
#pragma unroll
                for (int q = 0; q < 8; ++q) s += vvp[(grp * 8 + q) * 32 + c];
                vvs[grp * 32 + c] = s; }
            __syncthreads();
            float vg = v0;
#pragma unroll
            for (int j = 0; j < 32; ++j) vg += vvs[grp * 32 + j] * v2c[j];
            const float vf = VF[(size_t)m * 256 + c];
            v = v + (vf - v) * sigmoidf_(vg);
        } else VF[(size_t)m * 256 + c] = v;
        const float a = sigmoidf_(al);
        const float decay = __expf(-0.6065306597126334f * sigmoidf_(wl));
        float kk = k * kkc; const float ss = wave_sum(kk * kk); kk *= rsqrtf(fmaxf(ss, 1e-24f));
        const float k2 = k * (1.f + (a - 1.f) * kac);
        const float bon = wave_sum(r * k2 * rkc);
        float* rec = RW + ((size_t)((b * NH + hh) * T + t)) * 320;
        rec[lane] = decay; rec[64 + lane] = kk; rec[128 + lane] = kk * a; rec[192 + lane] = k2; rec[256 + lane] = r;
        RV[(size_t)m * 256 + c] = v; RG[(size_t)m * 256 + c] = g;
        if (lane == 0) RB[(size_t)m * 4 + hh] = bon;
        __syncthreads();
    }
}

__device__ __forceinline__ void rwkv_scan_wave(const Args& A, unsigned char* ws, int l, int bh, int lane) {
    const int b = bh >> 2, hh = bh & 3;
    f32x2 S[32];
#pragma unroll
    for (int i = 0; i < 32; ++i) S[i] = (f32x2){0.f, 0.f};
    const float lnw = A.in[20][l * 256 + hh * 64 + lane], lnb = A.in[21][l * 256 + hh * 64 + lane];
    const float* rvp = (const float*)(ws + WS_RV) + (size_t)(b * T) * 256 + hh * 64 + lane;
    const float* rgp = (const float*)(ws + WS_RG) + (size_t)(b * T) * 256 + hh * 64 + lane;
    const float* rbp = (const float*)(ws + WS_RB) + (size_t)(b * T) * 4 + hh;
    bf16* yp = (bf16*)(ws + WS_Y) + (size_t)(b * T) * 1024 + 512 + hh * 64 + lane;
    c4f2 rec = (c4f2)(const void*)((const float*)(ws + WS_RW) + (size_t)bh * T * 320);
    float vnext = rvp[0];
    for (int t = 0; t < T; ++t) {
        const float vv = vnext; if (t + 1 < T) vnext = rvp[(size_t)(t + 1) * 256];
        const float gg = rgp[(size_t)t * 256]; const float bon = rbp[(size_t)t * 4];
        c4f2 p = rec + (size_t)t * 160;
        f32x2 acc = (f32x2){0.f, 0.f};
#pragma unroll
        for (int i = 0; i < 32; ++i) acc += S[i] * p[32 + i];
        const float sa = acc.x + acc.y;
        f32x2 ya = (f32x2){0.f, 0.f};
#pragma unroll
        for (int i = 0; i < 32; ++i) { f32x2 s = S[i] * p[i]; s -= sa * p[64 + i]; s += vv * p[96 + i]; S[i] = s; ya += s * p[128 + i]; }
        const float y = ya.x + ya.y;
        const float mean = wave_sum(y) * (1.f / 64.f); const float dv = y - mean; const float var = wave_sum(dv * dv) * (1.f / 64.f);
        float o = dv * rsqrtf(var + 64e-5f) * lnw + lnb; o += bon * vv; o *= gg;
        if (DBG_ZERO & 4) o = 0.f;
        yp[(size_t)t * 1024] = (bf16)f2bf(o);
    }
}
__device__ __forceinline__ void hgrn_scan_wave(const Args& A, unsigned char* ws, int l, int bh, int lane) {
    const int b = bh >> 2, hh = bh & 3;
    float S[64];
#pragma unroll
    for (int i = 0; i < 64; ++i) S[i] = 0.f;
    const float nw = A.in[9][l * 64 + lane];
    const bf16* pb = (const bf16*)(ws + WS_P) + (size_t)(b * T) * PP + hh * 64;
    bf16* yp = (bf16*)(ws + WS_Y) + (size_t)(b * T) * 1024 + hh * 64 + lane;
    c4f fb = (c4f)(const void*)((const float*)(ws + WS_HGF) + (size_t)(b * T) * 256 + hh * 64);
    for (int t = 0; t < T; ++t) {
        const float iv = bf2f(pb[(size_t)t * PP + 512 + lane]); const float go = bf2f(pb[(size_t)t * PP + 768 + lane]);
        c4f f = fb + (size_t)t * 256; c4u q = (c4u)(const void*)(pb + (size_t)t * PP);
        float o0 = 0.f, o1 = 0.f;
#pragma unroll
        for (int i = 0; i < 32; ++i) { const unsigned qw = q[i]; const float q0 = __uint_as_float(qw << 16), q1 = __uint_as_float(qw & 0xffff0000u);
            S[2 * i] = f[2 * i] * (S[2 * i] - iv) + iv; o0 += q0 * S[2 * i];
            S[2 * i + 1] = f[2 * i + 1] * (S[2 * i + 1] - iv) + iv; o1 += q1 * S[2 * i + 1]; }
        const float o = o0 + o1;
        const float ms = wave_sum(o * o) * (1.f / 64.f);
        float r = o * rsqrtf(ms + 1e-6f) * nw * (go * sigmoidf_(go));
        if (DBG_ZERO & 1) r = 0.f;
        yp[(size_t)t * 1024] = (bf16)f2bf(r);
    }
}
__device__ __forceinline__ void fox_cumsum_wave(unsigned char* ws, int bh, int lane) {
    const int b = bh >> 2, hh = bh & 3;
    const float* fl = (const float*)(ws + WS_FL) + (size_t)(b * T + 64 * lane) * 4 + hh;
    float s = 0.f;
    for (int i = 0; i < 64; ++i) s += fl[i * 4];
    float incl = s;
#pragma unroll
    for (int o = 1; o < 64; o <<= 1) { const float n = __int_as_float(__builtin_amdgcn_ds_bpermute(((lane - o) & 63) << 2, __float_as_int(incl))); if (lane >= o) incl += n; }
    float run = incl - s;
    float* fbp = (float*)(ws + WS_FB) + (size_t)bh * T + 64 * lane;
    for (int i = 0; i < 64; ++i) { run += fl[i * 4]; fbp[i] = -run * LOG2E; }
}

__device__ __forceinline__ void dsa_scores_unit(unsigned char* ws, int u, int lane) {
    const int b = u >> 10, qg = (u >> 3) & 127, kc = u & 7;
    const int nkvb = 2 * ((qg >> 1) + 1);
    if (kc * 16 >= nkvb) return;
    const int q = lane & 31, hi = lane >> 5; const int trow = 32 * qg + q; const size_t grow = (size_t)b * T + trow;
    const bf16* QI = (const bf16*)(ws + WS_QI); const bf16* KI = (const bf16*)(ws + WS_KI); const float* SM = (const float*)(ws + WS_SMALL);
    bf16x8 qf[8][2]; float wq[8];
#pragma unroll
    for (int h = 0; h < 8; ++h) { qf[h][0] = *(const bf16x8*)(QI + grow * 256 + h * 32 + hi * 8); qf[h][1] = *(const bf16x8*)(QI + grow * 256 + h * 32 + 16 + hi * 8); wq[h] = SM[grow * 256 + 160 + h]; }
    float* srow = (float*)(ws + WS_SC) + sc_rowoff(b, trow);
    const int kb1 = (kc * 16 + 16 < nkvb) ? kc * 16 + 16 : nkvb;
#pragma unroll 1
    for (int kb = kc * 16; kb < kb1; ++kb) {
        const bf16* kp = KI + ((size_t)b * T + 32 * kb + q) * 32 + hi * 8;
        const bf16x8 k0 = *(const bf16x8*)kp, k1 = *(const bf16x8*)(kp + 16);
        f32x16 acc;
#pragma unroll
        for (int r = 0; r < 16; ++r) acc[r] = 0.f;
#pragma unroll
        for (int h = 0; h < 8; ++h) { f32x16 d;
#pragma unroll
            for (int r = 0; r < 16; ++r) d[r] = 0.f;
            d = __builtin_amdgcn_mfma_f32_32x32x16_bf16(k0, qf[h][0], d, 0, 0, 0);
            d = __builtin_amdgcn_mfma_f32_32x32x16_bf16(k1, qf[h][1], d, 0, 0, 0);
#pragma unroll
            for (int r = 0; r < 16; ++r) acc[r] += wq[h] * fmaxf(d[r], 0.f);
            if (h & 1) __builtin_amdgcn_sched_barrier(0); }
#pragma unroll
        for (int j = 0; j < 4; ++j) *(f32x4*)(srow + 32 * kb + 8 * j + 4 * hi) = (f32x4){acc[4 * j], acc[4 * j + 1], acc[4 * j + 2], acc[4 * j + 3]};
    }
}

__device__ __forceinline__ void dsa_select_row(unsigned char* ws, int row, int lane) {
    const int b = row >> 12, t = row & (T - 1); const int nreg = (t >> 6) + 1;
    const float* src = (const float*)(ws + WS_SC) + sc_rowoff(b, t);
    unsigned key[64];
#pragma unroll
    for (int g = 0; g < 8; ++g) {
        if (8 * g < nreg) {
#pragma unroll
            for (int jj = 0; jj < 8; ++jj) { const int j = 8 * g + jj; unsigned u = 0u;
                if (j < nreg) { const unsigned bits = __float_as_uint(src[64 * j + lane]); u = bits ^ ((bits >> 31) ? 0xffffffffu : 0x80000000u); if (64 * j + lane > t) u = 0u; }
                key[j] = u; }
        } else {
#pragma unroll
            for (int jj = 0; jj < 8; ++jj) key[8 * g + jj] = 0u;
        }
    }
    unsigned thr = 0u; int need = 0;
    if (t >= 256) {
        for (int bit = 31; bit >= 0; --bit) {
            const unsigned cand = thr | (1u << bit); int cnt = 0;
#pragma unroll
            for (int g = 0; g < 8; ++g) if (8 * g < nreg) {
#pragma unroll
                for (int jj = 0; jj < 8; ++jj) cnt += __popcll(__ballot(key[8 * g + jj] >= cand));
                __builtin_amdgcn_sched_barrier(0); }
            if (cnt >= 256) thr = cand;
        }
        int gt = 0;
#pragma unroll
        for (int g = 0; g < 8; ++g) if (8 * g < nreg) {
#pragma unroll
            for (int jj = 0; jj < 8; ++jj) gt += __popcll(__ballot(key[8 * g + jj] > thr)); }
        need = 256 - gt;
    }
    unsigned mylo = 0u, myhi = 0u;
#pragma unroll
    for (int j = 0; j < 64; ++j) {
        const bool eq = key[j] == thr; const unsigned long long eqm = __ballot(eq);
        const int rank = (int)__builtin_amdgcn_mbcnt_hi((unsigned)(eqm >> 32), __builtin_amdgcn_mbcnt_lo((unsigned)eqm, 0u));
        const bool sel = (key[j] > thr) || (eq && rank < need);
        need -= __popcll(eqm);
        const unsigned long long word = __ballot(sel);
        { const unsigned wl_ = (unsigned)word, wh_ = (unsigned)(word >> 32);
          asm volatile("s_nop 4\n\tv_writelane_b32 %0, %1, %2" : "+v"(mylo) : "s"(wl_), "n"(j)); asm volatile("v_writelane_b32 %0, %1, %2" : "+v"(myhi) : "s"(wh_), "n"(j)); }
        if ((j & 3) == 3) __builtin_amdgcn_sched_barrier(0);
    }
    ((unsigned long long*)(ws + WS_MASK))[((size_t)b * 64 + lane) * T + t] = ((unsigned long long)myhi << 32) | mylo;
}

constexpr int AT_KS = 0, AT_VS = 9216, AT_WSF = 9216 + 8704, AT_BYTES = AT_WSF + 8 * 256;
template <int MODE>
__device__ __forceinline__ void attn_unit(LAS unsigned char* lds, int b, int hh, int qb, const bf16* Q, const bf16* K, const bf16* VT, const float* FBp, const unsigned long long* MT, bf16* Y, int ycol, const int tid) {
    const int lane = tid & 63, r32 = lane & 31, hi = lane >> 5; const int wid = __builtin_amdgcn_readfirstlane(tid >> 6);
    const int q0 = qb * 256, qw0 = q0 + wid * 32; const size_t rowbase = (size_t)b * T;
    bf16x8 qr[4];
#pragma unroll
    for (int d0 = 0; d0 < 4; ++d0) qr[d0] = *(const bf16x8*)(Q + (rowbase + qw0 + r32) * 256 + hh * 64 + d0 * 16 + hi * 8);
    f32x16 o0, o1;
#pragma unroll
    for (int r = 0; r < 16; ++r) { o0[r] = 0.f; o1[r] = 0.f; }
    float m_run = -1e30f, l_run = 0.f;
    const int NT = (q0 + 256) / 64;
    const int lrow = tid >> 3, lch = tid & 7;
    const bf16* kg = K + (rowbase + lrow) * 256 + hh * 64 + lch * 8;
    const bf16* vg = VT + ((size_t)((b * NH + hh) * 64 + lrow)) * T + lch * 8;
    v4u kreg = *(const v4u*)kg, vreg = *(const v4u*)vg;
    LAS unsigned char* Ks = lds + AT_KS; LAS unsigned char* Vs = lds + AT_VS; LAS float* wsf = (LAS float*)(lds + AT_WSF) + wid * 64;
    const float* fbh = FBp + (size_t)(b * NH + hh) * T;
    const int qabs = qw0 + r32;
    for (int t = 0; t < NT; ++t) {
        __syncthreads();
        *(LAS v4u*)(Ks + lrow * 144 + lch * 16) = kreg;
        *(LAS u32x2*)(Vs + lrow * 136 + lch * 16) = (u32x2){vreg.x, vreg.y}; *(LAS u32x2*)(Vs + lrow * 136 + lch * 16 + 8) = (u32x2){vreg.z, vreg.w};
        __syncthreads();
        if (t + 1 < NT) { kreg = *(const v4u*)(kg + (size_t)(t + 1) * 64 * 256); vreg = *(const v4u*)(vg + (t + 1) * 64); }
        if (64 * t <= qw0 + 31) {
            f32x16 p0, p1;
#pragma unroll
            for (int r = 0; r < 16; ++r) { p0[r] = 0.f; p1[r] = 0.f; }
#pragma unroll
            for (int d0 = 0; d0 < 4; ++d0) {
                const bf16x8 kf0 = *(const LAS bf16x8*)(Ks + r32 * 144 + d0 * 32 + hi * 16), kf1 = *(const LAS bf16x8*)(Ks + (r32 + 32) * 144 + d0 * 32 + hi * 16);
                p0 = __builtin_amdgcn_mfma_f32_32x32x16_bf16(kf0, qr[d0], p0, 0, 0, 0);
                p1 = __builtin_amdgcn_mfma_f32_32x32x16_bf16(kf1, qr[d0], p1, 0, 0, 0);
            }
            if (MODE == 0) {
#pragma unroll
                for (int j = 0; j < 4; ++j) { const f32x4 b0 = *(const f32x4*)(fbh + 64 * t + 8 * j + 4 * hi), b1 = *(const f32x4*)(fbh + 64 * t + 32 + 8 * j + 4 * hi);
#pragma unroll
                    for (int e = 0; e < 4; ++e) { p0[4 * j + e] += b0[e]; p1[4 * j + e] += b1[e]; } }
            } else {
                const unsigned long long word = MT[((size_t)b * 64 + t) * T + qabs];
                const unsigned wlo = (unsigned)word, whi = (unsigned)(word >> 32);
#pragma unroll
                for (int r = 0; r < 16; ++r) { const int kv = crow(r, hi); if (!((wlo >> kv) & 1u)) p0[r] = NEGBIG; if (!((whi >> kv) & 1u)) p1[r] = NEGBIG; }
            }
            if (64 * t + 63 > qw0) {
#pragma unroll
                for (int r = 0; r < 16; ++r) { const int kv = 64 * t + crow(r, hi); if (kv > qabs) p0[r] = NEGBIG; if (kv + 32 > qabs) p1[r] = NEGBIG; }
            }
            float mx = p0[0];
#pragma unroll
            for (int r = 1; r < 16; ++r) mx = fmaxf(mx, p0[r]);
#pragma unroll
            for (int r = 0; r < 16; ++r) mx = fmaxf(mx, p1[r]);
            mx = half_max(mx);
            const float m_new = fmaxf(m_run, mx); const float f = __builtin_amdgcn_exp2f(m_run - m_new); m_run = m_new;
            float rs = 0.f;
#pragma unroll
            for (int r = 0; r < 16; ++r) { p0[r] = __builtin_amdgcn_exp2f(p0[r] - m_new); p1[r] = __builtin_amdgcn_exp2f(p1[r] - m_new); rs += p0[r] + p1[r]; }
            l_run = l_run * f + rs;
            if (hi == 0) wsf[r32] = f;
            __builtin_amdgcn_wave_barrier(); LDS_WAIT();
#pragma unroll
            for (int r = 0; r < 16; ++r) { const float fr_ = wsf[crow(r, hi)]; o0[r] *= fr_; o1[r] *= fr_; }
            __builtin_amdgcn_wave_barrier();
            u32x4 pw[4];
            pw[0] = (u32x4){pk2(p0[0], p0[1]), pk2(p0[2], p0[3]), pk2(p0[4], p0[5]), pk2(p0[6], p0[7])};
            pw[1] = (u32x4){pk2(p0[8], p0[9]), pk2(p0[10], p0[11]), pk2(p0[12], p0[13]), pk2(p0[14], p0[15])};
            pw[2] = (u32x4){pk2(p1[0], p1[1]), pk2(p1[2], p1[3]), pk2(p1[4], p1[5]), pk2(p1[6], p1[7])};
            pw[3] = (u32x4){pk2(p1[8], p1[9]), pk2(p1[10], p1[11]), pk2(p1[12], p1[13]), pk2(p1[14], p1[15])};
#pragma unroll
            for (int k = 0; k < 4; ++k) {
                const bf16x8 pa = __builtin_bit_cast(bf16x8, pw[k]);
                { const LAS unsigned char* vp = Vs + r32 * 136 + (16 * k + 4 * hi) * 2; const u32x2 lo = *(const LAS u32x2*)vp, h2 = *(const LAS u32x2*)(vp + 16);
                  const bf16x8 vb = __builtin_bit_cast(bf16x8, (u32x4){lo.x, lo.y, h2.x, h2.y}); o0 = __builtin_amdgcn_mfma_f32_32x32x16_bf16(pa, vb, o0, 0, 0, 0); }
                { const LAS unsigned char* vp = Vs + (r32 + 32) * 136 + (16 * k + 4 * hi) * 2; const u32x2 lo = *(const LAS u32x2*)vp, h2 = *(const LAS u32x2*)(vp + 16);
                  const bf16x8 vb = __builtin_bit_cast(bf16x8, (u32x4){lo.x, lo.y, h2.x, h2.y}); o1 = __builtin_amdgcn_mfma_f32_32x32x16_bf16(pa, vb, o1, 0, 0, 0); }
            }
        }
    }
    const float l_tot = half_sum(l_run);
    __builtin_amdgcn_wave_barrier();
    if (hi == 0) wsf[r32] = 1.f / l_tot;
    __builtin_amdgcn_wave_barrier(); LDS_WAIT();
#pragma unroll
    for (int r = 0; r < 16; ++r) { const int qr_ = crow(r, hi); const float rl = wsf[qr_];
        bf16* yp = Y + (rowbase + qw0 + qr_) * 1024 + ycol + hh * 64 + r32;
        float y0 = o0[r] * rl, y1 = o1[r] * rl; if (DBG_ZERO & (MODE == 0 ? 8 : 2)) { y0 = 0.f; y1 = 0.f; }
        yp[0] = (bf16)f2bf(y0); yp[32] = (bf16)f2bf(y1); }
    __builtin_amdgcn_wave_barrier();
}

__device__ __forceinline__ void load_args(Args& A) {
#if defined(__HIP_DEVICE_COMPILE__)
    const __attribute__((address_space(4))) unsigned long long* p = (const __attribute__((address_space(4))) unsigned long long*)__builtin_amdgcn_kernarg_segment_ptr();
    asm volatile("" : "+s"(p));
    unsigned long long* d = (unsigned long long*)&A;
#pragma unroll
    for (int i = 0; i < (int)(sizeof(Args) / 8); ++i) d[i] = p[i];
#endif
}
#ifndef MK_MULTI
#define MK_MULTI 0
#endif
constexpr int NPH = 14;
constexpr int LDS_BYTES = 147456;
constexpr int RING_BYTES = 131072, MISC_OFF = RING_BYTES + 320;

template <int PLO, int PHI> __global__ void __launch_bounds__(NWAVES * 64, 2) mk_fwd(Args KA) {
    extern __shared__ __attribute__((aligned(16))) unsigned char lds_raw[];
    LAS unsigned char* lds = (LAS unsigned char*)lds_raw;
    volatile LAS unsigned* MISC = (volatile LAS unsigned*)(lds + MISC_OFF);
    for (int u = threadIdx.x; u < (LDS_BYTES - RING_BYTES) / 4; u += NWAVES * 64) ((LAS unsigned*)(lds + RING_BYTES))[u] = 0u;
    __syncthreads();
#if MK_MULTI
#define GRID_BAR() do { } while (0)
#else
    XcdBarrier bar = xcd_barrier_post((unsigned*)(KA.ws + WS_CTL) + CW_BAR, MISC + 8);
#define GRID_BAR() do { XcdBarrier b_ = bar; asm volatile("" : "+s"(b_.bar), "+s"(b_.x)); xcd_barrier(b_); } while (0)
#endif
#ifdef ONLY_PH
#define IN(k) ((k) == ONLY_PH && PLO <= (k) && (k) < PHI)
#else
#define IN(k) (PLO <= (k) && (k) < PHI)
#endif
#define PHASE_IDS() int tid = threadIdx.x, bx = blockIdx.x, G = gridDim.x; asm volatile("" : "+v"(tid), "+s"(bx), "+s"(G)); Args A; load_args(A); unsigned char* ws = A.ws; \
    const int lane = tid & 63, wave = __builtin_amdgcn_readfirstlane(tid >> 6); const int gw = bx * NWAVES + wave, NGW = G * NWAVES; bf16* XN = (bf16*)(ws + WS_XN); (void)lane; (void)gw; (void)NGW; (void)XN
    for (int l = KA.l_lo; l < KA.l_hi; ++l) {
        if (IN(0)) { PHASE_IDS();
            LAS float* scr = (LAS float*)(lds + wave * 16384);
            const float* gpre = A.in[1] + l * D; const float* gmlp = A.in[3] + l * D;
            const float* win = A.in[5] + (size_t)l * D * IN_COLS; const float* wbr = A.in[6] + (size_t)l * 4 * 256 * 1024; const float* wout = A.in[7] + (size_t)l * D * D;
            const float* wup = A.in[25] + (size_t)l * D * FF; const float* wdn = A.in[26] + (size_t)l * FF * D;
            constexpr int I_IN = 16 * 120, I_G = 16 * 128, I_B = 4 * 32, I_O = 16 * 32, I_UP = 16 * 128, I_DN = 64 * 32;
            constexpr int NIT = I_IN + I_G + 4 * I_B + I_O + I_UP + I_DN;
            for (int it = gw; it < NIT; it += NGW) {
                int r = it;
                if (r < I_IN) { wt_item(win, IN_COLS, 1, 0, gpre, (bf16*)(ws + WS_WIN), D, r / 120, r % 120, scr, lane); continue; } r -= I_IN;
                if (r < I_G) { wt_item(win, IN_COLS, 0, 3756, gpre, (bf16*)(ws + WS_WG), D, r / 128, r % 128, scr, lane); continue; } r -= I_G;
                if (r < 4 * I_B) { const int n = r / I_B, q = r % I_B; wt_item(wbr + (size_t)n * 256 * 1024, 1024, 0, 0, nullptr, (bf16*)(ws + WS_WB) + (size_t)n * 1024 * 256, 256, q / 32, q % 32, scr, lane); continue; } r -= 4 * I_B;
                if (r < I_O) { wt_item(wout, D, 0, 0, nullptr, (bf16*)(ws + WS_WO), D, r / 32, r % 32, scr, lane); continue; } r -= I_O;
                if (r < I_UP) { wt_item(wup, FF, 0, 0, gmlp, (bf16*)(ws + WS_WUP), D, r / 128, r % 128, scr, lane); continue; } r -= I_UP;
                wt_item(wdn, D, 0, 0, nullptr, (bf16*)(ws + WS_WDN), FF, r / 32, r % 32, scr, lane);
            }
            if (l == 0) for (int m = gw; m < M; m += NGW) rms_row_to_bf16(A.in[0] + (size_t)m * D, XN + (size_t)m * D, lane);
            GRID_BAR();
        }
        if (IN(1)) { PHASE_IDS();
            pg8::Gemm g{XN, (const bf16*)(ws + WS_WIN), M, PP, D, D, D, 0, 0}; pg8::StaticOrder S; S.init(M, PP, G, bx);
            pg8::EpiIn E{(bf16*)(ws + WS_P), (float*)(ws + WS_SMALL)};
            pg8::gemm_phase<pg8::EpiIn, pg8::StaticOrder, true, true>(lds, g, S, E, tid);
            GRID_BAR();
        }
        if (IN(2)) { PHASE_IDS();
            for (int m = gw; m < M; m += NGW) prep_token(A, ws, l, m, lane);
            for (int it = gw; it < 2048; it += NGW) prep_vt(ws, it, lds + wave * 8448, lane);
            __syncthreads();
            prep_rwkv(A, ws, l, lds, tid, bx, G);
            GRID_BAR();
        }
        if (IN(3)) { PHASE_IDS();
            if (wave == 0) {
                if (bx < 16) rwkv_scan_wave(A, ws, l, bx, lane);
                else if (bx < 32) hgrn_scan_wave(A, ws, l, bx - 16, lane);
                else if (bx < 48) fox_cumsum_wave(ws, bx - 32, lane);
            }
            GRID_BAR();
        }
        if (IN(4)) { PHASE_IDS();
            for (int u = gw; u < 4096; u += NGW) dsa_scores_unit(ws, u, lane);
            GRID_BAR();
        }
        if (IN(5)) { PHASE_IDS();
            for (int row = gw; row < M; row += NGW) dsa_select_row(ws, row, lane);
            GRID_BAR();
        }
        if (IN(6)) { PHASE_IDS();
            for (int u = bx; u < 256; u += G) {
                const int bh = u >> 4, s = u & 15;
                attn_unit<0>(lds, bh >> 2, bh & 3, s, (const bf16*)(ws + WS_DQ), (const bf16*)(ws + WS_DK), (const bf16*)(ws + WS_DVT), (const float*)(ws + WS_FB), nullptr, (bf16*)(ws + WS_Y), 768, tid);
                attn_unit<1>(lds, bh >> 2, bh & 3, 15 - s, (const bf16*)(ws + WS_BQ), (const bf16*)(ws + WS_BK), (const bf16*)(ws + WS_BVT), (const float*)(ws + WS_FB), (const unsigned long long*)(ws + WS_MASK), (bf16*)(ws + WS_Y), 256, tid);
            }
            __syncthreads();
            if (DBG_MERGE == 5) { const float* xs = (l == 0) ? A.in[0] : A.out; for (int m = gw; m < M; m += NGW) rms_row_to_bf16(xs + (size_t)m * D, XN + (size_t)m * D, lane); }
            GRID_BAR();
        }
        if (IN(7)) { PHASE_IDS();
            pg8::Gemm g{XN, (const bf16*)(ws + (DBG_MERGE == 4 ? WS_WUP : WS_WG)), M, NG, D, D, D, 0, 0}; pg8::StaticOrder S; S.init(M, NG, G, bx);
            pg8::EpiAct<0> E{(bf16*)(ws + WS_G), NG};
            pg8::gemm_phase<pg8::EpiAct<0>, pg8::StaticOrder, true, true>(lds, g, S, E, tid);
            GRID_BAR();
        }
        if (IN(8)) { PHASE_IDS();
            int kmerge = 256; asm volatile("" : "+s"(kmerge));
            pg8::Gemm g{(const bf16*)(ws + WS_Y), (const bf16*)(ws + WS_WB), M, 4096, kmerge, 1024, 256, 4, 512}; pg8::MergeOrder S{G, bx};
            pg8::EpiMerge E{(const bf16*)(ws + WS_G), (bf16*)(ws + WS_Z)};
            pg8::gemm_phase<pg8::EpiMerge, pg8::MergeOrder, true, true>(lds, g, S, E, tid);
            GRID_BAR();
        }
        if (IN(9)) { PHASE_IDS();
            pg8::Gemm g{(const bf16*)(ws + WS_Z), (const bf16*)(ws + WS_WO), M, D, D, D, D, 0, 0}; pg8::StaticOrder S; S.init(M, D, G, bx);
            pg8::EpiF32 E{(float*)(ws + WS_MIX), D};
            pg8::gemm_phase<pg8::EpiF32, pg8::StaticOrder, true, true>(lds, g, S, E, tid);
            GRID_BAR();
        }
        if (IN(10)) { PHASE_IDS();
            const float* xold = (l == 0) ? A.in[0] : A.out;
            for (int m = gw; m < M; m += NGW) post_row((const float*)(ws + WS_MIX) + (size_t)m * D, xold + (size_t)m * D, A.in[2] + l * D, A.out + (size_t)m * D, XN + (size_t)m * D, lane);
            GRID_BAR();
        }
        if (IN(11)) { PHASE_IDS();
            pg8::Gemm g{XN, (const bf16*)(ws + WS_WUP), M, FF, D, D, D, 0, 0}; pg8::StaticOrder S; S.init(M, FF, G, bx);
            pg8::EpiAct<1> E{(bf16*)(ws + WS_U), FF};
            pg8::gemm_phase<pg8::EpiAct<1>, pg8::StaticOrder, true, true>(lds, g, S, E, tid);
            GRID_BAR();
        }
        if (IN(12)) { PHASE_IDS();
            pg8::Gemm g{(const bf16*)(ws + WS_U), (const bf16*)(ws + WS_WDN), M, D, FF, FF, FF, 0, 0}; pg8::StaticOrder S; S.init(M, D, G, bx);
            pg8::EpiF32 E{(float*)(ws + WS_MIX), D};
            pg8::gemm_phase<pg8::EpiF32, pg8::StaticOrder, true, true>(lds, g, S, E, tid);
            GRID_BAR();
        }
        if (IN(13)) { PHASE_IDS();
            for (int m = gw; m < M; m += NGW) post_row((const float*)(ws + WS_MIX) + (size_t)m * D, A.out + (size_t)m * D, A.in[4] + l * D, A.out + (size_t)m * D, (l + 1 < DEPTH) ? XN + (size_t)m * D : nullptr, lane);
            GRID_BAR();
        }
    }
#undef IN
}

template <int PH> static void launch_ph(int grid, hipStream_t stream, const Args& a) { hipLaunchKernelGGL((mk_fwd<PH, PH + 1>), dim3(grid), dim3(NWAVES * 64), LDS_BYTES, stream, a); }
template <int PH> static void set_lds_ph() { (void)hipFuncSetAttribute((const void*)mk_fwd<PH, PH + 1>, hipFuncAttributeMaxDynamicSharedMemorySize, LDS_BYTES); }
extern "C" void kernel_launch(void* const* d_in, const int* in_sizes, int n_in, void* d_out, int out_size, void* d_ws, size_t ws_size, hipStream_t stream) {
    static int grid = 0;
    if (grid == 0) {
        if (n_in != 27 || out_size != M * D || ws_size < WS_END) { fprintf(stderr, "kernel_launch: unexpected shapes (n_in %d, out %d, ws %zu < %zu)\n", n_in, out_size, ws_size, (size_t)WS_END); grid = -1; return; }
        int dev = 0, cus = 0, per_cu = 0;
        if (hipGetDevice(&dev) != hipSuccess || hipDeviceGetAttribute(&cus, hipDeviceAttributeMultiprocessorCount, dev) != hipSuccess) { grid = -1; return; }
#if MK_MULTI
        set_lds_ph<0>(); set_lds_ph<1>(); set_lds_ph<2>(); set_lds_ph<3>(); set_lds_ph<4>(); set_lds_ph<5>(); set_lds_ph<6>(); set_lds_ph<7>(); set_lds_ph<8>(); set_lds_ph<9>(); set_lds_ph<10>(); set_lds_ph<11>(); set_lds_ph<12>(); set_lds_ph<13>();
#else
        if (hipFuncSetAttribute((const void*)mk_fwd<0, NPH>, hipFuncAttributeMaxDynamicSharedMemorySize, LDS_BYTES) != hipSuccess) { fprintf(stderr, "kernel_launch: hipFuncSetAttribute failed\n"); grid = -1; return; }
        if (hipOccupancyMaxActiveBlocksPerMultiprocessor(&per_cu, (const void*)mk_fwd<0, NPH>, NWAVES * 64, LDS_BYTES) != hipSuccess || per_cu < 1) fprintf(stderr, "kernel_launch: occupancy query reports %d\n", per_cu);
#endif
        (void)hipGetLastError();
        grid = cus;
    }
    if (grid < 0) return;
    if (hipMemsetAsync((char*)d_ws + WS_CTL, 0, CTL_ZERO_BYTES, stream) != hipSuccess) return;
    Args a{};
    for (int i = 0; i < 27; ++i) a.in[i] = (const float*)d_in[i];
    a.out = (float*)d_out; a.ws = (unsigned char*)d_ws;
#if MK_MULTI
    for (int l = 0; l < DEPTH; ++l) { a.l_lo = l; a.l_hi = l + 1;
        launch_ph<0>(grid, stream, a); launch_ph<1>(grid, stream, a); launch_ph<2>(grid, stream, a); launch_ph<3>(grid, stream, a); launch_ph<4>(grid, stream, a); launch_ph<5>(grid, stream, a); launch_ph<6>(grid, stream, a);
        launch_ph<7>(grid, stream, a); launch_ph<8>(grid, stream, a); launch_ph<9>(grid, stream, a); launch_ph<10>(grid, stream, a); launch_ph<11>(grid, stream, a); launch_ph<12>(grid, stream, a); launch_ph<13>(grid, stream, a); }
#else
    a.l_lo = 0; a.l_hi = DEPTH;
    hipLaunchKernelGGL((mk_fwd<0, NPH>), dim3(grid), dim3(NWAVES * 64), LDS_BYTES, stream, a);
#endif
}
```

```cpp
#include <hip/hip_runtime.h>
#include <cstdio>
#include <cstdint>
namespace pg8 {
#define PG8_LAS __attribute__((address_space(3)))
typedef unsigned short bf16_t;
typedef short bf16x8 __attribute__((ext_vector_type(8)));
typedef float f32x4 __attribute__((ext_vector_type(4)));
typedef unsigned u32x4 __attribute__((ext_vector_type(4)));
constexpr int BM = 256, BK = 64, HALF = 128, HTB = HALF * BK * 2  , STAGE_BYTES = 8 * HTB, NXCD = 8, WGM = 8;

__host__ __device__ __forceinline__ int lds_byte(int r, int c) { const int st = (r >> 4) * 2 + (c >> 5), rr = r & 15, cc = c & 31, ob = rr * 64 + cc * 2; return st * 1024 + (ob ^ (((ob >> 9) & 1) << 5)); }
__host__ __device__ __forceinline__ void stage_rc(int b, int& R, int& C) { const int st = b / 1024, sb = b % 1024, swz = sb ^ (((sb >> 9) & 1) << 5); R = (st >> 1) * 16 + swz / 64; C = (st & 1) * 32 + (swz % 64) / 2; }
__host__ __device__ __forceinline__ int perm32(int rho) { const int n = rho >> 4, i = rho & 15; return 8 * (i >> 2) + 4 * n + (i & 3); }

struct Unit { int pm, pn; };
struct Gemm { const bf16_t* A; const bf16_t* Bt; int M, N, K; int lda, ldb; int agrp, astep; };

struct StaticOrder {
    int nM, nN, nwg, G, c;
    __host__ __device__ void init(int M, int N, int G_, int c_) { nM = M / BM; nN = N / BM; nwg = nM * nN; G = G_; c = c_; }
    __host__ __device__ bool next(int i, Unit& u) const {
        const long L = (long)i * G + c; if (L >= nwg) return false;
        int wgid = (int)L; { const int q = nwg / NXCD, r = nwg % NXCD, xcd = wgid % NXCD, off = wgid / NXCD; wgid = (xcd < r ? xcd * (q + 1) : r * (q + 1) + (xcd - r) * q) + off; }
        const int nig = WGM * nN, gid = wgid / nig, fm = gid * WGM, gsz = (nM - fm) < WGM ? (nM - fm) : WGM;
        u.pm = fm + ((wgid % nig) % gsz); u.pn = (wgid % nig) / gsz; return true;
    }
    __device__ __forceinline__ void a_ready(const Unit&) const {}
    __device__ __forceinline__ void done(const Unit&) const {}
};

typedef float cvt_f32x2_t __attribute__((ext_vector_type(2))); typedef __bf16 cvt_bf16x2_t __attribute__((ext_vector_type(2)));
__device__ __forceinline__ unsigned cvt_pk_bf16(float lo, float hi) { cvt_f32x2_t v = {lo, hi}; cvt_bf16x2_t b = __builtin_convertvector(v, cvt_bf16x2_t); return __builtin_bit_cast(unsigned, b); }
typedef float f32x2 __attribute__((ext_vector_type(2)));
__device__ __forceinline__ f32x2 gelu_pk(f32x2 v) {
    const f32x2 av = __builtin_elementwise_abs(v), d = av * 0.2316418882f + 1.0f;
    f32x2 t; t.x = __builtin_amdgcn_rcpf(d.x); t.y = __builtin_amdgcn_rcpf(d.y);
    f32x2 q = t * 0.5307027145f + (-0.7265760135f); q = q * t + 0.7107068705f; q = q * t + (-0.142248368f); q = q * t + 0.127414796f; q = q * t;
    const f32x2 s = (v * v) * (-0.72134752044f);
    f32x2 e; e.x = __builtin_amdgcn_exp2f(s.x); e.y = __builtin_amdgcn_exp2f(s.y);
    const f32x2 m = v * (q * e), r = v - m;
    f32x2 o; o.x = v.x < 0.f ? m.x : r.x; o.y = v.y < 0.f ? m.y : r.y; return o;
}

template <int ACT  > struct EpiBf16 {
    static constexpr bool PERM = true, AFTER_DRAIN = false; static_assert(ACT == 0 || ACT == 1, "EpiBf16: ACT is 0 (none) or 1 (gelu_pk)");
    bf16_t* O; int ldc; const float* bias; int split_cols; size_t split_stride; float scale0;
    __device__ __forceinline__ void operator()(const f32x4 (&acc)[2][2][4][2], const Unit& u, int wr, int wc, int fr, int fq) const {
        const int row0 = u.pm * BM + wr * 64 + fr; int colt = u.pn * BM; bf16_t* base = O;
        float sc = 1.f; if (split_cols) { const int t = colt / split_cols; base += (size_t)t * split_stride; colt -= t * split_cols; if (t == 0) sc = scale0; }
        const int col0 = colt + wc * 32 + 8 * fq, bcol0 = u.pn * BM + wc * 32 + 8 * fq;
        f32x4 bv[2][2];
#pragma unroll
        for (int bj = 0; bj < 2; ++bj)
#pragma unroll
            for (int n = 0; n < 2; ++n) bv[bj][n] = bias ? *(const f32x4*)(bias + bcol0 + bj * HALF + 4 * n) : (f32x4){0.f, 0.f, 0.f, 0.f};
#pragma unroll
        for (int ai = 0; ai < 2; ++ai)
#pragma unroll
            for (int m = 0; m < 4; ++m) { bf16_t* rowp = base + (size_t)(row0 + ai * HALF + m * 16) * ldc + col0;
#pragma unroll
                for (int bj = 0; bj < 2; ++bj) { f32x4 v0 = acc[ai][bj][m][0] + bv[bj][0], v1 = acc[ai][bj][m][1] + bv[bj][1];
                    if (ACT == 1) { f32x2 a = gelu_pk((f32x2){v0[0], v0[1]}), b = gelu_pk((f32x2){v0[2], v0[3]}), c = gelu_pk((f32x2){v1[0], v1[1]}), d = gelu_pk((f32x2){v1[2], v1[3]});
                        v0 = (f32x4){a.x, a.y, b.x, b.y}; v1 = (f32x4){c.x, c.y, d.x, d.y}; }
                    v0 = v0 * sc; v1 = v1 * sc; u32x4 w; w.x = cvt_pk_bf16(v0[0], v0[1]); w.y = cvt_pk_bf16(v0[2], v0[3]); w.z = cvt_pk_bf16(v1[0], v1[1]); w.w = cvt_pk_bf16(v1[2], v1[3]);
                    *(u32x4*)(rowp + bj * HALF) = w; } }
    }
};

template <class Epi, class Sched, bool ALIGN_EPI = false, bool SP2 = false>
__device__ __forceinline__ void gemm_phase(PG8_LAS unsigned char* lds, const Gemm g, const Sched& S, const Epi& E, const int tid) {
    const int wid = __builtin_amdgcn_readfirstlane(tid >> 6), lane = tid & 63, wr = wid >> 2, wc = wid & 3, fr = lane & 15, fq = lane >> 4;
    const int K = g.K, nt = K / BK;
    unsigned voffA[2], voffB[2];
#pragma unroll
    for (int i = 0; i < 2; ++i) { int R, C; stage_rc(tid * 16 + i * 8192, R, C); const int Rb = Epi::PERM ? ((R & ~31) + perm32(R & 31)) : R;
        voffA[i] = (unsigned)(R * g.lda + C) * 2u; voffB[i] = (unsigned)(Rb * g.ldb + C) * 2u; }
    const size_t kstep = (size_t)(BK * 2);
    const size_t hstepA = (size_t)HALF * g.lda * 2, hstepB = (size_t)HALF * g.ldb * 2;
    const size_t tstepA = 2 * hstepA, tstepB = 2 * hstepB;
    const unsigned ldsw = (unsigned)wid * 1024u;
    const int aoff = lds_byte(wr * 64 + fr, fq * 8), boff = lds_byte(wc * 32 + fr, fq * 8);
#define PG8_SA(b, h) (((b) * 2 + (h)) * HTB)
#define PG8_SB(b, h) ((4 + (b) * 2 + (h)) * HTB)
#define PG8_STAGE(bufoff, gbase, voff) do { _Pragma("unroll") for (int _i = 0; _i < 2; ++_i) \
        __builtin_amdgcn_global_load_lds((const unsigned*)((const char*)(gbase) + (voff)[_i]), (PG8_LAS unsigned*)(lds + (bufoff) + ldsw + _i * 8192), 16, 0, 0); } while (0)
#define PG8_LDA(dst, b, h) do { _Pragma("unroll") for (int m = 0; m < 4; ++m) _Pragma("unroll") for (int k = 0; k < 2; ++k) dst[m][k] = *(const PG8_LAS bf16x8*)(lds + PG8_SA(b, h) + aoff + m * 2048 + k * 1024); } while (0)
#define PG8_LDB(dst, b, h) do { _Pragma("unroll") for (int n = 0; n < 2; ++n) _Pragma("unroll") for (int k = 0; k < 2; ++k) dst[n][k] = *(const PG8_LAS bf16x8*)(lds + PG8_SB(b, h) + boff + n * 2048 + k * 1024); } while (0)
#define PG8_MMA(ai, bj, At, Bt) do { __builtin_amdgcn_s_setprio(1); _Pragma("unroll") for (int m = 0; m < 4; ++m) _Pragma("unroll") for (int n = 0; n < 2; ++n) _Pragma("unroll") for (int k = 0; k < 2; ++k) \
        acc[ai][bj][m][n] = __builtin_amdgcn_mfma_f32_16x16x32_bf16(Bt[n][k], At[m][k], acc[ai][bj][m][n], 0, 0, 0); __builtin_amdgcn_s_setprio(0); } while (0)
#define PG8_WAIT_V(n) asm volatile("s_waitcnt vmcnt(" #n ")" ::: "memory")
#define PG8_WAIT_L(n) asm volatile("s_waitcnt lgkmcnt(" #n ")" ::: "memory")
#define PG8_BAR __builtin_amdgcn_s_barrier()
#define PG8_SCHED __builtin_amdgcn_sched_barrier(0)
    Unit cur, nxt; int ui = 0;
    if (!S.next(0, cur)) return;
    f32x4 acc[2][2][4][2];
#pragma unroll
    for (int a = 0; a < 2; ++a)
#pragma unroll
        for (int b = 0; b < 2; ++b)
#pragma unroll
            for (int m = 0; m < 4; ++m)
#pragma unroll
                for (int n = 0; n < 2; ++n) acc[a][b][m][n] = (f32x4){0.f, 0.f, 0.f, 0.f};
    bf16x8 At[4][2], B0[2][2], B1[2][2];
    const char* cA = (const char*)g.A + (size_t)cur.pm * tstepA + (g.agrp ? (size_t)(cur.pn / g.agrp) * g.astep : (size_t)0); const char* cB = (const char*)g.Bt + (size_t)cur.pn * tstepB;
    S.a_ready(cur);
    if constexpr (SP2) {
        PG8_STAGE(PG8_SB(0, 0), cB, voffB); PG8_STAGE(PG8_SB(0, 1), cB + hstepB, voffB); PG8_STAGE(PG8_SA(0, 0), cA, voffA); PG8_STAGE(PG8_SA(0, 1), cA + hstepA, voffA);
        if (wr == 1) PG8_BAR;
        PG8_WAIT_V(2); PG8_BAR;
        PG8_STAGE(PG8_SB(1, 0), cB + kstep, voffB); PG8_STAGE(PG8_SA(1, 0), cA + kstep, voffA); PG8_STAGE(PG8_SB(1, 1), cB + hstepB + kstep, voffB);
        PG8_WAIT_V(6); PG8_BAR;
    } else {
        PG8_STAGE(PG8_SB(0, 0), cB, voffB); PG8_STAGE(PG8_SA(0, 0), cA, voffA); PG8_STAGE(PG8_SB(0, 1), cB + hstepB, voffB); PG8_STAGE(PG8_SA(0, 1), cA + hstepA, voffA);
        if (wr == 1) PG8_BAR;
        PG8_WAIT_V(4); PG8_BAR;
        PG8_STAGE(PG8_SB(1, 0), cB + kstep, voffB); PG8_STAGE(PG8_SA(1, 0), cA + kstep, voffA); PG8_STAGE(PG8_SB(1, 1), cB + hstepB + kstep, voffB);
        PG8_WAIT_V(6); PG8_BAR;
    }
    for (;;) {
        const bool has_next = S.next(ui + 1, nxt);
        const char* nA = has_next ? (const char*)g.A + (size_t)nxt.pm * tstepA + (g.agrp ? (size_t)(nxt.pn / g.agrp) * g.astep : (size_t)0) : cA; const char* nB = has_next ? (const char*)g.Bt + (size_t)nxt.pn * tstepB : cB;
        for (int t = 0; t < nt; t += 2) {
            const bool last = (t == nt - 2);
            const char* a1 = cA + (size_t)(t + 1) * kstep;
            const char* a2 = last ? nA : cA + (size_t)(t + 2) * kstep; const char* b2 = last ? nB : cB + (size_t)(t + 2) * kstep;
            const char* a3 = a2 + kstep; const char* b3 = b2 + kstep;
            if (last && has_next) S.a_ready(nxt);
            if constexpr (SP2) {
            PG8_LDB(B0, 0, 0); PG8_LDB(B1, 0, 1); PG8_SCHED; PG8_LDA(At, 0, 0); PG8_STAGE(PG8_SA(1, 1), a1 + hstepA, voffA);
            PG8_WAIT_V(8); PG8_WAIT_L(0); PG8_BAR; PG8_MMA(0, 0, At, B0); PG8_MMA(0, 1, At, B1); PG8_BAR; PG8_SCHED;
            PG8_LDA(At, 0, 1); PG8_STAGE(PG8_SB(0, 0), b2, voffB); PG8_STAGE(PG8_SB(0, 1), b2 + hstepB, voffB); PG8_STAGE(PG8_SA(0, 0), a2, voffA);
            PG8_WAIT_V(8); PG8_WAIT_L(0); PG8_BAR; PG8_MMA(1, 0, At, B0); PG8_MMA(1, 1, At, B1); PG8_BAR; PG8_SCHED;
            PG8_LDB(B0, 1, 0); PG8_LDB(B1, 1, 1); PG8_SCHED; PG8_LDA(At, 1, 0); PG8_STAGE(PG8_SA(0, 1), a2 + hstepA, voffA);
            PG8_WAIT_V(8); PG8_WAIT_L(0); PG8_BAR; PG8_MMA(0, 0, At, B0); PG8_MMA(0, 1, At, B1); PG8_BAR; PG8_SCHED;
            PG8_LDA(At, 1, 1); PG8_STAGE(PG8_SB(1, 0), b3, voffB); PG8_STAGE(PG8_SB(1, 1), b3 + hstepB, voffB); PG8_STAGE(PG8_SA(1, 0), a3, voffA);
            PG8_WAIT_V(8); PG8_WAIT_L(0); PG8_BAR; PG8_MMA(1, 0, At, B0); PG8_MMA(1, 1, At, B1); PG8_BAR; PG8_SCHED;
            } else {
            PG8_LDB(B0, 0, 0); PG8_SCHED; PG8_LDA(At, 0, 0); PG8_STAGE(PG8_SA(1, 1), a1 + hstepA, voffA);
            PG8_WAIT_L(8); PG8_BAR; PG8_WAIT_L(0); PG8_MMA(0, 0, At, B0); PG8_BAR; PG8_SCHED;
            PG8_LDB(B1, 0, 1); PG8_STAGE(PG8_SB(0, 0), b2, voffB);
            PG8_BAR; PG8_WAIT_L(0); PG8_MMA(0, 1, At, B1); PG8_BAR;
            PG8_LDA(At, 0, 1); PG8_STAGE(PG8_SA(0, 0), a2, voffA);
            PG8_BAR; PG8_WAIT_L(0); PG8_MMA(1, 0, At, B0); PG8_BAR; PG8_SCHED;
            PG8_STAGE(PG8_SB(0, 1), b2 + hstepB, voffB);
            PG8_WAIT_V(6); PG8_BAR; PG8_MMA(1, 1, At, B1); PG8_BAR;
            PG8_LDB(B0, 1, 0); PG8_SCHED; PG8_LDA(At, 1, 0); PG8_STAGE(PG8_SA(0, 1), a2 + hstepA, voffA);
            PG8_WAIT_L(8); PG8_BAR; PG8_WAIT_L(0); PG8_MMA(0, 0, At, B0); PG8_BAR; PG8_SCHED;
            PG8_LDB(B1, 1, 1); PG8_STAGE(PG8_SB(1, 0), b3, voffB);
            PG8_BAR; PG8_WAIT_L(0); PG8_MMA(0, 1, At, B1); PG8_BAR;
            PG8_LDA(At, 1, 1); PG8_STAGE(PG8_SA(1, 0), a3, voffA);
            PG8_BAR; PG8_WAIT_L(0); PG8_MMA(1, 0, At, B0); PG8_BAR; PG8_SCHED;
            PG8_STAGE(PG8_SB(1, 1), b3 + hstepB, voffB);
            PG8_WAIT_V(6); PG8_BAR; PG8_MMA(1, 1, At, B1); PG8_BAR;
            }
        }
        if constexpr (ALIGN_EPI) { if (wr == 0) PG8_BAR; }
        if constexpr (!Epi::AFTER_DRAIN) { E(acc, cur, wr, wc, fr, fq); S.done(cur); }
        if (!has_next) break;
#pragma unroll
        for (int a = 0; a < 2; ++a)
#pragma unroll
            for (int b = 0; b < 2; ++b)
#pragma unroll
                for (int m = 0; m < 4; ++m)
#pragma unroll
                    for (int n = 0; n < 2; ++n) acc[a][b][m][n] = (f32x4){0.f, 0.f, 0.f, 0.f};
        cur = nxt; cA = nA; cB = nB; ++ui;
        if constexpr (ALIGN_EPI) { if (wr == 1) PG8_BAR; }
    }
    PG8_WAIT_V(0);
    if constexpr (!ALIGN_EPI) { if (wr == 0) PG8_BAR; }
    PG8_BAR;
    if constexpr (Epi::AFTER_DRAIN) { E.fused(acc, cur, wr, wc, fr, fq, lds, wid, lane); S.done(cur); }
#undef PG8_SA
#undef PG8_SB
#undef PG8_STAGE
#undef PG8_LDA
#undef PG8_LDB
#undef PG8_MMA
#undef PG8_WAIT_V
#undef PG8_WAIT_L
#undef PG8_BAR
#undef PG8_SCHED
}
}
#define GAS __attribute__((address_space(1)))
#define LAS __attribute__((address_space(3)))
typedef unsigned short bf16;
typedef unsigned v4u __attribute__((ext_vector_type(4)));
typedef float f32x4 __attribute__((ext_vector_type(4)));
typedef short bf16x8 __attribute__((ext_vector_type(8)));
typedef GAS unsigned gu32;
typedef GAS unsigned long long gu64;
#define RLX_AGENT __ATOMIC_RELAXED, __HIP_MEMORY_SCOPE_AGENT
#define LDS_WAIT() asm volatile("s_waitcnt lgkmcnt(0)" ::: "memory")
#define VM_WAIT() asm volatile("s_waitcnt vmcnt(0)" ::: "memory")
__device__ __forceinline__ unsigned long long rt() { return __builtin_amdgcn_s_memrealtime(); }
__device__ __forceinline__ unsigned f2bf(float f) { unsigned u = __builtin_bit_cast(unsigned, f); return (u + 0x7fffu + ((u >> 16) & 1u)) >> 16; }
__device__ __forceinline__ unsigned pk2(float lo, float hi) { return pg8::cvt_pk_bf16(lo, hi); }

#define XB_TMO      128
#define XB_XCNT(j)  (256  + 64 * (j))
#define XB_XSUB(j)  (1280 + 64 * (j))
#define XB_XGEN(j)  (2304 + 64 * (j))
#define XB_TOP      3328
#define XB_TOPGEN   3392
#define XCD_BAR_WORDS 3456
#define XB_SPIN_CAP (1u << 18)

__device__ __forceinline__ unsigned xb_ld(unsigned* p)              { return __hip_atomic_load(p, __ATOMIC_RELAXED, __HIP_MEMORY_SCOPE_AGENT); }
__device__ __forceinline__ unsigned xb_add(unsigned* p, unsigned v) { return __hip_atomic_fetch_add(p, v, __ATOMIC_RELAXED, __HIP_MEMORY_SCOPE_AGENT); }
__device__ __forceinline__ unsigned xb_xcc_id() { return (unsigned)__builtin_amdgcn_s_getreg((3 << 11) | 20) & 0xFu; }
#define XB_SPIN(cond, bar) do { unsigned _sp = 0; while (cond) { __builtin_amdgcn_s_sleep(1); \
    if ((++_sp & 255u) == 0u) { if (xb_ld(&(bar)[XB_TMO])) break; if (_sp > XB_SPIN_CAP) { atomicAdd(&(bar)[XB_TMO], 1u); break; } } } } while (0)

struct XcdBarrier {
    unsigned* bar; unsigned x;
    volatile LAS unsigned* st;
};

__device__ __forceinline__ XcdBarrier xcd_barrier_post(unsigned* bar, volatile LAS unsigned* st) {
    XcdBarrier b; b.bar = bar; b.x = xb_xcc_id(); b.st = st;
    if (threadIdx.x == 0) (void)xb_add(&bar[XB_XCNT(b.x)], 1u);
    return b;
}
__device__ __forceinline__ void xcd_barrier_complete(unsigned* bar, unsigned x, unsigned& nloc, unsigned& nx) {
    const unsigned G = gridDim.x * gridDim.y * gridDim.z;
    unsigned sum, cnt, mine, sp = 0u;
    for (;;) {
        sum = 0u; cnt = 0u; mine = 0u;
#pragma unroll
        for (unsigned j = 0; j < 16; ++j) { const unsigned c = xb_ld(&bar[XB_XCNT(j)]); sum += c; cnt += (c > 0u) ? 1u : 0u; mine = (j == x) ? c : mine; }
        if (sum == G) break;
        __builtin_amdgcn_s_sleep(1);
        if ((++sp & 255u) == 0u) { if (xb_ld(&bar[XB_TMO])) break; if (sp > XB_SPIN_CAP) { atomicAdd(&bar[XB_TMO], 1u); break; } }
    }
    nloc = mine > 0u ? mine : 1u; nx = cnt > 0u ? cnt : 1u;
}

__device__ __forceinline__ void xcd_barrier(const XcdBarrier& b) {
    asm volatile("s_waitcnt vmcnt(0)" ::: "memory");
    __syncthreads();
    if (threadIdx.x == 0) {
        unsigned* bar = b.bar;
        __builtin_amdgcn_s_waitcnt(0);
        unsigned nloc = b.st[0], nx = b.st[1];
        if (nloc == 0u) { xcd_barrier_complete(bar, b.x, nloc, nx); b.st[0] = nloc; b.st[1] = nx; }
        const unsigned old = xb_add(&bar[XB_XSUB(b.x)], 1u);
        const unsigned gen = old / nloc;
        if (old + 1u == (gen + 1u) * nloc) {
            __builtin_amdgcn_fence(__ATOMIC_RELEASE, "agent");
            asm volatile("s_waitcnt vmcnt(0)" ::: "memory");
            const unsigned og = xb_add(&bar[XB_TOP], 1u);
            const unsigned tg = og / nx;
            if (og + 1u == (tg + 1u) * nx) xb_add(&bar[XB_TOPGEN], 1u);
            else XB_SPIN(xb_ld(&bar[XB_TOPGEN]) == tg, bar);
            __builtin_amdgcn_fence(__ATOMIC_ACQUIRE, "agent");
            xb_add(&bar[XB_XGEN(b.x)], 1u);
            asm volatile("s_waitcnt vmcnt(0)" ::: "memory");
        } else {
            XB_SPIN(xb_ld(&bar[XB_XGEN(b.x)]) == gen, bar);
            __builtin_amdgcn_fence(__ATOMIC_ACQUIRE, "agent");
            asm volatile("s_waitcnt vmcnt(0)" ::: "memory");
        }
    }
    __syncthreads();
}

constexpr int T_ = 4096;
constexpr int NB = 4, T = 4096, D = 1024, M = NB * T, NH = 4, HD = 64, BW = 256, FF = 4096, DEPTH = 4;
constexpr int IN_COLS = 7852, PP = 3840, NG = 4096;
constexpr int NWAVES = 8;
#ifndef DBG_MERGE
#define DBG_MERGE 0
#endif
#ifndef DBG_ZERO
#define DBG_ZERO 0
#endif
constexpr float C2 = 0.125f * 1.4426950408889634f;
constexpr float LOG2E = 1.4426950408889634f;
constexpr float NEGBIG = -30000.f;
typedef float f32x16 __attribute__((ext_vector_type(16)));
typedef float f32x2 __attribute__((ext_vector_type(2)));
typedef unsigned u32x2 __attribute__((ext_vector_type(2)));
typedef unsigned u32x4 __attribute__((ext_vector_type(4)));
typedef const __attribute__((address_space(4))) f32x2* c4f2;
typedef const __attribute__((address_space(4))) unsigned* c4u;
typedef const __attribute__((address_space(4))) float* c4f;

constexpr size_t MiB = 1u << 20;
constexpr size_t WS_CTL = 0, CTL_ZERO_BYTES = 1 * MiB;
constexpr size_t WS_WIN = 1 * MiB, WS_WG = 9 * MiB, WS_WB = 17 * MiB, WS_WO = 19 * MiB, WS_WUP = 21 * MiB, WS_WDN = 29 * MiB;
constexpr size_t WS_VFIRST = 37 * MiB;
constexpr size_t WS_XN = 53 * MiB, WS_P = 85 * MiB, WS_SMALL = 205 * MiB;
constexpr size_t WS_SC = 53 * MiB, WS_MASK = 183 * MiB, WS_YL = 191 * MiB, WS_PR = 199 * MiB, WS_OL = 207 * MiB, WS_QD = 215 * MiB;
constexpr size_t WS_BQ = 223 * MiB, WS_BK = 231 * MiB, WS_BVT = 239 * MiB, WS_QI = 247 * MiB, WS_KI = 255 * MiB, WS_WI = 256 * MiB, WS_DQ = 257 * MiB, WS_DK = 265 * MiB, WS_DVT = 273 * MiB;
constexpr size_t WS_FL = 281 * MiB, WS_FB = WS_FL + 256 * 1024, WS_RB = WS_FB + 256 * 1024, WS_HF = WS_RB + 256 * 1024;
constexpr size_t WS_RG = 282 * MiB, WS_HREC = 290 * MiB, WS_HGATE = 330 * MiB, WS_RW = 338 * MiB;
constexpr size_t WS_RSEG = 434 * MiB, WS_HSEG = 466 * MiB, WS_END = 490 * MiB;
constexpr size_t WS_Y = 85 * MiB, WS_G = 117 * MiB, WS_Z = 245 * MiB, WS_MIX = 277 * MiB, WS_U = 117 * MiB;
constexpr size_t SC_PB = (size_t)4096 * 2080;
static_assert(WS_SC + 4 * SC_PB * 4 <= WS_MASK, "scores fit");
constexpr int RREC = 1536;
constexpr int HRECB = 640;
constexpr int RSEGB = 32768, RS_PT = 0, RS_LT = 8192, RS_SS = 24576;
constexpr int HSEGB = 24576, HS_LT = 0, HS_SS = 16384;
static_assert(WS_RW + (size_t)16 * T_ * RREC <= WS_RSEG && WS_HSEG + (size_t)1024 * HSEGB <= WS_END + MiB / 4 && WS_HREC + (size_t)16 * T_ * HRECB <= WS_HGATE, "map");
constexpr int CW_BAR = 4096;

__device__ __forceinline__ float bf2f(unsigned short v) { return __uint_as_float((unsigned)v << 16); }
__device__ __forceinline__ float bflo(unsigned w) { return __uint_as_float(w << 16); }
__device__ __forceinline__ float bfhi(unsigned w) { return __uint_as_float(w & 0xffff0000u); }
template <int O> __device__ __forceinline__ float swz_xor(float v) { return __int_as_float(__builtin_amdgcn_ds_swizzle(__float_as_int(v), (O << 10) | 0x1f)); }
__device__ __forceinline__ float half_sum(float v) { auto rr = __builtin_amdgcn_permlane32_swap(__float_as_uint(v), __float_as_uint(v), false, false); return __uint_as_float(rr[0]) + __uint_as_float(rr[1]); }
__device__ __forceinline__ float half_max(float v) { auto rr = __builtin_amdgcn_permlane32_swap(__float_as_uint(v), __float_as_uint(v), false, false); return fmaxf(__uint_as_float(rr[0]), __uint_as_float(rr[1])); }
__device__ __forceinline__ float wave_sum(float v) {
    v += swz_xor<1>(v); v += swz_xor<2>(v); v += swz_xor<4>(v); v += swz_xor<8>(v); v += swz_xor<16>(v);
    return half_sum(v);
}
__device__ __forceinline__ float sigmoidf_(float x) { return 1.f / (1.f + __expf(-x)); }
__device__ __forceinline__ int crow(int r, int hi) { return (r & 3) + 8 * (r >> 2) + 4 * hi; }
__device__ __forceinline__ size_t sc_rowoff(int b, int t) { const int k = t >> 6; return (size_t)b * SC_PB + (size_t)64 * ((size_t)32 * k * (k + 1) + (size_t)(t - 64 * k) * (k + 1)); }

namespace pg8 {
struct EpiIn {
    static constexpr bool PERM = true, AFTER_DRAIN = false;
    bf16_t* P; float* SM;
    __device__ __forceinline__ void operator()(const f32x4 (&acc)[2][2][4][2], const Unit& u, int wr, int wc, int fr, int fq) const {
        const int row0 = u.pm * BM + wr * 64 + fr; const int col0 = wc * 32 + 8 * fq;
        if (u.pn == 11) {
#pragma unroll
            for (int ai = 0; ai < 2; ++ai)
#pragma unroll
                for (int m = 0; m < 4; ++m) { float* rowp = SM + (size_t)(row0 + ai * HALF + m * 16) * 256 + col0;
#pragma unroll
                    for (int bj = 0; bj < 2; ++bj) { *(f32x4*)(rowp + bj * HALF) = acc[ai][bj][m][0]; *(f32x4*)(rowp + bj * HALF + 4) = acc[ai][bj][m][1]; } }
        } else {
#pragma unroll
            for (int ai = 0; ai < 2; ++ai)
#pragma unroll
                for (int m = 0; m < 4; ++m) { bf16_t* rowp = P + (size_t)(row0 + ai * HALF + m * 16) * PP + u.pn * BM + col0;
#pragma unroll
                    for (int bj = 0; bj < 2; ++bj) { const f32x4 v0 = acc[ai][bj][m][0], v1 = acc[ai][bj][m][1];
                        u32x4 w; w.x = cvt_pk_bf16(v0[0], v0[1]); w.y = cvt_pk_bf16(v0[2], v0[3]); w.z = cvt_pk_bf16(v1[0], v1[1]); w.w = cvt_pk_bf16(v1[2], v1[3]);
                        *(u32x4*)(rowp + bj * HALF) = w; } }
        }
    }
};
template <int ACT> struct EpiAct {
    static constexpr bool PERM = true, AFTER_DRAIN = false;
    bf16_t* O; int ldc;
    __device__ __forceinline__ float f(float x) const { if (ACT == 0 && DBG_MERGE == 3) return 1.f; if (ACT == 0) return __builtin_amdgcn_rcpf(1.f + __builtin_amdgcn_exp2f(-1.4426950408889634f * x)); const float r = x > 0.f ? x : 0.f; return r * r; }
    __device__ __forceinline__ void operator()(const f32x4 (&acc)[2][2][4][2], const Unit& u, int wr, int wc, int fr, int fq) const {
        const int row0 = u.pm * BM + wr * 64 + fr; const int col0 = u.pn * BM + wc * 32 + 8 * fq;
#pragma unroll
        for (int ai = 0; ai < 2; ++ai)
#pragma unroll
            for (int m = 0; m < 4; ++m) { bf16_t* rowp = O + (size_t)(row0 + ai * HALF + m * 16) * ldc + col0;
#pragma unroll
                for (int bj = 0; bj < 2; ++bj) { const f32x4 v0 = acc[ai][bj][m][0], v1 = acc[ai][bj][m][1];
                    u32x4 w; w.x = cvt_pk_bf16(f(v0[0]), f(v0[1])); w.y = cvt_pk_bf16(f(v0[2]), f(v0[3])); w.z = cvt_pk_bf16(f(v1[0]), f(v1[1])); w.w = cvt_pk_bf16(f(v1[2]), f(v1[3]));
                    *(u32x4*)(rowp + bj * HALF) = w; } }
    }
};
struct EpiMerge {
    static constexpr bool PERM = true, AFTER_DRAIN = false;
    const bf16_t* G; bf16_t* Z;
    __device__ __forceinline__ void operator()(const f32x4 (&acc)[2][2][4][2], const Unit& u, int wr, int wc, int fr, int fq) const {
        const int n = u.pn >> 2, ct = u.pn & 3;
        asm volatile("" : "+v"(fr), "+v"(fq));
        const int row0 = u.pm * BM + wr * 64 + fr; const int col0 = wc * 32 + 8 * fq;
#pragma unroll
        for (int ai = 0; ai < 2; ++ai)
#pragma unroll
            for (int m = 0; m < 4; ++m) { const size_t row = (size_t)(row0 + ai * HALF + m * 16);
                const bf16_t* gp = G + row * NG + u.pn * BM + col0; bf16_t* zp = Z + row * D + ct * BM + col0;
#pragma unroll
                for (int bj = 0; bj < 2; ++bj) { const f32x4 v0 = acc[ai][bj][m][0], v1 = acc[ai][bj][m][1];
                    u32x4 gw = *(const u32x4*)(gp + bj * HALF);
                    if (DBG_MERGE == 1) gw = (u32x4){0x3f803f80u, 0x3f803f80u, 0x3f803f80u, 0x3f803f80u};
                    if (DBG_MERGE == 2 && n > 0) continue;
                    float o[8];
                    o[0] = v0[0] * __uint_as_float(gw.x << 16); o[1] = v0[1] * __uint_as_float(gw.x & 0xffff0000u);
                    o[2] = v0[2] * __uint_as_float(gw.y << 16); o[3] = v0[3] * __uint_as_float(gw.y & 0xffff0000u);
                    o[4] = v1[0] * __uint_as_float(gw.z << 16); o[5] = v1[1] * __uint_as_float(gw.z & 0xffff0000u);
                    o[6] = v1[2] * __uint_as_float(gw.w << 16); o[7] = v1[3] * __uint_as_float(gw.w & 0xffff0000u);
                    if (n > 0) { const u32x4 zw = *(const u32x4*)(zp + bj * HALF);
                        o[0] += __uint_as_float(zw.x << 16); o[1] += __uint_as_float(zw.x & 0xffff0000u); o[2] += __uint_as_float(zw.y << 16); o[3] += __uint_as_float(zw.y & 0xffff0000u);
                        o[4] += __uint_as_float(zw.z << 16); o[5] += __uint_as_float(zw.z & 0xffff0000u); o[6] += __uint_as_float(zw.w << 16); o[7] += __uint_as_float(zw.w & 0xffff0000u); }
                    u32x4 w; w.x = cvt_pk_bf16(o[0], o[1]); w.y = cvt_pk_bf16(o[2], o[3]); w.z = cvt_pk_bf16(o[4], o[5]); w.w = cvt_pk_bf16(o[6], o[7]);
                    *(u32x4*)(zp + bj * HALF) = w; }
                asm volatile("" ::: "memory"); }
    }
};
struct EpiF32 {
    static constexpr bool PERM = false, AFTER_DRAIN = false;
    float* O; int ldc;
    __device__ __forceinline__ void operator()(const f32x4 (&acc)[2][2][4][2], const Unit& u, int wr, int wc, int fr, int fq) const {
        const int row0 = u.pm * BM + wr * 64 + fr; const int col0 = u.pn * BM + wc * 32 + 4 * fq;
#pragma unroll
        for (int ai = 0; ai < 2; ++ai)
#pragma unroll
            for (int m = 0; m < 4; ++m) { float* rowp = O + (size_t)(row0 + ai * HALF + m * 16) * ldc + col0;
#pragma unroll
                for (int bj = 0; bj < 2; ++bj)
#pragma unroll
                    for (int n = 0; n < 2; ++n) *(f32x4*)(rowp + bj * HALF + n * 16) = acc[ai][bj][m][n]; }
    }
};
struct MergeOrder {
    int G, c;
    __host__ __device__ bool next(int i, Unit& u) const { const int ot = c + (i >> 2) * G; if (ot >= 256) return false; u.pm = ot >> 2; u.pn = (i & 3) * 4 + (ot & 3); return true; }
    __device__ __forceinline__ void a_ready(const Unit&) const {}
    __device__ __forceinline__ void done(const Unit&) const {}
};
}

__device__ __forceinline__ int in_src(int c, float& sc) {
    const int t = c >> 8, j = c & 255; sc = 1.f;
    switch (t) {
        case 0: sc = 0.125f; return j;
        case 1: return 256 + j;
        case 2: return 512 + j;
        case 3: return 768 + j;
        case 4: sc = C2; return 1024 + j;
        case 5: return 1280 + j;
        case 6: return 1536 + j;
        case 7: sc = 0.17677669529663687f; return 1792 + j;
        case 8: return 2088 + j;
        case 9: return 2344 + j;
        case 10: return 2600 + j;
        case 11: if (j < 128) return 2856 + j; if (j < 160) return 2048 + (j - 128); if (j < 168) { sc = 0.35355339059327373f; return 2080 + (j - 160); } if (j < 172) return 3752 + (j - 168); return -1;
        case 12: sc = C2; return 2984 + j;
        case 13: return 3240 + j;
        default: return 3496 + j;
    }
}
__device__ __forceinline__ void wt_item(const float* W, int ldw, int kind, int coff, const float* gk, bf16* WT, int K, int kb, int nb, LAS float* scr, int lane) {
    const int k0 = 64 * kb, n0 = 32 * nb;
    const int c = n0 + (lane & 31); float sc = 1.f; const int src = (kind == 1) ? in_src(c, sc) : coff + c;
#pragma unroll 8
    for (int i = 0; i < 32; ++i) { const int kk = 2 * i + (lane >> 5); float v = 0.f; if (src >= 0) v = W[(size_t)(k0 + kk) * ldw + src] * sc; if (gk) v *= gk[k0 + kk]; scr[kk * 33 + (lane & 31)] = v; }
    LDS_WAIT(); asm volatile("" ::: "memory");
    const int cc = lane & 7;
#pragma unroll
    for (int j = 0; j < 4; ++j) { const int n = (lane >> 3) + 8 * j; const LAS float* s = scr + (8 * cc) * 33 + n;
        v4u o; o.x = pk2(s[0 * 33], s[1 * 33]); o.y = pk2(s[2 * 33], s[3 * 33]); o.z = pk2(s[4 * 33], s[5 * 33]); o.w = pk2(s[6 * 33], s[7 * 33]);
        *(GAS v4u*)(WT + (size_t)(n0 + n) * K + k0 + 8 * cc) = o; }
    LDS_WAIT(); asm volatile("" ::: "memory");
}
__device__ __forceinline__ void rms_row_to_bf16(const float* xrow, bf16* orow, int lane) {
    const GAS f32x4* xr = (const GAS f32x4*)xrow + lane;
    f32x4 v[4]; float s = 0.f;
#pragma unroll
    for (int j = 0; j < 4; ++j) { v[j] = xr[64 * j]; s += (v[j].x * v[j].x + v[j].y * v[j].y) + (v[j].z * v[j].z + v[j].w * v[j].w); }
    const float rstd = 1.f / sqrtf(wave_sum(s) * (1.f / D) + 1e-6f);
    GAS unsigned long long* o8 = (GAS unsigned long long*)orow + lane;
#pragma unroll
    for (int j = 0; j < 4; ++j) o8[64 * j] = (unsigned long long)pk2(v[j].x * rstd, v[j].y * rstd) | ((unsigned long long)pk2(v[j].z * rstd, v[j].w * rstd) << 32);
}
__device__ __forceinline__ void post_row(const float* mixrow, const float* xold, const float* g, float* xout, bf16* xn, int lane) {
    const GAS f32x4* mr = (const GAS f32x4*)mixrow + lane; const GAS f32x4* xr = (const GAS f32x4*)xold + lane; const GAS f32x4* gr = (const GAS f32x4*)g + lane;
    f32x4 v[4]; float s = 0.f;
#pragma unroll
    for (int j = 0; j < 4; ++j) { v[j] = mr[64 * j]; s += (v[j].x * v[j].x + v[j].y * v[j].y) + (v[j].z * v[j].z + v[j].w * v[j].w); }
    const float rstd = 1.f / sqrtf(wave_sum(s) * (1.f / D) + 1e-6f);
    float s2 = 0.f;
#pragma unroll
    for (int j = 0; j < 4; ++j) { const f32x4 xo = xr[64 * j], gg = gr[64 * j]; v[j] = xo + v[j] * rstd * gg; s2 += (v[j].x * v[j].x + v[j].y * v[j].y) + (v[j].z * v[j].z + v[j].w * v[j].w); }
    GAS f32x4* orow = (GAS f32x4*)xout + lane;
#pragma unroll
    for (int j = 0; j < 4; ++j) orow[64 * j] = v[j];
    if (xn) {
        const float rstd2 = 1.f / sqrtf(wave_sum(s2) * (1.f / D) + 1e-6f);
        GAS unsigned long long* o8 = (GAS unsigned long long*)xn + lane;
#pragma unroll
        for (int j = 0; j < 4; ++j) o8[64 * j] = (unsigned long long)pk2(v[j].x * rstd2, v[j].y * rstd2) | ((unsigned long long)pk2(v[j].z * rstd2, v[j].w * rstd2) << 32);
    }
}

struct Args { const float* in[27]; float* out; unsigned char* ws; int l_lo, l_hi; };

__device__ __forceinline__ void rope_pair(float a, float b, float ang, float& oa, float& ob) {
    float rev = ang * 0.15915494309189535f; rev -= floorf(rev);
    const float sn = __builtin_amdgcn_sinf(rev), cs = __builtin_amdgcn_cosf(rev);
    oa = a * cs - b * sn; ob = b * cs + a * sn;
}
__device__ __forceinline__ void prep_token(const Args& A, unsigned char* ws, int l, int m, int lane) {
    const bf16* prow = (const bf16*)(ws + WS_P) + (size_t)m * PP; const float* srow = (const float*)(ws + WS_SMALL) + (size_t)m * 256;
    const int t = m & (T - 1);
    {
        const u32x2 w = *(const u32x2*)(prow + 256 + 4 * lane);
        const float fl[4] = {bflo(w.x), bfhi(w.x), bflo(w.y), bfhi(w.y)};
        f32x4 e[4]; const float* lbl = A.in[8];
#pragma unroll
        for (int q = 0; q < 4; ++q) e[q] = *(const f32x4*)(lbl + q * 256 + 4 * lane);
        f32x4 o;
#pragma unroll
        for (int i = 0; i < 4; ++i) { const float mx = fmaxf(fmaxf(e[0][i], e[1][i]), fmaxf(e[2][i], e[3][i]));
            float ex[4], sum = 0.f, part = 0.f;
#pragma unroll
            for (int q = 0; q < 4; ++q) { ex[q] = __expf(e[q][i] - mx); sum += ex[q]; }
#pragma unroll
            for (int q = 1; q < 4; ++q) if (q <= l) part += ex[q];
            const float lb = part / sum; o[i] = lb + (1.f - lb) * sigmoidf_(fl[i]); }
        const int hh = lane >> 4, d0 = (4 * lane) & 63; const int b = m >> 12;
        unsigned char* hr = ws + WS_HREC + ((size_t)((b * NH + hh) * T + t)) * HRECB;
        *(f32x4*)(hr + d0 * 4) = o;
        const u32x2 qw = *(const u32x2*)(prow + 4 * lane);
        *(f32x4*)(hr + 256 + d0 * 4) = (f32x4){bflo(qw.x), bfhi(qw.x), bflo(qw.y), bfhi(qw.y)};
        *(u32x2*)(hr + 512 + d0 * 2) = *(const u32x2*)(prow + 512 + 4 * lane);
        const u32x2 gw = *(const u32x2*)(prow + 768 + 4 * lane);
        const float g0 = bflo(gw.x), g1 = bfhi(gw.x), g2 = bflo(gw.y), g3 = bfhi(gw.y);
        *(u32x2*)((bf16*)(ws + WS_HGATE) + (size_t)m * 256 + 4 * lane) = (u32x2){pk2(g0 * sigmoidf_(g0), g1 * sigmoidf_(g1)), pk2(g2 * sigmoidf_(g2), g3 * sigmoidf_(g3))};
        if (lane < 8) ((float*)(ws + WS_WI))[(size_t)m * 8 + lane] = srow[160 + lane];
    }
    {
        const int hh = lane >> 4, j0 = (lane & 15) * 2;
        const float tf = (float)t;
        const float a0 = tf * exp2f(-(float)j0 * (13.287712379549449f / 32.f)), a1 = tf * exp2f(-(float)(j0 + 1) * (13.287712379549449f / 32.f));
#pragma unroll
        for (int which = 0; which < 2; ++which) {
            const bf16* src = prow + (which ? 1280 : 1024) + hh * 64 + j0;
            bf16* dst = (bf16*)(ws + (which ? WS_BK : WS_BQ)) + (size_t)m * 256 + hh * 64 + j0;
            const unsigned w1 = *(const unsigned*)src, w2 = *(const unsigned*)(src + 32);
            float o1a, o2a, o1b, o2b; rope_pair(bflo(w1), bflo(w2), a0, o1a, o2a); rope_pair(bfhi(w1), bfhi(w2), a1, o1b, o2b);
            *(unsigned*)dst = pk2(o1a, o1b); *(unsigned*)(dst + 32) = pk2(o2a, o2b);
        }
    }
    {
        const int ih = lane >> 3, j0 = (lane & 7) * 2; const float tf = (float)t;
        const float a0 = tf * exp2f(-(float)j0 * (13.287712379549449f / 16.f)), a1 = tf * exp2f(-(float)(j0 + 1) * (13.287712379549449f / 16.f));
        const bf16* src = prow + 1792 + ih * 32 + j0; bf16* dst = (bf16*)(ws + WS_QI) + (size_t)m * 256 + ih * 32 + j0;
        const unsigned w1 = *(const unsigned*)src, w2 = *(const unsigned*)(src + 16);
        float o1a, o2a, o1b, o2b; rope_pair(bflo(w1), bflo(w2), a0, o1a, o2a); rope_pair(bfhi(w1), bfhi(w2), a1, o1b, o2b);
        *(unsigned*)dst = pk2(o1a, o1b); *(unsigned*)(dst + 16) = pk2(o2a, o2b);
        if (lane < 16) {
            const float ang = tf * exp2f(-(float)lane * (13.287712379549449f / 16.f));
            float oa, ob; rope_pair(srow[128 + lane], srow[128 + lane + 16], ang, oa, ob);
            bf16* kd = (bf16*)(ws + WS_KI) + (size_t)m * 32; kd[lane] = (bf16)f2bf(oa); kd[lane + 16] = (bf16)f2bf(ob);
        }
        if (lane < 4) {
            const float x = srow[168 + lane] + A.in[10][l * 4 + lane];
            ((float*)(ws + WS_FL))[(size_t)m * 4 + lane] = fminf(x, 0.f) - log1pf(__expf(-fabsf(x)));
        }
    }
    {
        *(u32x2*)((bf16*)(ws + WS_DQ) + (size_t)m * 256 + 4 * lane) = *(const u32x2*)(prow + 3072 + 4 * lane);
        *(u32x2*)((bf16*)(ws + WS_DK) + (size_t)m * 256 + 4 * lane) = *(const u32x2*)(prow + 3328 + 4 * lane);
    }
}
__device__ __forceinline__ void prep_vt(unsigned char* ws, int item, LAS unsigned char* scr, int lane) {
    const int which = item >> 10, r = item & 1023, b = r >> 8, tb = (r >> 2) & 63, hh = r & 3;
    const bf16* src = (const bf16*)(ws + WS_P) + (size_t)(b * T + 64 * tb) * PP + (which ? 3584 : 1536) + hh * 64;
    bf16* dst = (bf16*)(ws + (which ? WS_DVT : WS_BVT)) + (size_t)((b * NH + hh) * 64) * T + 64 * tb;
#pragma unroll
    for (int i = 0; i < 8; ++i) { const int rr = 8 * i + (lane >> 3), ch = lane & 7; const v4u v = *(const v4u*)(src + (size_t)rr * PP + ch * 8);
        LAS unsigned* p = (LAS unsigned*)(scr + rr * 132 + ch * 16); p[0] = v.x; p[1] = v.y; p[2] = v.z; p[3] = v.w; }
    LDS_WAIT(); asm volatile("" ::: "memory");
#pragma unroll
    for (int i = 0; i < 8; ++i) { const int d = 8 * i + (lane >> 3), tc = lane & 7; unsigned short e[8];
#pragma unroll
        for (int k = 0; k < 8; ++k) e[k] = *(const LAS unsigned short*)(scr + (tc * 8 + k) * 132 + d * 2);
        v4u o; o.x = e[0] | ((unsigned)e[1] << 16); o.y = e[2] | ((unsigned)e[3] << 16); o.z = e[4] | ((unsigned)e[5] << 16); o.w = e[6] | ((unsigned)e[7] << 16);
        *(v4u*)(dst + (size_t)d * T + tc * 8) = o; }
    LDS_WAIT(); asm volatile("" ::: "memory");
}
__device__ __forceinline__ void prep_rwkv(const Args& A, unsigned char* ws, int l, LAS unsigned char* lds, const int tid, const int bx, const int G) {
    const int c = tid & 255, grp = tid >> 8, lane = tid & 63, hh = c >> 6;
    LAS float* g2s = (LAS float*)lds;
    LAS float* w2s = (LAS float*)(lds + 65536);
    LAS float* a2s = (LAS float*)(lds + 98304);
    LAS float* tws = (LAS float*)(lds + 131072 + 1024);
    LAS float* ains = tws + 64;
    LAS float* sgs = ains + 64;
    LAS float* vs = sgs + 128;
    LAS float* vvp = vs + 512;
    LAS float* vvs = vvp + 512;
    const float* mu = A.in[11] + l * 896; const float* w2 = A.in[13] + (size_t)l * 32 * 256; const float* a2 = A.in[15] + (size_t)l * 32 * 256; const float* g2 = A.in[16] + (size_t)l * 64 * 256;
    for (int i = tid; i < 64 * 256; i += 512) g2s[i] = g2[i];
    for (int i = tid; i < 32 * 256; i += 512) { w2s[i] = w2[i]; a2s[i] = a2[i]; }
    float v2c[32], v1p[32];
    const int jq = c & 31, sq = c >> 5;
    if (l > 0) { const float* v1 = A.in[23] + (size_t)(l - 1) * 256 * 32; const float* v2 = A.in[24] + (size_t)(l - 1) * 32 * 256;
#pragma unroll
        for (int j = 0; j < 32; ++j) { v2c[j] = v2[j * 256 + c]; v1p[j] = v1[(32 * sq + j) * 32 + jq]; } }
    else {
#pragma unroll
        for (int j = 0; j < 32; ++j) { v2c[j] = 0.f; v1p[j] = 0.f; } }
    const float mur = mu[c], muk = mu[256 + c], muv = mu[512 + c], mus = (c < 128) ? mu[768 + c] : 0.f;
    const float w0 = A.in[12][l * 256 + c], a0 = A.in[14][l * 256 + c], v0 = (l > 0) ? A.in[22][(l - 1) * 256 + c] : 0.f;
    const float kkc = A.in[17][l * 256 + c], kac = A.in[18][l * 256 + c], rkc = A.in[19][l * 256 + c];
    __syncthreads();
    const bf16* P = (const bf16*)(ws + WS_P); const float* SM = (const float*)(ws + WS_SMALL);
    float* VF = (float*)(ws + WS_VFIRST); float* RW = (float*)(ws + WS_RW); bf16* RG = (bf16*)(ws + WS_RG); float* RB = (float*)(ws + WS_RB);
    for (int p = bx; p < M / 2; p += G) {
        const int m = 2 * p + grp, t = m & (T - 1), b = m >> 12;
        const bf16* pr = P + (size_t)m * PP + 2048; const float* sr = SM + (size_t)m * 256;
        float r = bf2f(pr[c]), k = bf2f(pr[256 + c]), v = bf2f(pr[512 + c]);
        float rp = 0.f, kp = 0.f, vp = 0.f, sp = 0.f, scur = (c < 128) ? sr[c] : 0.f;
        if (t > 0) { rp = bf2f(pr[c - PP]); kp = bf2f(pr[256 + c - PP]); vp = bf2f(pr[512 + c - PP]); if (c < 128) sp = sr[c - 256]; }
        r += (rp - r) * mur; k += (kp - k) * muk; v += (vp - v) * muv;
        if (c < 128) { const float xs = scur + (sp - scur) * mus;
            if (c < 32) tws[grp * 32 + c] = tanhf(xs); else if (c < 64) ains[grp * 32 + (c - 32)] = xs; else sgs[grp * 64 + (c - 64)] = sigmoidf_(xs); }
        if (l > 0) vs[grp * 256 + c] = v;
        __syncthreads();
        float wl = w0, al = a0, g = 0.f;
#pragma unroll 8
        for (int j = 0; j < 32; ++j) { wl += tws[grp * 32 + j] * w2s[j * 256 + c]; al += ains[grp * 32 + j] * a2s[j * 256 + c]; }
#pragma unroll 16
        for (int j = 0; j < 64; ++j) g += sgs[grp * 64 + j] * g2s[j * 256 + c];
        if (l > 0) { float part = 0.f;
#pragma unroll
            for (int j = 0; j < 32; ++j) part += vs[grp * 256 + 32 * sq + j] * v1p[j];
            vvp[(grp * 8 + sq) * 32 + jq] = part; }
        __syncthreads();
        if (l > 0) {
            if (c < 32) { float s = 0.f;
#pragma unroll
                for (int q = 0; q < 8; ++q) s += vvp[(grp * 8 + q) * 32 + c];
                vvs[grp * 32 + c] = s; }
            __syncthreads();
            float vg = v0;
#pragma unroll
            for (int j = 0; j < 32; ++j) vg += vvs[grp * 32 + j] * v2c[j];
            const float vf = VF[(size_t)m * 256 + c];
            v = v + (vf - v) * sigmoidf_(vg);
        } else VF[(size_t)m * 256 + c] = v;
        const float a = sigmoidf_(al);
        const float decay = __expf(-0.6065306597126334f * sigmoidf_(wl));
        float kk = k * kkc; const float ss = wave_sum(kk * kk); kk *= rsqrtf(fmaxf(ss, 1e-24f));
        const float k2 = k * (1.f + (a - 1.f) * kac);
        const float bon = wave_sum(r * k2 * rkc);
        float* rec = RW + ((size_t)((b * NH + hh) * T + t)) * (RREC / 4);
        rec[lane] = decay; rec[64 + lane] = kk; rec[128 + lane] = kk * a; rec[192 + lane] = k2; rec[256 + lane] = r; rec[320 + lane] = v;
        RG[(size_t)m * 256 + c] = (bf16)f2bf(g);
        if (lane == 0) RB[(size_t)m * 4 + hh] = bon;
        __syncthreads();
    }
}

__device__ __forceinline__ void rwkv_pass1(unsigned char* ws, LAS unsigned char* buf, int u, int lane) {
    asm volatile("" : "+v"(lane));
    const int bh = u >> 6, seg = u & 63, b = bh >> 2, hh = bh & 3;
    f32x2 SL[32], SI[32];
#pragma unroll
    for (int i = 0; i < 32; ++i) { SL[i] = (f32x2){0.f, 0.f}; SI[i] = (f32x2){(2 * i == lane) ? 1.f : 0.f, (2 * i + 1 == lane) ? 1.f : 0.f}; }
    const unsigned char* rec = ws + WS_RW + ((size_t)(bh * T + seg * 64)) * RREC;
    bf16* ylp = (bf16*)(ws + WS_YL) + ((size_t)(b * T + seg * 64)) * 256 + hh * 64 + lane;
    bf16* prp = (bf16*)(ws + WS_PR) + ((size_t)(b * T + seg * 64)) * 256 + hh * 64 + lane;
#define R1_DMA(sub) do { _Pragma("unroll") for (int c_ = 0; c_ < 6; ++c_) \
        __builtin_amdgcn_global_load_lds((const unsigned*)(rec + (size_t)(sub) * 6144 + c_ * 1024 + lane * 16), (LAS unsigned*)(buf + ((sub) & 1) * 6144 + c_ * 1024), 16, 0, 0); } while (0)
    R1_DMA(0);
#pragma unroll 1
    for (int sub = 0; sub < 16; ++sub) {
        asm volatile("s_waitcnt vmcnt(0)" ::: "memory");
        if (sub + 1 < 16) R1_DMA(sub + 1);
        const LAS unsigned char* cur = buf + (sub & 1) * 6144;
#pragma unroll 1
        for (int tl = 0; tl < 4; ++tl) {
            const LAS f32x4* W4 = (const LAS f32x4*)(cur + tl * RREC);
            const float vv = *(const LAS float*)(cur + tl * RREC + 1280 + lane * 4);
            f32x2 aL = (f32x2){0.f, 0.f}, aI = (f32x2){0.f, 0.f};
#pragma unroll
            for (int i = 0; i < 16; ++i) { const f32x4 kq = W4[16 + i]; const f32x2 k0 = (f32x2){kq.x, kq.y}, k1 = (f32x2){kq.z, kq.w};
                aL += SL[2 * i] * k0; aL += SL[2 * i + 1] * k1; aI += SI[2 * i] * k0; aI += SI[2 * i + 1] * k1;
                if ((i & 3) == 3) __builtin_amdgcn_sched_barrier(0); }
            const float saL = aL.x + aL.y, saI = aI.x + aI.y;
            f32x2 yL = (f32x2){0.f, 0.f}, yI = (f32x2){0.f, 0.f};
#pragma unroll
            for (int i = 0; i < 16; ++i) { const f32x4 w4 = W4[i], b4 = W4[32 + i], k4 = W4[48 + i], r4 = W4[64 + i];
                const f32x2 w0 = (f32x2){w4.x, w4.y}, w1 = (f32x2){w4.z, w4.w}, b0 = (f32x2){b4.x, b4.y}, b1 = (f32x2){b4.z, b4.w};
                const f32x2 kp0 = (f32x2){k4.x, k4.y}, kp1 = (f32x2){k4.z, k4.w}, r0 = (f32x2){r4.x, r4.y}, r1 = (f32x2){r4.z, r4.w};
                f32x2 s0 = SL[2 * i] * w0; s0 -= saL * b0; s0 += vv * kp0; SL[2 * i] = s0; yL += s0 * r0;
                f32x2 s1 = SL[2 * i + 1] * w1; s1 -= saL * b1; s1 += vv * kp1; SL[2 * i + 1] = s1; yL += s1 * r1;
                f32x2 t0 = SI[2 * i] * w0; t0 -= saI * b0; SI[2 * i] = t0; yI += t0 * r0;
                f32x2 t1 = SI[2 * i + 1] * w1; t1 -= saI * b1; SI[2 * i + 1] = t1; yI += t1 * r1;
                if (i & 1) __builtin_amdgcn_sched_barrier(0); }
            const int t = sub * 4 + tl;
            ylp[(size_t)t * 256] = (bf16)f2bf(yL.x + yL.y); prp[(size_t)t * 256] = (bf16)f2bf(yI.x + yI.y);
        }
    }
#undef R1_DMA
    unsigned char* sg = ws + WS_RSEG + (size_t)u * RSEGB;
    bf16* PT = (bf16*)(sg + RS_PT); float* LT = (float*)(sg + RS_LT);
#pragma unroll
    for (int i = 0; i < 32; ++i) { LT[(2 * i) * 64 + lane] = SL[i].x; LT[(2 * i + 1) * 64 + lane] = SL[i].y; PT[(2 * i) * 64 + lane] = (bf16)f2bf(SI[i].x); PT[(2 * i + 1) * 64 + lane] = (bf16)f2bf(SI[i].y); }
}
__device__ __forceinline__ void hgrn_pass1(unsigned char* ws, LAS unsigned char* buf, int u, int lane) {
    const int bh = u >> 6, seg = u & 63, b = bh >> 2, hh = bh & 3;
    f32x2 S[32];
#pragma unroll
    for (int i = 0; i < 32; ++i) S[i] = (f32x2){0.f, 0.f};
    float cf = 1.f;
    const unsigned char* rec = ws + WS_HREC + ((size_t)(bh * T + seg * 64)) * HRECB;
    bf16* olp = (bf16*)(ws + WS_OL) + ((size_t)(b * T + seg * 64)) * 256 + hh * 64 + lane;
    bf16* qdp = (bf16*)(ws + WS_QD) + ((size_t)(b * T + seg * 64)) * 256 + hh * 64 + lane;
#define H1_DMA(sub) do { _Pragma("unroll") for (int c_ = 0; c_ < 5; ++c_) \
        __builtin_amdgcn_global_load_lds((const unsigned*)(rec + (size_t)(sub) * 5120 + c_ * 1024 + lane * 16), (LAS unsigned*)(buf + ((sub) & 1) * 5120 + c_ * 1024), 16, 0, 0); } while (0)
    H1_DMA(0);
#pragma unroll 1
    for (int sub = 0; sub < 8; ++sub) {
        asm volatile("s_waitcnt vmcnt(0)" ::: "memory");
        if (sub + 1 < 8) H1_DMA(sub + 1);
        const LAS unsigned char* cur = buf + (sub & 1) * 5120;
#pragma unroll 1
        for (int tl = 0; tl < 8; ++tl) {
            const LAS unsigned char* rp = cur + tl * HRECB;
            const LAS f32x4* F4 = (const LAS f32x4*)rp; const LAS f32x4* Q4 = (const LAS f32x4*)(rp + 256);
            const float iv = bf2f(*(const LAS unsigned short*)(rp + 512 + lane * 2));
            const float fl = *(const LAS float*)(rp + lane * 4), ql = *(const LAS float*)(rp + 256 + lane * 4);
            cf *= fl;
            const f32x2 iv2 = (f32x2){iv, iv};
            f32x2 o = (f32x2){0.f, 0.f};
#pragma unroll
            for (int i = 0; i < 16; ++i) { const f32x4 f4 = F4[i], q4 = Q4[i];
                f32x2 s0 = S[2 * i] - iv2; s0 = s0 * (f32x2){f4.x, f4.y} + iv2; S[2 * i] = s0; o += s0 * (f32x2){q4.x, q4.y};
                f32x2 s1 = S[2 * i + 1] - iv2; s1 = s1 * (f32x2){f4.z, f4.w} + iv2; S[2 * i + 1] = s1; o += s1 * (f32x2){q4.z, q4.w}; }
            const int t = sub * 8 + tl;
            olp[(size_t)t * 256] = (bf16)f2bf(o.x + o.y); qdp[(size_t)t * 256] = (bf16)f2bf(ql * cf);
        }
    }
#undef H1_DMA
    float* LT = (float*)(ws + WS_HSEG + (size_t)u * HSEGB + HS_LT) + lane * 64;
#pragma unroll
    for (int i = 0; i < 16; ++i) *(f32x4*)(LT + 4 * i) = (f32x4){S[2 * i].x, S[2 * i].y, S[2 * i + 1].x, S[2 * i + 1].y};
    ((float*)(ws + WS_HF))[(size_t)u * 64 + lane] = cf;
}
__device__ __forceinline__ void scan_carry(unsigned char* ws, LAS unsigned char* lds, int bh, const int tid) {
    const int lane = tid & 63, r32 = lane & 31, hi = lane >> 5; const int wid = __builtin_amdgcn_readfirstlane(tid >> 6);
    LAS unsigned char* Sb = lds;
    for (int i = tid; i < 64 * 36; i += 512) ((LAS unsigned*)Sb)[i] = 0u;
    float hs[16];
#pragma unroll
    for (int i = 0; i < 16; ++i) hs[i] = 0.f;
    const int ti = (wid >> 1) & 1, tv = wid & 1;
    __syncthreads();
    for (int g = 0; g < 64; ++g) {
        const size_t u = (size_t)bh * 64 + g;
        if (wid < 4) {
            unsigned char* sg = ws + WS_RSEG + u * RSEGB;
            { const int e = tid;
#pragma unroll
              for (int k = 0; k < 2; ++k) { const int idx = e * 2 + k, row = idx >> 3, ch = idx & 7; *(v4u*)(sg + RS_SS + row * 128 + ch * 16) = *(const LAS v4u*)(Sb + row * 144 + ch * 16); } }
            const float* LT = (const float*)(sg + RS_LT); const bf16* PT = (const bf16*)(sg + RS_PT);
            f32x16 acc;
#pragma unroll
            for (int r = 0; r < 16; ++r) acc[r] = LT[(32 * ti + crow(r, hi)) * 64 + 32 * tv + r32];
#pragma unroll
            for (int ks = 0; ks < 4; ++ks) {
                const bf16x8 a = *(const bf16x8*)(PT + (32 * ti + r32) * 64 + 16 * ks + 8 * hi);
                const bf16x8 bb = *(const LAS bf16x8*)(Sb + (32 * tv + r32) * 144 + (16 * ks + 8 * hi) * 2);
                acc = __builtin_amdgcn_mfma_f32_32x32x16_bf16(a, bb, acc, 0, 0, 0);
            }
            __syncthreads();
#pragma unroll
            for (int q = 0; q < 4; ++q) *(LAS u32x2*)(Sb + (32 * tv + r32) * 144 + (32 * ti + 8 * q + 4 * hi) * 2) = (u32x2){pk2(acc[4 * q], acc[4 * q + 1]), pk2(acc[4 * q + 2], acc[4 * q + 3])};
            __syncthreads();
        } else {
            unsigned char* sg = ws + WS_HSEG + u * HSEGB; const int e = tid - 256;
            { u32x4 o0, o1; o0.x = pk2(hs[0], hs[1]); o0.y = pk2(hs[2], hs[3]); o0.z = pk2(hs[4], hs[5]); o0.w = pk2(hs[6], hs[7]);
              o1.x = pk2(hs[8], hs[9]); o1.y = pk2(hs[10], hs[11]); o1.z = pk2(hs[12], hs[13]); o1.w = pk2(hs[14], hs[15]);
              *(u32x4*)(sg + HS_SS + e * 32) = o0; *(u32x4*)(sg + HS_SS + e * 32 + 16) = o1; }
            const float* LT = (const float*)(sg + HS_LT) + e * 16; const float* F = (const float*)(ws + WS_HF) + u * 64 + (e & 3) * 16;
#pragma unroll
            for (int q = 0; q < 4; ++q) { const f32x4 l4 = *(const f32x4*)(LT + 4 * q), f4 = *(const f32x4*)(F + 4 * q);
#pragma unroll
                for (int k = 0; k < 4; ++k) hs[4 * q + k] = hs[4 * q + k] * f4[k] + l4[k]; }
            __syncthreads();
            __syncthreads();
        }
    }
}
template <int MIXER>
__device__ __forceinline__ void scan_fixup(const Args& A, unsigned char* ws, int l, int u, int lane) {
    const int bh = u >> 6, seg = u & 63, b = bh >> 2, hh = bh & 3, r32 = lane & 31, hi = lane >> 5;
    const bf16* SS = (const bf16*)(MIXER == 0 ? ws + WS_RSEG + (size_t)u * RSEGB + RS_SS : ws + WS_HSEG + (size_t)u * HSEGB + HS_SS);
    const size_t row0 = (size_t)b * T + seg * 64;
    const bf16* PRp = (const bf16*)(ws + (MIXER == 0 ? WS_PR : WS_QD)) + row0 * 256 + hh * 64;
    const bf16* LOC = (const bf16*)(ws + (MIXER == 0 ? WS_YL : WS_OL)) + row0 * 256 + hh * 64;
    f32x16 acc[2][2];
#pragma unroll
    for (int a = 0; a < 2; ++a)
#pragma unroll
        for (int c = 0; c < 2; ++c)
#pragma unroll
            for (int r = 0; r < 16; ++r) acc[a][c][r] = 0.f;
#pragma unroll
    for (int ks = 0; ks < 4; ++ks) {
        bf16x8 af[2], bfr[2];
#pragma unroll
        for (int x = 0; x < 2; ++x) { af[x] = *(const bf16x8*)(SS + (32 * x + r32) * 64 + 16 * ks + 8 * hi); bfr[x] = *(const bf16x8*)(PRp + (size_t)(32 * x + r32) * 256 + 16 * ks + 8 * hi); }
#pragma unroll
        for (int tv = 0; tv < 2; ++tv)
#pragma unroll
            for (int tt = 0; tt < 2; ++tt) acc[tv][tt] = __builtin_amdgcn_mfma_f32_32x32x16_bf16(af[tv], bfr[tt], acc[tv][tt], 0, 0, 0);
    }
    bf16* Yp = (bf16*)(ws + WS_Y) + row0 * 1024 + (MIXER == 0 ? 512 : 0) + hh * 64;
#pragma unroll
    for (int tt = 0; tt < 2; ++tt) {
        const int t = 32 * tt + r32;
        float y[2][16]; float sum = 0.f;
#pragma unroll
        for (int tv = 0; tv < 2; ++tv)
#pragma unroll
            for (int q = 0; q < 4; ++q) { const u32x2 w = *(const u32x2*)(LOC + (size_t)t * 256 + 32 * tv + 8 * q + 4 * hi);
                y[tv][4 * q] = acc[tv][tt][4 * q] + bflo(w.x); y[tv][4 * q + 1] = acc[tv][tt][4 * q + 1] + bfhi(w.x); y[tv][4 * q + 2] = acc[tv][tt][4 * q + 2] + bflo(w.y); y[tv][4 * q + 3] = acc[tv][tt][4 * q + 3] + bfhi(w.y); }
        if (MIXER == 0) {
#pragma unroll
            for (int tv = 0; tv < 2; ++tv)
#pragma unroll
                for (int r = 0; r < 16; ++r) sum += y[tv][r];
            const float mean = half_sum(sum) * (1.f / 64.f); float q2 = 0.f;
#pragma unroll
            for (int tv = 0; tv < 2; ++tv)
#pragma unroll
                for (int r = 0; r < 16; ++r) { y[tv][r] -= mean; q2 += y[tv][r] * y[tv][r]; }
            const float rstd = rsqrtf(half_sum(q2) * (1.f / 64.f) + 64e-5f);
            const float bon = ((const float*)(ws + WS_RB))[(row0 + t) * 4 + hh];
            const float* vp = (const float*)(ws + WS_RW + ((size_t)(bh * T + seg * 64 + t)) * RREC + 1280);
            const bf16* gp = (const bf16*)(ws + WS_RG) + (row0 + t) * 256 + hh * 64;
#pragma unroll
            for (int tv = 0; tv < 2; ++tv)
#pragma unroll
                for (int q = 0; q < 4; ++q) { const int v0 = 32 * tv + 8 * q + 4 * hi;
                    const f32x4 lw = *(const f32x4*)(A.in[20] + l * 256 + hh * 64 + v0), lb = *(const f32x4*)(A.in[21] + l * 256 + hh * 64 + v0), v4 = *(const f32x4*)(vp + v0);
                    const u32x2 gw = *(const u32x2*)(gp + v0); const float gg[4] = {bflo(gw.x), bfhi(gw.x), bflo(gw.y), bfhi(gw.y)};
                    float o[4];
#pragma unroll
                    for (int k = 0; k < 4; ++k) { o[k] = (y[tv][4 * q + k] * rstd * lw[k] + lb[k] + bon * v4[k]) * gg[k]; if (DBG_ZERO & 4) o[k] = 0.f; }
                    *(u32x2*)(Yp + (size_t)t * 1024 + v0) = (u32x2){pk2(o[0], o[1]), pk2(o[2], o[3])}; }
        } else {
#pragma unroll
            for (int tv = 0; tv < 2; ++tv)
#pragma unroll
                for (int r = 0; r < 16; ++r) sum += y[tv][r] * y[tv][r];
            const float rstd = rsqrtf(half_sum(sum) * (1.f / 64.f) + 1e-6f);
            const bf16* gp = (const bf16*)(ws + WS_HGATE) + (row0 + t) * 256 + hh * 64;
#pragma unroll
            for (int tv = 0; tv < 2; ++tv)
#pragma unroll
                for (int q = 0; q < 4; ++q) { const int v0 = 32 * tv + 8 * q + 4 * hi;
                    const f32x4 nw = *(const f32x4*)(A.in[9] + l * 64 + v0);
                    const u32x2 gw = *(const u32x2*)(gp + v0); const float gg[4] = {bflo(gw.x), bfhi(gw.x), bflo(gw.y), bfhi(gw.y)};
                    float o[4];
#pragma unroll
                    for (int k = 0; k < 4; ++k) { o[k] = y[tv][4 * q + k] * rstd * nw[k] * gg[k]; if (DBG_ZERO & 1) o[k] = 0.f; }
                    *(u32x2*)(Yp + (size_t)t * 1024 + v0) = (u32x2){pk2(o[0], o[1]), pk2(o[2], o[3])}; }
        }
    }
}
__device__ __forceinline__ void fox_cumsum_wave(unsigned char* ws, int bh, int lane) {
    const int b = bh >> 2, hh = bh & 3;
    const float* fl = (const float*)(ws + WS_FL) + (size_t)(b * T + 64 * lane) * 4 + hh;
    float s = 0.f;
    for (int i = 0; i < 64; ++i) s += fl[i * 4];
    float incl = s;
#pragma unroll
    for (int o = 1; o < 64; o <<= 1) { const float n = __int_as_float(__builtin_amdgcn_ds_bpermute(((lane - o) & 63) << 2, __float_as_int(incl))); if (lane >= o) incl += n; }
    float run = incl - s;
    float* fbp = (float*)(ws + WS_FB) + (size_t)bh * T + 64 * lane;
    for (int i = 0; i < 64; ++i) { run += fl[i * 4]; fbp[i] = -run * LOG2E; }
}

__device__ __forceinline__ void dsa_scores_unit(unsigned char* ws, int u, int lane) {
    const int b = u >> 10, qg = (u >> 3) & 127, kc = u & 7;
    const int nkvb = 2 * ((qg >> 1) + 1);
    if (kc * 16 >= nkvb) return;
    const int q = lane & 31, hi = lane >> 5; const int trow = 32 * qg + q; const size_t grow = (size_t)b * T + trow;
    const bf16* QI = (const bf16*)(ws + WS_QI); const bf16* KI = (const bf16*)(ws + WS_KI); const float* WIp = (const float*)(ws + WS_WI);
    bf16x8 qf[8][2]; float wq[8];
#pragma unroll
    for (int h = 0; h < 8; ++h) { qf[h][0] = *(const bf16x8*)(QI + grow * 256 + h * 32 + hi * 8); qf[h][1] = *(const bf16x8*)(QI + grow * 256 + h * 32 + 16 + hi * 8); wq[h] = WIp[grow * 8 + h]; }
    float* srow = (float*)(ws + WS_SC) + sc_rowoff(b, trow);
    const int kb1 = (kc * 16 + 16 < nkvb) ? kc * 16 + 16 : nkvb;
#pragma unroll 1
    for (int kb = kc * 16; kb < kb1; ++kb) {
        const bf16* kp = KI + ((size_t)b * T + 32 * kb + q) * 32 + hi * 8;
        const bf16x8 k0 = *(const bf16x8*)kp, k1 = *(const bf16x8*)(kp + 16);
        f32x16 acc;
#pragma unroll
        for (int r = 0; r < 16; ++r) acc[r] = 0.f;
#pragma unroll
        for (int h = 0; h < 8; ++h) { f32x16 d;
#pragma unroll
            for (int r = 0; r < 16; ++r) d[r] = 0.f;
            d = __builtin_amdgcn_mfma_f32_32x32x16_bf16(k0, qf[h][0], d, 0, 0, 0);
            d = __builtin_amdgcn_mfma_f32_32x32x16_bf16(k1, qf[h][1], d, 0, 0, 0);
#pragma unroll
            for (int r = 0; r < 16; ++r) acc[r] += wq[h] * fmaxf(d[r], 0.f);
            if (h & 1) __builtin_amdgcn_sched_barrier(0); }
#pragma unroll
        for (int j = 0; j < 4; ++j) *(f32x4*)(srow + 32 * kb + 8 * j + 4 * hi) = (f32x4){acc[4 * j], acc[4 * j + 1], acc[4 * j + 2], acc[4 * j + 3]};
    }
}

__device__ __forceinline__ void dsa_select_row(unsigned char* ws, int row, int lane) {
    const int b = row >> 12, t = row & (T - 1); const int nreg = (t >> 6) + 1;
    const float* src = (const float*)(ws + WS_SC) + sc_rowoff(b, t);
    unsigned key[64];
#pragma unroll
    for (int g = 0; g < 8; ++g) {
        if (8 * g < nreg) {
#pragma unroll
            for (int jj = 0; jj < 8; ++jj) { const int j = 8 * g + jj; unsigned u = 0u;
                if (j < nreg) { const unsigned bits = __float_as_uint(src[64 * j + lane]); u = bits ^ ((bits >> 31) ? 0xffffffffu : 0x80000000u); if (64 * j + lane > t) u = 0u; }
                key[j] = u; }
        } else {
#pragma unroll
            for (int jj = 0; jj < 8; ++jj) key[8 * g + jj] = 0u;
        }
    }
    unsigned thr = 0u; int need = 0;
    if (t >= 256) {
        for (int bit = 31; bit >= 0; --bit) {
            const unsigned cand = thr | (1u << bit); int cnt = 0;
#pragma unroll
            for (int g = 0; g < 8; ++g) if (8 * g < nreg) {
#pragma unroll
                for (int jj = 0; jj < 8; ++jj) cnt += __popcll(__ballot(key[8 * g + jj] >= cand));
                __builtin_amdgcn_sched_barrier(0); }
            if (cnt >= 256) thr = cand;
        }
        int gt = 0;
#pragma unroll
        for (int g = 0; g < 8; ++g) if (8 * g < nreg) {
#pragma unroll
            for (int jj = 0; jj < 8; ++jj) gt += __popcll(__ballot(key[8 * g + jj] > thr)); }
        need = 256 - gt;
    }
    unsigned mylo = 0u, myhi = 0u;
#pragma unroll
    for (int j = 0; j < 64; ++j) {
        const bool eq = key[j] == thr; const unsigned long long eqm = __ballot(eq);
        const int rank = (int)__builtin_amdgcn_mbcnt_hi((unsigned)(eqm >> 32), __builtin_amdgcn_mbcnt_lo((unsigned)eqm, 0u));
        const bool sel = (key[j] > thr) || (eq && rank < need);
        need -= __popcll(eqm);
        const unsigned long long word = __ballot(sel);
        { const unsigned wl_ = (unsigned)word, wh_ = (unsigned)(word >> 32);
          asm volatile("s_nop 4\n\tv_writelane_b32 %0, %1, %2" : "+v"(mylo) : "s"(wl_), "n"(j)); asm volatile("v_writelane_b32 %0, %1, %2" : "+v"(myhi) : "s"(wh_), "n"(j)); }
        if ((j & 3) == 3) __builtin_amdgcn_sched_barrier(0);
    }
    ((unsigned long long*)(ws + WS_MASK))[((size_t)b * 64 + lane) * T + t] = ((unsigned long long)myhi << 32) | mylo;
}

constexpr int AT_KS = 0, AT_VS = 9216, AT_WSF = 9216 + 8704, AT_BYTES = AT_WSF + 8 * 256;
template <int MODE>
__device__ __forceinline__ void attn_unit(LAS unsigned char* lds, int b, int hh, int qb, const bf16* Q, const bf16* K, const bf16* VT, const float* FBp, const unsigned long long* MT, bf16* Y, int ycol, const int tid) {
    const int lane = tid & 63, r32 = lane & 31, hi = lane >> 5; const int wid = __builtin_amdgcn_readfirstlane(tid >> 6);
    const int q0 = qb * 256, qw0 = q0 + wid * 32; const size_t rowbase = (size_t)b * T;
    bf16x8 qr[4];
#pragma unroll
    for (int d0 = 0; d0 < 4; ++d0) qr[d0] = *(const bf16x8*)(Q + (rowbase + qw0 + r32) * 256 + hh * 64 + d0 * 16 + hi * 8);
    f32x16 o0, o1;
#pragma unroll
    for (int r = 0; r < 16; ++r) { o0[r] = 0.f; o1[r] = 0.f; }
    float m_run = -1e30f, l_run = 0.f;
    const int NT = (q0 + 256) / 64;
    const int lrow = tid >> 3, lch = tid & 7;
    const bf16* kg = K + (rowbase + lrow) * 256 + hh * 64 + lch * 8;
    const bf16* vg = VT + ((size_t)((b * NH + hh) * 64 + lrow)) * T + lch * 8;
    v4u kreg = *(const v4u*)kg, vreg = *(const v4u*)vg;
    LAS unsigned char* Ks = lds + AT_KS; LAS unsigned char* Vs = lds + AT_VS; LAS float* wsf = (LAS float*)(lds + AT_WSF) + wid * 64;
    const float* fbh = FBp + (size_t)(b * NH + hh) * T;
    const int qabs = qw0 + r32;
    for (int t = 0; t < NT; ++t) {
        __syncthreads();
        *(LAS v4u*)(Ks + lrow * 144 + lch * 16) = kreg;
        *(LAS u32x2*)(Vs + lrow * 136 + lch * 16) = (u32x2){vreg.x, vreg.y}; *(LAS u32x2*)(Vs + lrow * 136 + lch * 16 + 8) = (u32x2){vreg.z, vreg.w};
        __syncthreads();
        if (t + 1 < NT) { kreg = *(const v4u*)(kg + (size_t)(t + 1) * 64 * 256); vreg = *(const v4u*)(vg + (t + 1) * 64); }
        if (64 * t <= qw0 + 31) {
            f32x16 p0, p1;
#pragma unroll
            for (int r = 0; r < 16; ++r) { p0[r] = 0.f; p1[r] = 0.f; }
#pragma unroll
            for (int d0 = 0; d0 < 4; ++d0) {
                const bf16x8 kf0 = *(const LAS bf16x8*)(Ks + r32 * 144 + d0 * 32 + hi * 16), kf1 = *(const LAS bf16x8*)(Ks + (r32 + 32) * 144 + d0 * 32 + hi * 16);
                p0 = __builtin_amdgcn_mfma_f32_32x32x16_bf16(kf0, qr[d0], p0, 0, 0, 0);
                p1 = __builtin_amdgcn_mfma_f32_32x32x16_bf16(kf1, qr[d0], p1, 0, 0, 0);
            }
            if (MODE == 0) {
#pragma unroll
                for (int j = 0; j < 4; ++j) { const f32x4 b0 = *(const f32x4*)(fbh + 64 * t + 8 * j + 4 * hi), b1 = *(const f32x4*)(fbh + 64 * t + 32 + 8 * j + 4 * hi);
#pragma unroll
                    for (int e = 0; e < 4; ++e) { p0[4 * j + e] += b0[e]; p1[4 * j + e] += b1[e]; } }
            } else {
                const unsigned long long word = MT[((size_t)b * 64 + t) * T + qabs];
                const unsigned wlo = (unsigned)word, whi = (unsigned)(word >> 32);
#pragma unroll
                for (int r = 0; r < 16; ++r) { const int kv = crow(r, hi); if (!((wlo >> kv) & 1u)) p0[r] = NEGBIG; if (!((whi >> kv) & 1u)) p1[r] = NEGBIG; }
            }
            if (64 * t + 63 > qw0) {
#pragma unroll
                for (int r = 0; r < 16; ++r) { const int kv = 64 * t + crow(r, hi); if (kv > qabs) p0[r] = NEGBIG; if (kv + 32 > qabs) p1[r] = NEGBIG; }
            }
            float mx = p0[0];
#pragma unroll
            for (int r = 1; r < 16; ++r) mx = fmaxf(mx, p0[r]);
#pragma unroll
            for (int r = 0; r < 16; ++r) mx = fmaxf(mx, p1[r]);
            mx = half_max(mx);
            const float m_new = fmaxf(m_run, mx); const float f = __builtin_amdgcn_exp2f(m_run - m_new); m_run = m_new;
            float rs = 0.f;
#pragma unroll
            for (int r = 0; r < 16; ++r) { p0[r] = __builtin_amdgcn_exp2f(p0[r] - m_new); p1[r] = __builtin_amdgcn_exp2f(p1[r] - m_new); rs += p0[r] + p1[r]; }
            l_run = l_run * f + rs;
            if (hi == 0) wsf[r32] = f;
            __builtin_amdgcn_wave_barrier(); LDS_WAIT();
#pragma unroll
            for (int r = 0; r < 16; ++r) { const float fr_ = wsf[crow(r, hi)]; o0[r] *= fr_; o1[r] *= fr_; }
            __builtin_amdgcn_wave_barrier();
            u32x4 pw[4];
            pw[0] = (u32x4){pk2(p0[0], p0[1]), pk2(p0[2], p0[3]), pk2(p0[4], p0[5]), pk2(p0[6], p0[7])};
            pw[1] = (u32x4){pk2(p0[8], p0[9]), pk2(p0[10], p0[11]), pk2(p0[12], p0[13]), pk2(p0[14], p0[15])};
            pw[2] = (u32x4){pk2(p1[0], p1[1]), pk2(p1[2], p1[3]), pk2(p1[4], p1[5]), pk2(p1[6], p1[7])};
            pw[3] = (u32x4){pk2(p1[8], p1[9]), pk2(p1[10], p1[11]), pk2(p1[12], p1[13]), pk2(p1[14], p1[15])};
#pragma unroll
            for (int k = 0; k < 4; ++k) {
                const bf16x8 pa = __builtin_bit_cast(bf16x8, pw[k]);
                { const LAS unsigned char* vp = Vs + r32 * 136 + (16 * k + 4 * hi) * 2; const u32x2 lo = *(const LAS u32x2*)vp, h2 = *(const LAS u32x2*)(vp + 16);
                  const bf16x8 vb = __builtin_bit_cast(bf16x8, (u32x4){lo.x, lo.y, h2.x, h2.y}); o0 = __builtin_amdgcn_mfma_f32_32x32x16_bf16(pa, vb, o0, 0, 0, 0); }
                { const LAS unsigned char* vp = Vs + (r32 + 32) * 136 + (16 * k + 4 * hi) * 2; const u32x2 lo = *(const LAS u32x2*)vp, h2 = *(const LAS u32x2*)(vp + 16);
                  const bf16x8 vb = __builtin_bit_cast(bf16x8, (u32x4){lo.x, lo.y, h2.x, h2.y}); o1 = __builtin_amdgcn_mfma_f32_32x32x16_bf16(pa, vb, o1, 0, 0, 0); }
            }
        }
    }
    const float l_tot = half_sum(l_run);
    __builtin_amdgcn_wave_barrier();
    if (hi == 0) wsf[r32] = 1.f / l_tot;
    __builtin_amdgcn_wave_barrier(); LDS_WAIT();
#pragma unroll
    for (int r = 0; r < 16; ++r) { const int qr_ = crow(r, hi); const float rl = wsf[qr_];
        bf16* yp = Y + (rowbase + qw0 + qr_) * 1024 + ycol + hh * 64 + r32;
        float y0 = o0[r] * rl, y1 = o1[r] * rl; if (DBG_ZERO & (MODE == 0 ? 8 : 2)) { y0 = 0.f; y1 = 0.f; }
        yp[0] = (bf16)f2bf(y0); yp[32] = (bf16)f2bf(y1); }
    __builtin_amdgcn_wave_barrier();
}

__device__ __forceinline__ void load_args(Args& A) {
#if defined(__HIP_DEVICE_COMPILE__)
    const __attribute__((address_space(4))) unsigned long long* p = (const __attribute__((address_space(4))) unsigned long long*)__builtin_amdgcn_kernarg_segment_ptr();
    asm volatile("" : "+s"(p));
    unsigned long long* d = (unsigned long long*)&A;
#pragma unroll
    for (int i = 0; i < (int)(sizeof(Args) / 8); ++i) d[i] = p[i];
#endif
}
#ifndef MK_MULTI
#define MK_MULTI 0
#endif
constexpr int NPH = 13;
constexpr int LDS_BYTES = 147456;
constexpr int RING_BYTES = 131072, MISC_OFF = RING_BYTES + 320;

template <int PLO, int PHI> __global__ void __launch_bounds__(NWAVES * 64, 2) mk_fwd(Args KA) {
    extern __shared__ __attribute__((aligned(16))) unsigned char lds_raw[];
    LAS unsigned char* lds = (LAS unsigned char*)lds_raw;
    volatile LAS unsigned* MISC = (volatile LAS unsigned*)(lds + MISC_OFF);
    for (int u = threadIdx.x; u < (LDS_BYTES - RING_BYTES) / 4; u += NWAVES * 64) ((LAS unsigned*)(lds + RING_BYTES))[u] = 0u;
    __syncthreads();
#if MK_MULTI
#define GRID_BAR() do { } while (0)
#else
    XcdBarrier bar = xcd_barrier_post((unsigned*)(KA.ws + WS_CTL) + CW_BAR, MISC + 8);
#define GRID_BAR() do { XcdBarrier b_ = bar; asm volatile("" : "+s"(b_.bar), "+s"(b_.x)); xcd_barrier(b_); } while (0)
#endif
#ifdef ONLY_PH
#define IN(k) ((k) == ONLY_PH && PLO <= (k) && (k) < PHI)
#else
#define IN(k) (PLO <= (k) && (k) < PHI)
#endif
#define PHASE_IDS() int tid = threadIdx.x, bx = blockIdx.x, G = gridDim.x; asm volatile("" : "+v"(tid), "+s"(bx), "+s"(G)); Args A; load_args(A); unsigned char* ws = A.ws; \
    const int lane = tid & 63, wave = __builtin_amdgcn_readfirstlane(tid >> 6); const int gw = bx * NWAVES + wave, NGW = G * NWAVES; bf16* XN = (bf16*)(ws + WS_XN); (void)lane; (void)gw; (void)NGW; (void)XN
    for (int l = KA.l_lo; l < KA.l_hi; ++l) {
        if (IN(0)) { PHASE_IDS();
            LAS float* scr = (LAS float*)(lds + wave * 16384);
            const float* gpre = A.in[1] + l * D; const float* gmlp = A.in[3] + l * D;
            const float* win = A.in[5] + (size_t)l * D * IN_COLS; const float* wbr = A.in[6] + (size_t)l * 4 * 256 * 1024; const float* wout = A.in[7] + (size_t)l * D * D;
            const float* wup = A.in[25] + (size_t)l * D * FF; const float* wdn = A.in[26] + (size_t)l * FF * D;
            constexpr int I_IN = 16 * 120, I_G = 16 * 128, I_B = 4 * 32, I_O = 16 * 32, I_UP = 16 * 128, I_DN = 64 * 32;
            constexpr int NIT = I_IN + I_G + 4 * I_B + I_O + I_UP + I_DN;
            for (int it = gw; it < NIT; it += NGW) {
                int r = it;
                if (r < I_IN) { wt_item(win, IN_COLS, 1, 0, gpre, (bf16*)(ws + WS_WIN), D, r / 120, r % 120, scr, lane); continue; } r -= I_IN;
                if (r < I_G) { wt_item(win, IN_COLS, 0, 3756, gpre, (bf16*)(ws + WS_WG), D, r / 128, r % 128, scr, lane); continue; } r -= I_G;
                if (r < 4 * I_B) { const int n = r / I_B, q = r % I_B; wt_item(wbr + (size_t)n * 256 * 1024, 1024, 0, 0, nullptr, (bf16*)(ws + WS_WB) + (size_t)n * 1024 * 256, 256, q / 32, q % 32, scr, lane); continue; } r -= 4 * I_B;
                if (r < I_O) { wt_item(wout, D, 0, 0, nullptr, (bf16*)(ws + WS_WO), D, r / 32, r % 32, scr, lane); continue; } r -= I_O;
                if (r < I_UP) { wt_item(wup, FF, 0, 0, gmlp, (bf16*)(ws + WS_WUP), D, r / 128, r % 128, scr, lane); continue; } r -= I_UP;
                wt_item(wdn, D, 0, 0, nullptr, (bf16*)(ws + WS_WDN), FF, r / 32, r % 32, scr, lane);
            }
            if (l == 0) for (int m = gw; m < M; m += NGW) rms_row_to_bf16(A.in[0] + (size_t)m * D, XN + (size_t)m * D, lane);
            GRID_BAR();
        }
        if (IN(1)) { PHASE_IDS();
            pg8::Gemm g{XN, (const bf16*)(ws + WS_WIN), M, PP, D, D, D, 0, 0}; pg8::StaticOrder S; S.init(M, PP, G, bx);
            pg8::EpiIn E{(bf16*)(ws + WS_P), (float*)(ws + WS_SMALL)};
            pg8::gemm_phase<pg8::EpiIn, pg8::StaticOrder, true, true>(lds, g, S, E, tid);
            GRID_BAR();
        }
        if (IN(2)) { PHASE_IDS();
            for (int m = gw; m < M; m += NGW) prep_token(A, ws, l, m, lane);
            for (int it = gw; it < 2048; it += NGW) prep_vt(ws, it, lds + wave * 8448, lane);
            __syncthreads();
            prep_rwkv(A, ws, l, lds, tid, bx, G);
            GRID_BAR();
        }
        if (IN(3)) { PHASE_IDS();
            const int w4 = wave & 3;
            if (wave < 4) { for (int u = bx * 4 + w4; u < 1024; u += G * 4) rwkv_pass1(ws, lds + w4 * 12288, u, lane); }
            else {
                for (int u = bx * 4 + w4; u < 1024; u += G * 4) hgrn_pass1(ws, lds + 49152 + w4 * 10240, u, lane);
                for (int u = bx * 4 + w4; u < 4096; u += G * 4) dsa_scores_unit(ws, u, lane);
                if (bx * 4 + w4 < 16) fox_cumsum_wave(ws, bx * 4 + w4, lane);
            }
            GRID_BAR();
        }
        if (IN(4)) { PHASE_IDS();
            if (bx < 16) { for (int bh = bx; bh < 16; bh += G) scan_carry(ws, lds, bh, tid); }
            if (G <= 16) { for (int row = gw; row < M; row += NGW) dsa_select_row(ws, row, lane); }
            else if (bx >= 16) { for (int row = (bx - 16) * NWAVES + wave; row < M; row += (G - 16) * NWAVES) dsa_select_row(ws, row, lane); }
            GRID_BAR();
        }
        if (IN(5)) { PHASE_IDS();
            for (int u = gw; u < 2048; u += NGW) { if (u < 1024) scan_fixup<0>(A, ws, l, u, lane); else scan_fixup<1>(A, ws, l, u - 1024, lane); }
            { const float* xs = (l == 0) ? A.in[0] : A.out; for (int m = gw; m < M; m += NGW) rms_row_to_bf16(xs + (size_t)m * D, XN + (size_t)m * D, lane); }
            for (int u = bx; u < 256; u += G) {
                const int bh = u >> 4, s = u & 15;
                attn_unit<0>(lds, bh >> 2, bh & 3, s, (const bf16*)(ws + WS_DQ), (const bf16*)(ws + WS_DK), (const bf16*)(ws + WS_DVT), (const float*)(ws + WS_FB), nullptr, (bf16*)(ws + WS_Y), 768, tid);
                attn_unit<1>(lds, bh >> 2, bh & 3, 15 - s, (const bf16*)(ws + WS_BQ), (const bf16*)(ws + WS_BK), (const bf16*)(ws + WS_BVT), (const float*)(ws + WS_FB), (const unsigned long long*)(ws + WS_MASK), (bf16*)(ws + WS_Y), 256, tid);
            }
            __syncthreads();
            GRID_BAR();
        }
        if (IN(6)) { PHASE_IDS();
            pg8::Gemm g{XN, (const bf16*)(ws + (DBG_MERGE == 4 ? WS_WUP : WS_WG)), M, NG, D, D, D, 0, 0}; pg8::StaticOrder S; S.init(M, NG, G, bx);
            pg8::EpiAct<0> E{(bf16*)(ws + WS_G), NG};
            pg8::gemm_phase<pg8::EpiAct<0>, pg8::StaticOrder, true, true>(lds, g, S, E, tid);
            GRID_BAR();
        }
        if (IN(7)) { PHASE_IDS();
            int kmerge = 256; asm volatile("" : "+s"(kmerge));
            pg8::Gemm g{(const bf16*)(ws + WS_Y), (const bf16*)(ws + WS_WB), M, 4096, kmerge, 1024, 256, 4, 512}; pg8::MergeOrder S{G, bx};
            pg8::EpiMerge E{(const bf16*)(ws + WS_G), (bf16*)(ws + WS_Z)};
            pg8::gemm_phase<pg8::EpiMerge, pg8::MergeOrder, true, true>(lds, g, S, E, tid);
            GRID_BAR();
        }
        if (IN(8)) { PHASE_IDS();
            pg8::Gemm g{(const bf16*)(ws + WS_Z), (const bf16*)(ws + WS_WO), M, D, D, D, D, 0, 0}; pg8::StaticOrder S; S.init(M, D, G, bx);
            pg8::EpiF32 E{(float*)(ws + WS_MIX), D};
            pg8::gemm_phase<pg8::EpiF32, pg8::StaticOrder, true, true>(lds, g, S, E, tid);
            GRID_BAR();
        }
        if (IN(9)) { PHASE_IDS();
            const float* xold = (l == 0) ? A.in[0] : A.out;
            for (int m = gw; m < M; m += NGW) post_row((const float*)(ws + WS_MIX) + (size_t)m * D, xold + (size_t)m * D, A.in[2] + l * D, A.out + (size_t)m * D, XN + (size_t)m * D, lane);
            GRID_BAR();
        }
        if (IN(10)) { PHASE_IDS();
            pg8::Gemm g{XN, (const bf16*)(ws + WS_WUP), M, FF, D, D, D, 0, 0}; pg8::StaticOrder S; S.init(M, FF, G, bx);
            pg8::EpiAct<1> E{(bf16*)(ws + WS_U), FF};
            pg8::gemm_phase<pg8::EpiAct<1>, pg8::StaticOrder, true, true>(lds, g, S, E, tid);
            GRID_BAR();
        }
        if (IN(11)) { PHASE_IDS();
            pg8::Gemm g{(const bf16*)(ws + WS_U), (const bf16*)(ws + WS_WDN), M, D, FF, FF, FF, 0, 0}; pg8::StaticOrder S; S.init(M, D, G, bx);
            pg8::EpiF32 E{(float*)(ws + WS_MIX), D};
            pg8::gemm_phase<pg8::EpiF32, pg8::StaticOrder, true, true>(lds, g, S, E, tid);
            GRID_BAR();
        }
        if (IN(12)) { PHASE_IDS();
            for (int m = gw; m < M; m += NGW) post_row((const float*)(ws + WS_MIX) + (size_t)m * D, A.out + (size_t)m * D, A.in[4] + l * D, A.out + (size_t)m * D, (l + 1 < DEPTH) ? XN + (size_t)m * D : nullptr, lane);
            GRID_BAR();
        }
    }
#undef IN
}

template <int PH> static void launch_ph(int grid, hipStream_t stream, const Args& a) { hipLaunchKernelGGL((mk_fwd<PH, PH + 1>), dim3(grid), dim3(NWAVES * 64), LDS_BYTES, stream, a); }
template <int PH> static void set_lds_ph() { (void)hipFuncSetAttribute((const void*)mk_fwd<PH, PH + 1>, hipFuncAttributeMaxDynamicSharedMemorySize, LDS_BYTES); }
extern "C" void kernel_launch(void* const* d_in, const int* in_sizes, int n_in, void* d_out, int out_size, void* d_ws, size_t ws_size, hipStream_t stream) {
    static int grid = 0;
    if (grid == 0) {
        if (n_in != 27 || out_size != M * D || ws_size < WS_END) { fprintf(stderr, "kernel_launch: unexpected shapes (n_in %d, out %d, ws %zu < %zu)\n", n_in, out_size, ws_size, (size_t)WS_END); grid = -1; return; }
        int dev = 0, cus = 0, per_cu = 0;
        if (hipGetDevice(&dev) != hipSuccess || hipDeviceGetAttribute(&cus, hipDeviceAttributeMultiprocessorCount, dev) != hipSuccess) { grid = -1; return; }
#if MK_MULTI
        set_lds_ph<0>(); set_lds_ph<1>(); set_lds_ph<2>(); set_lds_ph<3>(); set_lds_ph<4>(); set_lds_ph<5>(); set_lds_ph<6>(); set_lds_ph<7>(); set_lds_ph<8>(); set_lds_ph<9>(); set_lds_ph<10>(); set_lds_ph<11>(); set_lds_ph<12>();
#else
        if (hipFuncSetAttribute((const void*)mk_fwd<0, NPH>, hipFuncAttributeMaxDynamicSharedMemorySize, LDS_BYTES) != hipSuccess) { fprintf(stderr, "kernel_launch: hipFuncSetAttribute failed\n"); grid = -1; return; }
        if (hipOccupancyMaxActiveBlocksPerMultiprocessor(&per_cu, (const void*)mk_fwd<0, NPH>, NWAVES * 64, LDS_BYTES) != hipSuccess || per_cu < 1) fprintf(stderr, "kernel_launch: occupancy query reports %d\n", per_cu);
#endif
        (void)hipGetLastError();
        grid = cus;
    }
    if (grid < 0) return;
    if (hipMemsetAsync((char*)d_ws + WS_CTL, 0, CTL_ZERO_BYTES, stream) != hipSuccess) return;
    Args a{};
    for (int i = 0; i < 27; ++i) a.in[i] = (const float*)d_in[i];
    a.out = (float*)d_out; a.ws = (unsigned char*)d_ws;
#if MK_MULTI
    for (int l = 0; l < DEPTH; ++l) { a.l_lo = l; a.l_hi = l + 1;
        launch_ph<0>(grid, stream, a); launch_ph<1>(grid, stream, a); launch_ph<2>(grid, stream, a); launch_ph<3>(grid, stream, a); launch_ph<4>(grid, stream, a); launch_ph<5>(grid, stream, a); launch_ph<6>(grid, stream, a);
        launch_ph<7>(grid, stream, a); launch_ph<8>(grid, stream, a); launch_ph<9>(grid, stream, a); launch_ph<10>(grid, stream, a); launch_ph<11>(grid, stream, a); launch_ph<12>(grid, stream, a); }
#else
    a.l_lo = 0; a.l_hi = DEPTH;
    hipLaunchKernelGGL((mk_fwd<0, NPH>), dim3(grid), dim3(NWAVES * 64), LDS_BYTES, stream, a);
#endif
}
```

```cpp
#include <hip/hip_runtime.h>
#include <cstdio>
#include <cstdint>
namespace pg8 {
#define PG8_LAS __attribute__((address_space(3)))
typedef unsigned short bf16_t;
typedef short bf16x8 __attribute__((ext_vector_type(8)));
typedef float f32x4 __attribute__((ext_vector_type(4)));
typedef unsigned u32x4 __attribute__((ext_vector_type(4)));
constexpr int BM = 256, BK = 64, HALF = 128, HTB = HALF * BK * 2  , STAGE_BYTES = 8 * HTB, NXCD = 8, WGM = 8;

__host__ __device__ __forceinline__ int lds_byte(int r, int c) { const int st = (r >> 4) * 2 + (c >> 5), rr = r & 15, cc = c & 31, ob = rr * 64 + cc * 2; return st * 1024 + (ob ^ (((ob >> 9) & 1) << 5)); }
__host__ __device__ __forceinline__ void stage_rc(int b, int& R, int& C) { const int st = b / 1024, sb = b % 1024, swz = sb ^ (((sb >> 9) & 1) << 5); R = (st >> 1) * 16 + swz / 64; C = (st & 1) * 32 + (swz % 64) / 2; }
__host__ __device__ __forceinline__ int perm32(int rho) { const int n = rho >> 4, i = rho & 15; return 8 * (i >> 2) + 4 * n + (i & 3); }

struct Unit { int pm, pn; };
struct Gemm { const bf16_t* A; const bf16_t* Bt; int M, N, K; int lda, ldb; int agrp, astep; };

struct StaticOrder {
    int nM, nN, nwg, G, c;
    __host__ __device__ void init(int M, int N, int G_, int c_) { nM = M / BM; nN = N / BM; nwg = nM * nN; G = G_; c = c_; }
    __host__ __device__ bool next(int i, Unit& u) const {
        const long L = (long)i * G + c; if (L >= nwg) return false;
        int wgid = (int)L; { const int q = nwg / NXCD, r = nwg % NXCD, xcd = wgid % NXCD, off = wgid / NXCD; wgid = (xcd < r ? xcd * (q + 1) : r * (q + 1) + (xcd - r) * q) + off; }
        const int nig = WGM * nN, gid = wgid / nig, fm = gid * WGM, gsz = (nM - fm) < WGM ? (nM - fm) : WGM;
        u.pm = fm + ((wgid % nig) % gsz); u.pn = (wgid % nig) / gsz; return true;
    }
    __device__ __forceinline__ void a_ready(const Unit&) const {}
    __device__ __forceinline__ void done(const Unit&) const {}
};

typedef float cvt_f32x2_t __attribute__((ext_vector_type(2))); typedef __bf16 cvt_bf16x2_t __attribute__((ext_vector_type(2)));
__device__ __forceinline__ unsigned cvt_pk_bf16(float lo, float hi) { cvt_f32x2_t v = {lo, hi}; cvt_bf16x2_t b = __builtin_convertvector(v, cvt_bf16x2_t); return __builtin_bit_cast(unsigned, b); }
typedef float f32x2 __attribute__((ext_vector_type(2)));
__device__ __forceinline__ f32x2 gelu_pk(f32x2 v) {
    const f32x2 av = __builtin_elementwise_abs(v), d = av * 0.2316418882f + 1.0f;
    f32x2 t; t.x = __builtin_amdgcn_rcpf(d.x); t.y = __builtin_amdgcn_rcpf(d.y);
    f32x2 q = t * 0.5307027145f + (-0.7265760135f); q = q * t + 0.7107068705f; q = q * t + (-0.142248368f); q = q * t + 0.127414796f; q = q * t;
    const f32x2 s = (v * v) * (-0.72134752044f);
    f32x2 e; e.x = __builtin_amdgcn_exp2f(s.x); e.y = __builtin_amdgcn_exp2f(s.y);
    const f32x2 m = v * (q * e), r = v - m;
    f32x2 o; o.x = v.x < 0.f ? m.x : r.x; o.y = v.y < 0.f ? m.y : r.y; return o;
}

template <int ACT  > struct EpiBf16 {
    static constexpr bool PERM = true, AFTER_DRAIN = false; static_assert(ACT == 0 || ACT == 1, "EpiBf16: ACT is 0 (none) or 1 (gelu_pk)");
    bf16_t* O; int ldc; const float* bias; int split_cols; size_t split_stride; float scale0;
    __device__ __forceinline__ void operator()(const f32x4 (&acc)[2][2][4][2], const Unit& u, int wr, int wc, int fr, int fq) const {
        const int row0 = u.pm * BM + wr * 64 + fr; int colt = u.pn * BM; bf16_t* base = O;
        float sc = 1.f; if (split_cols) { const int t = colt / split_cols; base += (size_t)t * split_stride; colt -= t * split_cols; if (t == 0) sc = scale0; }
        const int col0 = colt + wc * 32 + 8 * fq, bcol0 = u.pn * BM + wc * 32 + 8 * fq;
        f32x4 bv[2][2];
#pragma unroll
        for (int bj = 0; bj < 2; ++bj)
#pragma unroll
            for (int n = 0; n < 2; ++n) bv[bj][n] = bias ? *(const f32x4*)(bias + bcol0 + bj * HALF + 4 * n) : (f32x4){0.f, 0.f, 0.f, 0.f};
#pragma unroll
        for (int ai = 0; ai < 2; ++ai)
#pragma unroll
            for (int m = 0; m < 4; ++m) { bf16_t* rowp = base + (size_t)(row0 + ai * HALF + m * 16) * ldc + col0;
#pragma unroll
                for (int bj = 0; bj < 2; ++bj) { f32x4 v0 = acc[ai][bj][m][0] + bv[bj][0], v1 = acc[ai][bj][m][1] + bv[bj][1];
                    if (ACT == 1) { f32x2 a = gelu_pk((f32x2){v0[0], v0[1]}), b = gelu_pk((f32x2){v0[2], v0[3]}), c = gelu_pk((f32x2){v1[0], v1[1]}), d = gelu_pk((f32x2){v1[2], v1[3]});
                        v0 = (f32x4){a.x, a.y, b.x, b.y}; v1 = (f32x4){c.x, c.y, d.x, d.y}; }
                    v0 = v0 * sc; v1 = v1 * sc; u32x4 w; w.x = cvt_pk_bf16(v0[0], v0[1]); w.y = cvt_pk_bf16(v0[2], v0[3]); w.z = cvt_pk_bf16(v1[0], v1[1]); w.w = cvt_pk_bf16(v1[2], v1[3]);
                    *(u32x4*)(rowp + bj * HALF) = w; } }
    }
};

template <class Epi, class Sched, bool ALIGN_EPI = false, bool SP2 = false>
__device__ __forceinline__ void gemm_phase(PG8_LAS unsigned char* lds, const Gemm g, const Sched& S, const Epi& E, const int tid) {
    const int wid = __builtin_amdgcn_readfirstlane(tid >> 6), lane = tid & 63, wr = wid >> 2, wc = wid & 3, fr = lane & 15, fq = lane >> 4;
    const int K = g.K, nt = K / BK;
    unsigned voffA[2], voffB[2];
#pragma unroll
    for (int i = 0; i < 2; ++i) { int R, C; stage_rc(tid * 16 + i * 8192, R, C); const int Rb = Epi::PERM ? ((R & ~31) + perm32(R & 31)) : R;
        voffA[i] = (unsigned)(R * g.lda + C) * 2u; voffB[i] = (unsigned)(Rb * g.ldb + C) * 2u; }
    const size_t kstep = (size_t)(BK * 2);
    const size_t hstepA = (size_t)HALF * g.lda * 2, hstepB = (size_t)HALF * g.ldb * 2;
    const size_t tstepA = 2 * hstepA, tstepB = 2 * hstepB;
    const unsigned ldsw = (unsigned)wid * 1024u;
    const int aoff = lds_byte(wr * 64 + fr, fq * 8), boff = lds_byte(wc * 32 + fr, fq * 8);
#define PG8_SA(b, h) (((b) * 2 + (h)) * HTB)
#define PG8_SB(b, h) ((4 + (b) * 2 + (h)) * HTB)
#define PG8_STAGE(bufoff, gbase, voff) do { _Pragma("unroll") for (int _i = 0; _i < 2; ++_i) \
        __builtin_amdgcn_global_load_lds((const unsigned*)((const char*)(gbase) + (voff)[_i]), (PG8_LAS unsigned*)(lds + (bufoff) + ldsw + _i * 8192), 16, 0, 0); } while (0)
#define PG8_LDA(dst, b, h) do { _Pragma("unroll") for (int m = 0; m < 4; ++m) _Pragma("unroll") for (int k = 0; k < 2; ++k) dst[m][k] = *(const PG8_LAS bf16x8*)(lds + PG8_SA(b, h) + aoff + m * 2048 + k * 1024); } while (0)
#define PG8_LDB(dst, b, h) do { _Pragma("unroll") for (int n = 0; n < 2; ++n) _Pragma("unroll") for (int k = 0; k < 2; ++k) dst[n][k] = *(const PG8_LAS bf16x8*)(lds + PG8_SB(b, h) + boff + n * 2048 + k * 1024); } while (0)
#define PG8_MMA(ai, bj, At, Bt) do { __builtin_amdgcn_s_setprio(1); _Pragma("unroll") for (int m = 0; m < 4; ++m) _Pragma("unroll") for (int n = 0; n < 2; ++n) _Pragma("unroll") for (int k = 0; k < 2; ++k) \
        acc[ai][bj][m][n] = __builtin_amdgcn_mfma_f32_16x16x32_bf16(Bt[n][k], At[m][k], acc[ai][bj][m][n], 0, 0, 0); __builtin_amdgcn_s_setprio(0); } while (0)
#define PG8_WAIT_V(n) asm volatile("s_waitcnt vmcnt(" #n ")" ::: "memory")
#define PG8_WAIT_L(n) asm volatile("s_waitcnt lgkmcnt(" #n ")" ::: "memory")
#define PG8_BAR __builtin_amdgcn_s_barrier()
#define PG8_SCHED __builtin_amdgcn_sched_barrier(0)
    Unit cur, nxt; int ui = 0;
    if (!S.next(0, cur)) return;
    f32x4 acc[2][2][4][2];
#pragma unroll
    for (int a = 0; a < 2; ++a)
#pragma unroll
        for (int b = 0; b < 2; ++b)
#pragma unroll
            for (int m = 0; m < 4; ++m)
#pragma unroll
                for (int n = 0; n < 2; ++n) acc[a][b][m][n] = (f32x4){0.f, 0.f, 0.f, 0.f};
    bf16x8 At[4][2], B0[2][2], B1[2][2];
    const char* cA = (const char*)g.A + (size_t)cur.pm * tstepA + (g.agrp ? (size_t)(cur.pn / g.agrp) * g.astep : (size_t)0); const char* cB = (const char*)g.Bt + (size_t)cur.pn * tstepB;
    S.a_ready(cur);
    if constexpr (SP2) {
        PG8_STAGE(PG8_SB(0, 0), cB, voffB); PG8_STAGE(PG8_SB(0, 1), cB + hstepB, voffB); PG8_STAGE(PG8_SA(0, 0), cA, voffA); PG8_STAGE(PG8_SA(0, 1), cA + hstepA, voffA);
        if (wr == 1) PG8_BAR;
        PG8_WAIT_V(2); PG8_BAR;
        PG8_STAGE(PG8_SB(1, 0), cB + kstep, voffB); PG8_STAGE(PG8_SA(1, 0), cA + kstep, voffA); PG8_STAGE(PG8_SB(1, 1), cB + hstepB + kstep, voffB);
        PG8_WAIT_V(6); PG8_BAR;
    } else {
        PG8_STAGE(PG8_SB(0, 0), cB, voffB); PG8_STAGE(PG8_SA(0, 0), cA, voffA); PG8_STAGE(PG8_SB(0, 1), cB + hstepB, voffB); PG8_STAGE(PG8_SA(0, 1), cA + hstepA, voffA);
        if (wr == 1) PG8_BAR;
        PG8_WAIT_V(4); PG8_BAR;
        PG8_STAGE(PG8_SB(1, 0), cB + kstep, voffB); PG8_STAGE(PG8_SA(1, 0), cA + kstep, voffA); PG8_STAGE(PG8_SB(1, 1), cB + hstepB + kstep, voffB);
        PG8_WAIT_V(6); PG8_BAR;
    }
    for (;;) {
        const bool has_next = S.next(ui + 1, nxt);
        const char* nA = has_next ? (const char*)g.A + (size_t)nxt.pm * tstepA + (g.agrp ? (size_t)(nxt.pn / g.agrp) * g.astep : (size_t)0) : cA; const char* nB = has_next ? (const char*)g.Bt + (size_t)nxt.pn * tstepB : cB;
        for (int t = 0; t < nt; t += 2) {
            const bool last = (t == nt - 2);
            const char* a1 = cA + (size_t)(t + 1) * kstep;
            const char* a2 = last ? nA : cA + (size_t)(t + 2) * kstep; const char* b2 = last ? nB : cB + (size_t)(t + 2) * kstep;
            const char* a3 = a2 + kstep; const char* b3 = b2 + kstep;
            if (last && has_next) S.a_ready(nxt);
            if constexpr (SP2) {
            PG8_LDB(B0, 0, 0); PG8_LDB(B1, 0, 1); PG8_SCHED; PG8_LDA(At, 0, 0); PG8_STAGE(PG8_SA(1, 1), a1 + hstepA, voffA);
            PG8_WAIT_V(8); PG8_WAIT_L(0); PG8_BAR; PG8_MMA(0, 0, At, B0); PG8_MMA(0, 1, At, B1); PG8_BAR; PG8_SCHED;
            PG8_LDA(At, 0, 1); PG8_STAGE(PG8_SB(0, 0), b2, voffB); PG8_STAGE(PG8_SB(0, 1), b2 + hstepB, voffB); PG8_STAGE(PG8_SA(0, 0), a2, voffA);
            PG8_WAIT_V(8); PG8_WAIT_L(0); PG8_BAR; PG8_MMA(1, 0, At, B0); PG8_MMA(1, 1, At, B1); PG8_BAR; PG8_SCHED;
            PG8_LDB(B0, 1, 0); PG8_LDB(B1, 1, 1); PG8_SCHED; PG8_LDA(At, 1, 0); PG8_STAGE(PG8_SA(0, 1), a2 + hstepA, voffA);
            PG8_WAIT_V(8); PG8_WAIT_L(0); PG8_BAR; PG8_MMA(0, 0, At, B0); PG8_MMA(0, 1, At, B1); PG8_BAR; PG8_SCHED;
            PG8_LDA(At, 1, 1); PG8_STAGE(PG8_SB(1, 0), b3, voffB); PG8_STAGE(PG8_SB(1, 1), b3 + hstepB, voffB); PG8_STAGE(PG8_SA(1, 0), a3, voffA);
            PG8_WAIT_V(8); PG8_WAIT_L(0); PG8_BAR; PG8_MMA(1, 0, At, B0); PG8_MMA(1, 1, At, B1); PG8_BAR; PG8_SCHED;
            } else {
            PG8_LDB(B0, 0, 0); PG8_SCHED; PG8_LDA(At, 0, 0); PG8_STAGE(PG8_SA(1, 1), a1 + hstepA, voffA);
            PG8_WAIT_L(8); PG8_BAR; PG8_WAIT_L(0); PG8_MMA(0, 0, At, B0); PG8_BAR; PG8_SCHED;
            PG8_LDB(B1, 0, 1); PG8_STAGE(PG8_SB(0, 0), b2, voffB);
            PG8_BAR; PG8_WAIT_L(0); PG8_MMA(0, 1, At, B1); PG8_BAR;
            PG8_LDA(At, 0, 1); PG8_STAGE(PG8_SA(0, 0), a2, voffA);
            PG8_BAR; PG8_WAIT_L(0); PG8_MMA(1, 0, At, B0); PG8_BAR; PG8_SCHED;
            PG8_STAGE(PG8_SB(0, 1), b2 + hstepB, voffB);
            PG8_WAIT_V(6); PG8_BAR; PG8_MMA(1, 1, At, B1); PG8_BAR;
            PG8_LDB(B0, 1, 0); PG8_SCHED; PG8_LDA(At, 1, 0); PG8_STAGE(PG8_SA(0, 1), a2 + hstepA, voffA);
            PG8_WAIT_L(8); PG8_BAR; PG8_WAIT_L(0); PG8_MMA(0, 0, At, B0); PG8_BAR; PG8_SCHED;
            PG8_LDB(B1, 1, 1); PG8_STAGE(PG8_SB(1, 0), b3, voffB);
            PG8_BAR; PG8_WAIT_L(0); PG8_MMA(0, 1, At, B1); PG8_BAR;
            PG8_LDA(At, 1, 1); PG8_STAGE(PG8_SA(1, 0), a3, voffA);
            PG8_BAR; PG8_WAIT_L(0); PG8_MMA(1, 0, At, B0); PG8_BAR; PG8_SCHED;
            PG8_STAGE(PG8_SB(1, 1), b3 + hstepB, voffB);
            PG8_WAIT_V(6); PG8_BAR; PG8_MMA(1, 1, At, B1); PG8_BAR;
            }
        }
        if constexpr (ALIGN_EPI) { if (wr == 0) PG8_BAR; }
        if constexpr (!Epi::AFTER_DRAIN) { E(acc, cur, wr, wc, fr, fq); S.done(cur); }
        if (!has_next) break;
#pragma unroll
        for (int a = 0; a < 2; ++a)
#pragma unroll
            for (int b = 0; b < 2; ++b)
#pragma unroll
                for (int m = 0; m < 4; ++m)
#pragma unroll
                    for (int n = 0; n < 2; ++n) acc[a][b][m][n] = (f32x4){0.f, 0.f, 0.f, 0.f};
        cur = nxt; cA = nA; cB = nB; ++ui;
        if constexpr (ALIGN_EPI) { if (wr == 1) PG8_BAR; }
    }
    PG8_WAIT_V(0);
    if constexpr (!ALIGN_EPI) { if (wr == 0) PG8_BAR; }
    PG8_BAR;
    if constexpr (Epi::AFTER_DRAIN) { E.fused(acc, cur, wr, wc, fr, fq, lds, wid, lane); S.done(cur); }
#undef PG8_SA
#undef PG8_SB
#undef PG8_STAGE
#undef PG8_LDA
#undef PG8_LDB
#undef PG8_MMA
#undef PG8_WAIT_V
#undef PG8_WAIT_L
#undef PG8_BAR
#undef PG8_SCHED
}
}
#define GAS __attribute__((address_space(1)))
#define LAS __attribute__((address_space(3)))
typedef unsigned short bf16;
typedef unsigned v4u __attribute__((ext_vector_type(4)));
typedef float f32x4 __attribute__((ext_vector_type(4)));
typedef short bf16x8 __attribute__((ext_vector_type(8)));
typedef GAS unsigned gu32;
typedef GAS unsigned long long gu64;
#define RLX_AGENT __ATOMIC_RELAXED, __HIP_MEMORY_SCOPE_AGENT
#define LDS_WAIT() asm volatile("s_waitcnt lgkmcnt(0)" ::: "memory")
#define VM_WAIT() asm volatile("s_waitcnt vmcnt(0)" ::: "memory")
__device__ __forceinline__ unsigned long long rt() { return __builtin_amdgcn_s_memrealtime(); }
__device__ __forceinline__ unsigned f2bf(float f) { unsigned u = __builtin_bit_cast(unsigned, f); return (u + 0x7fffu + ((u >> 16) & 1u)) >> 16; }
__device__ __forceinline__ unsigned pk2(float lo, float hi) { return pg8::cvt_pk_bf16(lo, hi); }

#define XB_TMO      128
#define XB_XCNT(j)  (256  + 64 * (j))
#define XB_XSUB(j)  (1280 + 64 * (j))
#define XB_XGEN(j)  (2304 + 64 * (j))
#define XB_TOP      3328
#define XB_TOPGEN   3392
#define XCD_BAR_WORDS 3456
#define XB_SPIN_CAP (1u << 18)

__device__ __forceinline__ unsigned xb_ld(unsigned* p)              { return __hip_atomic_load(p, __ATOMIC_RELAXED, __HIP_MEMORY_SCOPE_AGENT); }
__device__ __forceinline__ unsigned xb_add(unsigned* p, unsigned v) { return __hip_atomic_fetch_add(p, v, __ATOMIC_RELAXED, __HIP_MEMORY_SCOPE_AGENT); }
__device__ __forceinline__ unsigned xb_xcc_id() { return (unsigned)__builtin_amdgcn_s_getreg((3 << 11) | 20) & 0xFu; }
#define XB_SPIN(cond, bar) do { unsigned _sp = 0; while (cond) { __builtin_amdgcn_s_sleep(1); \
    if ((++_sp & 255u) == 0u) { if (xb_ld(&(bar)[XB_TMO])) break; if (_sp > XB_SPIN_CAP) { atomicAdd(&(bar)[XB_TMO], 1u); break; } } } } while (0)

struct XcdBarrier {
    unsigned* bar; unsigned x;
    volatile LAS unsigned* st;
};

__device__ __forceinline__ XcdBarrier xcd_barrier_post(unsigned* bar, volatile LAS unsigned* st) {
    XcdBarrier b; b.bar = bar; b.x = xb_xcc_id(); b.st = st;
    if (threadIdx.x == 0) (void)xb_add(&bar[XB_XCNT(b.x)], 1u);
    return b;
}
__device__ __forceinline__ void xcd_barrier_complete(unsigned* bar, unsigned x, unsigned& nloc, unsigned& nx) {
    const unsigned G = gridDim.x * gridDim.y * gridDim.z;
    unsigned sum, cnt, mine, sp = 0u;
    for (;;) {
        sum = 0u; cnt = 0u; mine = 0u;
#pragma unroll
        for (unsigned j = 0; j < 16; ++j) { const unsigned c = xb_ld(&bar[XB_XCNT(j)]); sum += c; cnt += (c > 0u) ? 1u : 0u; mine = (j == x) ? c : mine; }
        if (sum == G) break;
        __builtin_amdgcn_s_sleep(1);
        if ((++sp & 255u) == 0u) { if (xb_ld(&bar[XB_TMO])) break; if (sp > XB_SPIN_CAP) { atomicAdd(&bar[XB_TMO], 1u); break; } }
    }
    nloc = mine > 0u ? mine : 1u; nx = cnt > 0u ? cnt : 1u;
}

__device__ __forceinline__ void xcd_barrier(const XcdBarrier& b) {
    asm volatile("s_waitcnt vmcnt(0)" ::: "memory");
    __syncthreads();
    if (threadIdx.x == 0) {
        unsigned* bar = b.bar;
        __builtin_amdgcn_s_waitcnt(0);
        unsigned nloc = b.st[0], nx = b.st[1];
        if (nloc == 0u) { xcd_barrier_complete(bar, b.x, nloc, nx); b.st[0] = nloc; b.st[1] = nx; }
        const unsigned old = xb_add(&bar[XB_XSUB(b.x)], 1u);
        const unsigned gen = old / nloc;
        if (old + 1u == (gen + 1u) * nloc) {
            __builtin_amdgcn_fence(__ATOMIC_RELEASE, "agent");
            asm volatile("s_waitcnt vmcnt(0)" ::: "memory");
            const unsigned og = xb_add(&bar[XB_TOP], 1u);
            const unsigned tg = og / nx;
            if (og + 1u == (tg + 1u) * nx) xb_add(&bar[XB_TOPGEN], 1u);
            else XB_SPIN(xb_ld(&bar[XB_TOPGEN]) == tg, bar);
            __builtin_amdgcn_fence(__ATOMIC_ACQUIRE, "agent");
            xb_add(&bar[XB_XGEN(b.x)], 1u);
            asm volatile("s_waitcnt vmcnt(0)" ::: "memory");
        } else {
            XB_SPIN(xb_ld(&bar[XB_XGEN(b.x)]) == gen, bar);
            __builtin_amdgcn_fence(__ATOMIC_ACQUIRE, "agent");
            asm volatile("s_waitcnt vmcnt(0)" ::: "memory");
        }
    }
    __syncthreads();
}

constexpr int T_ = 4096;
constexpr int NB = 4, T = 4096, D = 1024, M = NB * T, NH = 4, HD = 64, BW = 256, FF = 4096, DEPTH = 4;
constexpr int IN_COLS = 7852, PP = 3840, NG = 4096;
constexpr int NWAVES = 8;
#ifndef PROBE_DUP
#define PROBE_DUP -1
#endif
#ifndef PROBE_SUB
#define PROBE_SUB -1
#endif
#define REP(k) for (int rp_ = 0; rp_ < ((PROBE_SUB == (k)) ? 2 : 1); ++rp_)
#ifndef DBG_MERGE
#define DBG_MERGE 0
#endif
#ifndef DBG_ZERO
#define DBG_ZERO 0
#endif
constexpr float C2 = 0.125f * 1.4426950408889634f;
constexpr float LOG2E = 1.4426950408889634f;
constexpr float NEGBIG = -30000.f;
typedef float f32x16 __attribute__((ext_vector_type(16)));
typedef float f32x2 __attribute__((ext_vector_type(2)));
typedef unsigned u32x2 __attribute__((ext_vector_type(2)));
typedef unsigned u32x4 __attribute__((ext_vector_type(4)));
typedef const __attribute__((address_space(4))) f32x2* c4f2;
typedef const __attribute__((address_space(4))) unsigned* c4u;
typedef const __attribute__((address_space(4))) float* c4f;

constexpr size_t MiB = 1u << 20;
constexpr size_t WS_CTL = 0, CTL_ZERO_BYTES = 1 * MiB;
constexpr size_t WS_WIN = 1 * MiB, WS_WG = 9 * MiB, WS_WB = 17 * MiB, WS_WO = 19 * MiB, WS_WUP = 21 * MiB, WS_WDN = 29 * MiB;
constexpr size_t WS_VFIRST = 37 * MiB;
constexpr size_t WS_XN = 53 * MiB, WS_P = 85 * MiB, WS_SMALL = 205 * MiB;
constexpr size_t WS_SC = 53 * MiB, WS_MASK = 183 * MiB, WS_YL = 191 * MiB, WS_PR = 199 * MiB, WS_OL = 207 * MiB, WS_QD = 215 * MiB;
constexpr size_t WS_BQ = 223 * MiB, WS_BK = 231 * MiB, WS_BVT = 239 * MiB, WS_QI = 247 * MiB, WS_KI = 255 * MiB, WS_WI = 256 * MiB, WS_DQ = 257 * MiB, WS_DK = 265 * MiB, WS_DVT = 273 * MiB;
constexpr size_t WS_FL = 281 * MiB, WS_FB = WS_FL + 256 * 1024, WS_RB = WS_FB + 256 * 1024, WS_HF = WS_RB + 256 * 1024;
constexpr size_t WS_RG = 282 * MiB, WS_HREC = 290 * MiB, WS_HGATE = 330 * MiB, WS_RW = 338 * MiB;
constexpr size_t WS_RSEG = 434 * MiB, WS_HSEG = 466 * MiB, WS_END = 490 * MiB;
constexpr size_t WS_Y = 85 * MiB, WS_G = 117 * MiB, WS_Z = 245 * MiB, WS_MIX = 277 * MiB, WS_U = 117 * MiB;
constexpr size_t SC_PB = (size_t)4096 * 2080;
static_assert(WS_SC + 4 * SC_PB * 4 <= WS_MASK, "scores fit");
constexpr int RREC = 1536;
constexpr int HRECB = 640;
constexpr int RSEGB = 32768, RS_PT = 0, RS_LT = 8192, RS_SS = 24576;
constexpr int HSEGB = 24576, HS_LT = 0, HS_SS = 16384;
static_assert(WS_RW + (size_t)16 * T_ * RREC <= WS_RSEG && WS_HSEG + (size_t)1024 * HSEGB <= WS_END + MiB / 4 && WS_HREC + (size_t)16 * T_ * HRECB <= WS_HGATE, "map");
constexpr int CW_BAR = 4096;

__device__ __forceinline__ float bf2f(unsigned short v) { return __uint_as_float((unsigned)v << 16); }
__device__ __forceinline__ float bflo(unsigned w) { return __uint_as_float(w << 16); }
__device__ __forceinline__ float bfhi(unsigned w) { return __uint_as_float(w & 0xffff0000u); }
template <int O> __device__ __forceinline__ float swz_xor(float v) { return __int_as_float(__builtin_amdgcn_ds_swizzle(__float_as_int(v), (O << 10) | 0x1f)); }
__device__ __forceinline__ float half_sum(float v) { auto rr = __builtin_amdgcn_permlane32_swap(__float_as_uint(v), __float_as_uint(v), false, false); return __uint_as_float(rr[0]) + __uint_as_float(rr[1]); }
__device__ __forceinline__ float half_max(float v) { auto rr = __builtin_amdgcn_permlane32_swap(__float_as_uint(v), __float_as_uint(v), false, false); return fmaxf(__uint_as_float(rr[0]), __uint_as_float(rr[1])); }
__device__ __forceinline__ unsigned wave_sum_u32(unsigned v) {
    v += (unsigned)__builtin_amdgcn_update_dpp(0, (int)v, 0xB1, 0xf, 0xf, false);
    v += (unsigned)__builtin_amdgcn_update_dpp(0, (int)v, 0x4E, 0xf, 0xf, false);
    v += (unsigned)__builtin_amdgcn_update_dpp(0, (int)v, 0x124, 0xf, 0xf, false);
    v += (unsigned)__builtin_amdgcn_update_dpp(0, (int)v, 0x128, 0xf, 0xf, false);
    v += (unsigned)__builtin_amdgcn_ds_swizzle((int)v, (16 << 10) | 0x1f);
    auto rr = __builtin_amdgcn_permlane32_swap(v, v, false, false); return rr[0] + rr[1];
}
__device__ __forceinline__ float wave_sum(float v) {
    v += swz_xor<1>(v); v += swz_xor<2>(v); v += swz_xor<4>(v); v += swz_xor<8>(v); v += swz_xor<16>(v);
    return half_sum(v);
}
__device__ __forceinline__ float sigmoidf_(float x) { return 1.f / (1.f + __expf(-x)); }
__device__ __forceinline__ int crow(int r, int hi) { return (r & 3) + 8 * (r >> 2) + 4 * hi; }
__device__ __forceinline__ size_t sc_rowoff(int b, int t) { const int k = t >> 6; return (size_t)b * SC_PB + (size_t)64 * ((size_t)32 * k * (k + 1) + (size_t)(t - 64 * k) * (k + 1)); }

namespace pg8 {
struct EpiIn {
    static constexpr bool PERM = true, AFTER_DRAIN = false;
    bf16_t* P; float* SM;
    __device__ __forceinline__ void operator()(const f32x4 (&acc)[2][2][4][2], const Unit& u, int wr, int wc, int fr, int fq) const {
        const int row0 = u.pm * BM + wr * 64 + fr; const int col0 = wc * 32 + 8 * fq;
        if (u.pn == 11) {
#pragma unroll
            for (int ai = 0; ai < 2; ++ai)
#pragma unroll
                for (int m = 0; m < 4; ++m) { float* rowp = SM + (size_t)(row0 + ai * HALF + m * 16) * 256 + col0;
#pragma unroll
                    for (int bj = 0; bj < 2; ++bj) { *(f32x4*)(rowp + bj * HALF) = acc[ai][bj][m][0]; *(f32x4*)(rowp + bj * HALF + 4) = acc[ai][bj][m][1]; } }
        } else {
#pragma unroll
            for (int ai = 0; ai < 2; ++ai)
#pragma unroll
                for (int m = 0; m < 4; ++m) { bf16_t* rowp = P + (size_t)(row0 + ai * HALF + m * 16) * PP + u.pn * BM + col0;
#pragma unroll
                    for (int bj = 0; bj < 2; ++bj) { const f32x4 v0 = acc[ai][bj][m][0], v1 = acc[ai][bj][m][1];
                        u32x4 w; w.x = cvt_pk_bf16(v0[0], v0[1]); w.y = cvt_pk_bf16(v0[2], v0[3]); w.z = cvt_pk_bf16(v1[0], v1[1]); w.w = cvt_pk_bf16(v1[2], v1[3]);
                        *(u32x4*)(rowp + bj * HALF) = w; } }
        }
    }
};
template <int ACT> struct EpiAct {
    static constexpr bool PERM = true, AFTER_DRAIN = false;
    bf16_t* O; int ldc;
    __device__ __forceinline__ float f(float x) const { if (ACT == 0 && DBG_MERGE == 3) return 1.f; if (ACT == 0) return __builtin_amdgcn_rcpf(1.f + __builtin_amdgcn_exp2f(-1.4426950408889634f * x)); const float r = x > 0.f ? x : 0.f; return r * r; }
    __device__ __forceinline__ void operator()(const f32x4 (&acc)[2][2][4][2], const Unit& u, int wr, int wc, int fr, int fq) const {
        const int row0 = u.pm * BM + wr * 64 + fr; const int col0 = u.pn * BM + wc * 32 + 8 * fq;
#pragma unroll
        for (int ai = 0; ai < 2; ++ai)
#pragma unroll
            for (int m = 0; m < 4; ++m) { bf16_t* rowp = O + (size_t)(row0 + ai * HALF + m * 16) * ldc + col0;
#pragma unroll
                for (int bj = 0; bj < 2; ++bj) { const f32x4 v0 = acc[ai][bj][m][0], v1 = acc[ai][bj][m][1];
                    u32x4 w; w.x = cvt_pk_bf16(f(v0[0]), f(v0[1])); w.y = cvt_pk_bf16(f(v0[2]), f(v0[3])); w.z = cvt_pk_bf16(f(v1[0]), f(v1[1])); w.w = cvt_pk_bf16(f(v1[2]), f(v1[3]));
                    *(u32x4*)(rowp + bj * HALF) = w; } }
    }
};
struct EpiMerge {
    static constexpr bool PERM = true, AFTER_DRAIN = false;
    const bf16_t* G; bf16_t* Z;
    __device__ __forceinline__ void operator()(const f32x4 (&acc)[2][2][4][2], const Unit& u, int wr, int wc, int fr, int fq) const {
        const int n = u.pn >> 2, ct = u.pn & 3;
        asm volatile("" : "+v"(fr), "+v"(fq));
        const int row0 = u.pm * BM + wr * 64 + fr; const int col0 = wc * 32 + 8 * fq;
#pragma unroll
        for (int ai = 0; ai < 2; ++ai)
#pragma unroll
            for (int m = 0; m < 4; ++m) { const size_t row = (size_t)(row0 + ai * HALF + m * 16);
                const bf16_t* gp = G + row * NG + u.pn * BM + col0; bf16_t* zp = Z + row * D + ct * BM + col0;
#pragma unroll
                for (int bj = 0; bj < 2; ++bj) { const f32x4 v0 = acc[ai][bj][m][0], v1 = acc[ai][bj][m][1];
                    u32x4 gw = *(const u32x4*)(gp + bj * HALF);
                    if (DBG_MERGE == 1) gw = (u32x4){0x3f803f80u, 0x3f803f80u, 0x3f803f80u, 0x3f803f80u};
                    if (DBG_MERGE == 2 && n > 0) continue;
                    float o[8];
                    o[0] = v0[0] * __uint_as_float(gw.x << 16); o[1] = v0[1] * __uint_as_float(gw.x & 0xffff0000u);
                    o[2] = v0[2] * __uint_as_float(gw.y << 16); o[3] = v0[3] * __uint_as_float(gw.y & 0xffff0000u);
                    o[4] = v1[0] * __uint_as_float(gw.z << 16); o[5] = v1[1] * __uint_as_float(gw.z & 0xffff0000u);
                    o[6] = v1[2] * __uint_as_float(gw.w << 16); o[7] = v1[3] * __uint_as_float(gw.w & 0xffff0000u);
                    if (n > 0) { const u32x4 zw = *(const u32x4*)(zp + bj * HALF);
                        o[0] += __uint_as_float(zw.x << 16); o[1] += __uint_as_float(zw.x & 0xffff0000u); o[2] += __uint_as_float(zw.y << 16); o[3] += __uint_as_float(zw.y & 0xffff0000u);
                        o[4] += __uint_as_float(zw.z << 16); o[5] += __uint_as_float(zw.z & 0xffff0000u); o[6] += __uint_as_float(zw.w << 16); o[7] += __uint_as_float(zw.w & 0xffff0000u); }
                    u32x4 w; w.x = cvt_pk_bf16(o[0], o[1]); w.y = cvt_pk_bf16(o[2], o[3]); w.z = cvt_pk_bf16(o[4], o[5]); w.w = cvt_pk_bf16(o[6], o[7]);
                    *(u32x4*)(zp + bj * HALF) = w; }
                asm volatile("" ::: "memory"); }
    }
};
struct EpiF32 {
    static constexpr bool PERM = false, AFTER_DRAIN = false;
    float* O; int ldc;
    __device__ __forceinline__ void operator()(const f32x4 (&acc)[2][2][4][2], const Unit& u, int wr, int wc, int fr, int fq) const {
        const int row0 = u.pm * BM + wr * 64 + fr; const int col0 = u.pn * BM + wc * 32 + 4 * fq;
#pragma unroll
        for (int ai = 0; ai < 2; ++ai)
#pragma unroll
            for (int m = 0; m < 4; ++m) { float* rowp = O + (size_t)(row0 + ai * HALF + m * 16) * ldc + col0;
#pragma unroll
                for (int bj = 0; bj < 2; ++bj)
#pragma unroll
                    for (int n = 0; n < 2; ++n) *(f32x4*)(rowp + bj * HALF + n * 16) = acc[ai][bj][m][n]; }
    }
};
struct MergeOrder {
    int G, c;
    __host__ __device__ bool next(int i, Unit& u) const { const int ot = c + (i >> 2) * G; if (ot >= 256) return false; u.pm = ot >> 2; u.pn = (i & 3) * 4 + (ot & 3); return true; }
    __device__ __forceinline__ void a_ready(const Unit&) const {}
    __device__ __forceinline__ void done(const Unit&) const {}
};
}

__device__ __forceinline__ int in_src(int c, float& sc) {
    const int t = c >> 8, j = c & 255; sc = 1.f;
    switch (t) {
        case 0: sc = 0.125f; return j;
        case 1: return 256 + j;
        case 2: return 512 + j;
        case 3: return 768 + j;
        case 4: sc = C2; return 1024 + j;
        case 5: return 1280 + j;
        case 6: return 1536 + j;
        case 7: sc = 0.17677669529663687f; return 1792 + j;
        case 8: return 2088 + j;
        case 9: return 2344 + j;
        case 10: return 2600 + j;
        case 11: if (j < 128) return 2856 + j; if (j < 160) return 2048 + (j - 128); if (j < 168) { sc = 0.35355339059327373f; return 2080 + (j - 160); } if (j < 172) return 3752 + (j - 168); return -1;
        case 12: sc = C2; return 2984 + j;
        case 13: return 3240 + j;
        default: return 3496 + j;
    }
}
__device__ __forceinline__ void wt_item(const float* W, int ldw, int kind, int coff, const float* gk, bf16* WT, int K, int kb, int nb, LAS float* scr, int lane) {
    const int k0 = 64 * kb, n0 = 32 * nb;
    const int c = n0 + (lane & 31); float sc = 1.f; const int src = (kind == 1) ? in_src(c, sc) : coff + c;
#pragma unroll 8
    for (int i = 0; i < 32; ++i) { const int kk = 2 * i + (lane >> 5); float v = 0.f; if (src >= 0) v = W[(size_t)(k0 + kk) * ldw + src] * sc; if (gk) v *= gk[k0 + kk]; scr[kk * 33 + (lane & 31)] = v; }
    LDS_WAIT(); asm volatile("" ::: "memory");
    const int cc = lane & 7;
#pragma unroll
    for (int j = 0; j < 4; ++j) { const int n = (lane >> 3) + 8 * j; const LAS float* s = scr + (8 * cc) * 33 + n;
        v4u o; o.x = pk2(s[0 * 33], s[1 * 33]); o.y = pk2(s[2 * 33], s[3 * 33]); o.z = pk2(s[4 * 33], s[5 * 33]); o.w = pk2(s[6 * 33], s[7 * 33]);
        *(GAS v4u*)(WT + (size_t)(n0 + n) * K + k0 + 8 * cc) = o; }
    LDS_WAIT(); asm volatile("" ::: "memory");
}
template <int R>
__device__ __forceinline__ void rms_rows_to_bf16(const float* x0, bf16* o0, size_t rstride, int lane) {
    f32x4 v[R][4]; float s[R];
#pragma unroll
    for (int r = 0; r < R; ++r) { const GAS f32x4* xr = (const GAS f32x4*)(x0 + r * rstride * D) + lane; s[r] = 0.f;
#pragma unroll
        for (int j = 0; j < 4; ++j) v[r][j] = xr[64 * j]; }
#pragma unroll
    for (int r = 0; r < R; ++r)
#pragma unroll
        for (int j = 0; j < 4; ++j) s[r] += (v[r][j].x * v[r][j].x + v[r][j].y * v[r][j].y) + (v[r][j].z * v[r][j].z + v[r][j].w * v[r][j].w);
#pragma unroll
    for (int r = 0; r < R; ++r) s[r] = wave_sum(s[r]);
#pragma unroll
    for (int r = 0; r < R; ++r) { const float rstd = 1.f / sqrtf(s[r] * (1.f / D) + 1e-6f);
        GAS unsigned long long* o8 = (GAS unsigned long long*)(o0 + r * rstride * D) + lane;
#pragma unroll
        for (int j = 0; j < 4; ++j) o8[64 * j] = (unsigned long long)pk2(v[r][j].x * rstd, v[r][j].y * rstd) | ((unsigned long long)pk2(v[r][j].z * rstd, v[r][j].w * rstd) << 32); }
}
template <int R>
__device__ __forceinline__ void post_rows(const float* mix0, const float* xold0, const float* g, float* xout0, bf16* xn0, size_t rstride, int lane) {
    f32x4 v[R][4], xo[R][4]; float s[R], s2[R];
    const GAS f32x4* gr = (const GAS f32x4*)g + lane;
#pragma unroll
    for (int r = 0; r < R; ++r) { const GAS f32x4* mr = (const GAS f32x4*)(mix0 + r * rstride * D) + lane; const GAS f32x4* xr = (const GAS f32x4*)(xold0 + r * rstride * D) + lane; s[r] = 0.f; s2[r] = 0.f;
#pragma unroll
        for (int j = 0; j < 4; ++j) { v[r][j] = mr[64 * j]; xo[r][j] = xr[64 * j]; } }
#pragma unroll
    for (int r = 0; r < R; ++r)
#pragma unroll
        for (int j = 0; j < 4; ++j) s[r] += (v[r][j].x * v[r][j].x + v[r][j].y * v[r][j].y) + (v[r][j].z * v[r][j].z + v[r][j].w * v[r][j].w);
#pragma unroll
    for (int r = 0; r < R; ++r) s[r] = wave_sum(s[r]);
#pragma unroll
    for (int r = 0; r < R; ++r) { const float rstd = 1.f / sqrtf(s[r] * (1.f / D) + 1e-6f);
        GAS f32x4* orow = (GAS f32x4*)(xout0 + r * rstride * D) + lane;
#pragma unroll
        for (int j = 0; j < 4; ++j) { const f32x4 gg = gr[64 * j]; v[r][j] = xo[r][j] + v[r][j] * rstd * gg; s2[r] += (v[r][j].x * v[r][j].x + v[r][j].y * v[r][j].y) + (v[r][j].z * v[r][j].z + v[r][j].w * v[r][j].w); orow[64 * j] = v[r][j]; } }
    if (xn0) {
#pragma unroll
        for (int r = 0; r < R; ++r) s2[r] = wave_sum(s2[r]);
#pragma unroll
        for (int r = 0; r < R; ++r) { const float rstd2 = 1.f / sqrtf(s2[r] * (1.f / D) + 1e-6f);
            GAS unsigned long long* o8 = (GAS unsigned long long*)(xn0 + r * rstride * D) + lane;
#pragma unroll
            for (int j = 0; j < 4; ++j) o8[64 * j] = (unsigned long long)pk2(v[r][j].x * rstd2, v[r][j].y * rstd2) | ((unsigned long long)pk2(v[r][j].z * rstd2, v[r][j].w * rstd2) << 32); }
    }
}

struct Args { const float* in[27]; float* out; unsigned char* ws; int l_lo, l_hi; };

__device__ __forceinline__ void rope_pair(float a, float b, float ang, float& oa, float& ob) {
    float rev = ang * 0.15915494309189535f; rev -= floorf(rev);
    const float sn = __builtin_amdgcn_sinf(rev), cs = __builtin_amdgcn_cosf(rev);
    oa = a * cs - b * sn; ob = b * cs + a * sn;
}
__device__ __forceinline__ void prep_token(const Args& A, unsigned char* ws, int l, int m, int lane) {
    const bf16* prow = (const bf16*)(ws + WS_P) + (size_t)m * PP; const float* srow = (const float*)(ws + WS_SMALL) + (size_t)m * 256;
    const int t = m & (T - 1);
    {
        const u32x2 w = *(const u32x2*)(prow + 256 + 4 * lane);
        const float fl[4] = {bflo(w.x), bfhi(w.x), bflo(w.y), bfhi(w.y)};
        f32x4 e[4]; const float* lbl = A.in[8];
#pragma unroll
        for (int q = 0; q < 4; ++q) e[q] = *(const f32x4*)(lbl + q * 256 + 4 * lane);
        f32x4 o;
#pragma unroll
        for (int i = 0; i < 4; ++i) { const float mx = fmaxf(fmaxf(e[0][i], e[1][i]), fmaxf(e[2][i], e[3][i]));
            float ex[4], sum = 0.f, part = 0.f;
#pragma unroll
            for (int q = 0; q < 4; ++q) { ex[q] = __expf(e[q][i] - mx); sum += ex[q]; }
#pragma unroll
            for (int q = 1; q < 4; ++q) if (q <= l) part += ex[q];
            const float lb = part / sum; o[i] = lb + (1.f - lb) * sigmoidf_(fl[i]); }
        const int hh = lane >> 4, d0 = (4 * lane) & 63; const int b = m >> 12;
        unsigned char* hr = ws + WS_HREC + ((size_t)((b * NH + hh) * T + t)) * HRECB;
        *(f32x4*)(hr + d0 * 4) = o;
        const u32x2 qw = *(const u32x2*)(prow + 4 * lane);
        *(f32x4*)(hr + 256 + d0 * 4) = (f32x4){bflo(qw.x), bfhi(qw.x), bflo(qw.y), bfhi(qw.y)};
        *(u32x2*)(hr + 512 + d0 * 2) = *(const u32x2*)(prow + 512 + 4 * lane);
        const u32x2 gw = *(const u32x2*)(prow + 768 + 4 * lane);
        const float g0 = bflo(gw.x), g1 = bfhi(gw.x), g2 = bflo(gw.y), g3 = bfhi(gw.y);
        *(u32x2*)((bf16*)(ws + WS_HGATE) + (size_t)m * 256 + 4 * lane) = (u32x2){pk2(g0 * sigmoidf_(g0), g1 * sigmoidf_(g1)), pk2(g2 * sigmoidf_(g2), g3 * sigmoidf_(g3))};
        if (lane < 8) ((float*)(ws + WS_WI))[(size_t)m * 8 + lane] = srow[160 + lane];
    }
    {
        const int hh = lane >> 4, j0 = (lane & 15) * 2;
        const float tf = (float)t;
        const float a0 = tf * exp2f(-(float)j0 * (13.287712379549449f / 32.f)), a1 = tf * exp2f(-(float)(j0 + 1) * (13.287712379549449f / 32.f));
#pragma unroll
        for (int which = 0; which < 2; ++which) {
            const bf16* src = prow + (which ? 1280 : 1024) + hh * 64 + j0;
            bf16* dst = (bf16*)(ws + (which ? WS_BK : WS_BQ)) + (size_t)m * 256 + hh * 64 + j0;
            const unsigned w1 = *(const unsigned*)src, w2 = *(const unsigned*)(src + 32);
            float o1a, o2a, o1b, o2b; rope_pair(bflo(w1), bflo(w2), a0, o1a, o2a); rope_pair(bfhi(w1), bfhi(w2), a1, o1b, o2b);
            *(unsigned*)dst = pk2(o1a, o1b); *(unsigned*)(dst + 32) = pk2(o2a, o2b);
        }
    }
    {
        const int ih = lane >> 3, j0 = (lane & 7) * 2; const float tf = (float)t;
        const float a0 = tf * exp2f(-(float)j0 * (13.287712379549449f / 16.f)), a1 = tf * exp2f(-(float)(j0 + 1) * (13.287712379549449f / 16.f));
        const bf16* src = prow + 1792 + ih * 32 + j0; bf16* dst = (bf16*)(ws + WS_QI) + (size_t)m * 256 + ih * 32 + j0;
        const unsigned w1 = *(const unsigned*)src, w2 = *(const unsigned*)(src + 16);
        float o1a, o2a, o1b, o2b; rope_pair(bflo(w1), bflo(w2), a0, o1a, o2a); rope_pair(bfhi(w1), bfhi(w2), a1, o1b, o2b);
        *(unsigned*)dst = pk2(o1a, o1b); *(unsigned*)(dst + 16) = pk2(o2a, o2b);
        if (lane < 16) {
            const float ang = tf * exp2f(-(float)lane * (13.287712379549449f / 16.f));
            float oa, ob; rope_pair(srow[128 + lane], srow[128 + lane + 16], ang, oa, ob);
            bf16* kd = (bf16*)(ws + WS_KI) + (size_t)m * 32; kd[lane] = (bf16)f2bf(oa); kd[lane + 16] = (bf16)f2bf(ob);
        }
        if (lane < 4) {
            const float x = srow[168 + lane] + A.in[10][l * 4 + lane];
            ((float*)(ws + WS_FL))[(size_t)m * 4 + lane] = fminf(x, 0.f) - log1pf(__expf(-fabsf(x)));
        }
    }
    {
        *(u32x2*)((bf16*)(ws + WS_DQ) + (size_t)m * 256 + 4 * lane) = *(const u32x2*)(prow + 3072 + 4 * lane);
        *(u32x2*)((bf16*)(ws + WS_DK) + (size_t)m * 256 + 4 * lane) = *(const u32x2*)(prow + 3328 + 4 * lane);
    }
}
__device__ __forceinline__ void prep_vt(unsigned char* ws, int item, LAS unsigned char* scr, int lane) {
    const int which = item >> 10, r = item & 1023, b = r >> 8, tb = (r >> 2) & 63, hh = r & 3;
    const bf16* src = (const bf16*)(ws + WS_P) + (size_t)(b * T + 64 * tb) * PP + (which ? 3584 : 1536) + hh * 64;
    bf16* dst = (bf16*)(ws + (which ? WS_DVT : WS_BVT)) + (size_t)((b * NH + hh) * 64) * T + 64 * tb;
#pragma unroll
    for (int i = 0; i < 8; ++i) { const int rr = 8 * i + (lane >> 3), ch = lane & 7; const v4u v = *(const v4u*)(src + (size_t)rr * PP + ch * 8);
        LAS unsigned* p = (LAS unsigned*)(scr + rr * 132 + ch * 16); p[0] = v.x; p[1] = v.y; p[2] = v.z; p[3] = v.w; }
    LDS_WAIT(); asm volatile("" ::: "memory");
#pragma unroll
    for (int i = 0; i < 8; ++i) { const int d = 8 * i + (lane >> 3), tc = lane & 7; unsigned short e[8];
#pragma unroll
        for (int k = 0; k < 8; ++k) e[k] = *(const LAS unsigned short*)(scr + (tc * 8 + k) * 132 + d * 2);
        v4u o; o.x = e[0] | ((unsigned)e[1] << 16); o.y = e[2] | ((unsigned)e[3] << 16); o.z = e[4] | ((unsigned)e[5] << 16); o.w = e[6] | ((unsigned)e[7] << 16);
        *(v4u*)(dst + (size_t)d * T + tc * 8) = o; }
    LDS_WAIT(); asm volatile("" ::: "memory");
}
__device__ __forceinline__ void prep_rwkv(const Args& A, unsigned char* ws, int l, LAS unsigned char* lds, const int tid, const int bx, const int G) {
    const int c = tid & 255, grp = tid >> 8, lane = tid & 63, hh = c >> 6;
    LAS float* g2s = (LAS float*)lds;
    LAS float* w2s = (LAS float*)(lds + 65536);
    LAS float* a2s = (LAS float*)(lds + 98304);
    LAS f32x4* sm = (LAS f32x4*)(lds + 131072 + 1024) + grp * 544;
    LAS f32x4* tws = sm; LAS f32x4* ains = sm + 32; LAS f32x4* sgs = sm + 64; LAS f32x4* vs = sm + 128; LAS f32x4* vvp = sm + 384; LAS f32x4* vvs = sm + 512;
    const float* mu = A.in[11] + l * 896; const float* w2 = A.in[13] + (size_t)l * 32 * 256; const float* a2 = A.in[15] + (size_t)l * 32 * 256; const float* g2 = A.in[16] + (size_t)l * 64 * 256;
    for (int i = tid; i < 64 * 256; i += 512) g2s[i] = g2[i];
    for (int i = tid; i < 32 * 256; i += 512) { w2s[i] = w2[i]; a2s[i] = a2[i]; }
    float v2c[32], v1p[32];
    const int jq = c & 31, sq = c >> 5;
    if (l > 0) { const float* v1 = A.in[23] + (size_t)(l - 1) * 256 * 32; const float* v2 = A.in[24] + (size_t)(l - 1) * 32 * 256;
#pragma unroll
        for (int j = 0; j < 32; ++j) { v2c[j] = v2[j * 256 + c]; v1p[j] = v1[(32 * sq + j) * 32 + jq]; } }
    else {
#pragma unroll
        for (int j = 0; j < 32; ++j) { v2c[j] = 0.f; v1p[j] = 0.f; } }
    const float mur = mu[c], muk = mu[256 + c], muv = mu[512 + c], mus = (c < 128) ? mu[768 + c] : 0.f;
    const float w0 = A.in[12][l * 256 + c], a0 = A.in[14][l * 256 + c], v0 = (l > 0) ? A.in[22][(l - 1) * 256 + c] : 0.f;
    const float kkc = A.in[17][l * 256 + c], kac = A.in[18][l * 256 + c], rkc = A.in[19][l * 256 + c];
    __syncthreads();
    const bf16* P = (const bf16*)(ws + WS_P); const float* SM = (const float*)(ws + WS_SMALL);
    float* VF = (float*)(ws + WS_VFIRST); float* RW = (float*)(ws + WS_RW); bf16* RG = (bf16*)(ws + WS_RG); float* RB = (float*)(ws + WS_RB);
    for (int it = bx; it < M / 8; it += G) {
        const int m0 = it * 8 + grp * 4, t0 = m0 & (T - 1), b = m0 >> 12;
        const bf16* pr = P + (size_t)m0 * PP + 2048 + c; const float* sr = SM + (size_t)m0 * 256 + c;
        float rr[5], kr[5], vr[5], ss[5], vf[4];
#pragma unroll
        for (int i = 0; i < 5; ++i) { const bool ok = (i > 0) || (t0 > 0); const long off = (long)(i - 1) * PP;
            rr[i] = ok ? bf2f(pr[off]) : 0.f; kr[i] = ok ? bf2f(pr[off + 256]) : 0.f; vr[i] = ok ? bf2f(pr[off + 512]) : 0.f;
            ss[i] = (ok && c < 128) ? sr[(long)(i - 1) * 256] : 0.f; }
        if (l > 0) {
#pragma unroll
            for (int i = 0; i < 4; ++i) vf[i] = VF[(size_t)(m0 + i) * 256 + c]; }
        float r[4], k[4], v[4];
#pragma unroll
        for (int i = 0; i < 4; ++i) { r[i] = rr[i + 1] + (rr[i] - rr[i + 1]) * mur; k[i] = kr[i + 1] + (kr[i] - kr[i + 1]) * muk; v[i] = vr[i + 1] + (vr[i] - vr[i + 1]) * muv; }
        if (c < 128) { f32x4 x;
#pragma unroll
            for (int i = 0; i < 4; ++i) { const float xs = ss[i + 1] + (ss[i] - ss[i + 1]) * mus; x[i] = (c < 32) ? tanhf(xs) : (c < 64) ? xs : sigmoidf_(xs); }
            if (c < 32) tws[c] = x; else if (c < 64) ains[c - 32] = x; else sgs[c - 64] = x; }
        if (l > 0) vs[c] = (f32x4){v[0], v[1], v[2], v[3]};
        __syncthreads();
        float wl[4], al[4], g[4];
#pragma unroll
        for (int i = 0; i < 4; ++i) { wl[i] = w0; al[i] = a0; g[i] = 0.f; }
#pragma unroll 8
        for (int j = 0; j < 32; ++j) { const float w2v = w2s[j * 256 + c], a2v = a2s[j * 256 + c]; const f32x4 t4 = tws[j], n4 = ains[j];
#pragma unroll
            for (int i = 0; i < 4; ++i) { wl[i] += t4[i] * w2v; al[i] += n4[i] * a2v; } }
#pragma unroll 8
        for (int j = 0; j < 64; ++j) { const float g2v = g2s[j * 256 + c]; const f32x4 s4 = sgs[j];
#pragma unroll
            for (int i = 0; i < 4; ++i) g[i] += s4[i] * g2v; }
        if (l > 0) { float part[4] = {0.f, 0.f, 0.f, 0.f};
#pragma unroll
            for (int j = 0; j < 32; ++j) { const f32x4 v4 = vs[32 * sq + j];
#pragma unroll
                for (int i = 0; i < 4; ++i) part[i] += v4[i] * v1p[j]; }
#pragma unroll
            for (int i = 0; i < 4; ++i) part[i] = half_sum(part[i]);
            if (lane < 32) vvp[hh * 32 + lane] = (f32x4){part[0], part[1], part[2], part[3]}; }
        __syncthreads();
        if (l > 0) {
            if (c < 32) vvs[c] = vvp[c] + vvp[32 + c] + vvp[64 + c] + vvp[96 + c];
            __syncthreads();
            float vg[4] = {v0, v0, v0, v0};
#pragma unroll
            for (int j = 0; j < 32; ++j) { const f32x4 q4 = vvs[j];
#pragma unroll
                for (int i = 0; i < 4; ++i) vg[i] += q4[i] * v2c[j]; }
#pragma unroll
            for (int i = 0; i < 4; ++i) v[i] = v[i] + (vf[i] - v[i]) * sigmoidf_(vg[i]);
        } else {
#pragma unroll
            for (int i = 0; i < 4; ++i) VF[(size_t)(m0 + i) * 256 + c] = v[i]; }
#pragma unroll
        for (int i = 0; i < 4; ++i) {
            const float a = sigmoidf_(al[i]);
            const float decay = __expf(-0.6065306597126334f * sigmoidf_(wl[i]));
            float kk = k[i] * kkc; const float s2 = wave_sum(kk * kk); kk *= rsqrtf(fmaxf(s2, 1e-24f));
            const float k2 = k[i] * (1.f + (a - 1.f) * kac);
            const float bon = wave_sum(r[i] * k2 * rkc);
            float* rec = RW + ((size_t)((b * NH + hh) * T + t0 + i)) * (RREC / 4);
            rec[lane] = decay; rec[64 + lane] = kk; rec[128 + lane] = kk * a; rec[192 + lane] = k2; rec[256 + lane] = r[i]; rec[320 + lane] = v[i];
            RG[(size_t)(m0 + i) * 256 + c] = (bf16)f2bf(g[i]);
            if (lane == 0) RB[(size_t)(m0 + i) * 4 + hh] = bon;
        }
        __syncthreads();
    }
}

__device__ __forceinline__ void rwkv_pass1(unsigned char* ws, LAS unsigned char* buf, int u, int lane) {
    asm volatile("" : "+v"(lane));
    const int bh = u >> 6, seg = u & 63, b = bh >> 2, hh = bh & 3;
    f32x2 SL[32], SI[32];
#pragma unroll
    for (int i = 0; i < 32; ++i) { SL[i] = (f32x2){0.f, 0.f}; SI[i] = (f32x2){(2 * i == lane) ? 1.f : 0.f, (2 * i + 1 == lane) ? 1.f : 0.f}; }
    const unsigned char* rec = ws + WS_RW + ((size_t)(bh * T + seg * 64)) * RREC;
    bf16* ylp = (bf16*)(ws + WS_YL) + ((size_t)(b * T + seg * 64)) * 256 + hh * 64 + lane;
    bf16* prp = (bf16*)(ws + WS_PR) + ((size_t)(b * T + seg * 64)) * 256 + hh * 64 + lane;
#define R1_DMA(sub) do { _Pragma("unroll") for (int c_ = 0; c_ < 6; ++c_) \
        __builtin_amdgcn_global_load_lds((const unsigned*)(rec + (size_t)(sub) * 6144 + c_ * 1024 + lane * 16), (LAS unsigned*)(buf + ((sub) & 1) * 6144 + c_ * 1024), 16, 0, 0); } while (0)
    R1_DMA(0);
#pragma unroll 1
    for (int sub = 0; sub < 16; ++sub) {
        asm volatile("s_waitcnt vmcnt(0)" ::: "memory");
        if (sub + 1 < 16) R1_DMA(sub + 1);
        const LAS unsigned char* cur = buf + (sub & 1) * 6144;
#pragma unroll 1
        for (int tl = 0; tl < 4; ++tl) {
            const LAS f32x4* W4 = (const LAS f32x4*)(cur + tl * RREC);
            const float vv = *(const LAS float*)(cur + tl * RREC + 1280 + lane * 4);
            f32x2 aL = (f32x2){0.f, 0.f}, aI = (f32x2){0.f, 0.f};
#pragma unroll
            for (int i = 0; i < 16; ++i) { const f32x4 kq = W4[16 + i]; const f32x2 k0 = (f32x2){kq.x, kq.y}, k1 = (f32x2){kq.z, kq.w};
                aL += SL[2 * i] * k0; aL += SL[2 * i + 1] * k1; aI += SI[2 * i] * k0; aI += SI[2 * i + 1] * k1;
                if ((i & 3) == 3) __builtin_amdgcn_sched_barrier(0); }
            const float saL = aL.x + aL.y, saI = aI.x + aI.y;
            f32x2 yL = (f32x2){0.f, 0.f}, yI = (f32x2){0.f, 0.f};
#pragma unroll
            for (int i = 0; i < 16; ++i) { const f32x4 w4 = W4[i], b4 = W4[32 + i], k4 = W4[48 + i], r4 = W4[64 + i];
                const f32x2 w0 = (f32x2){w4.x, w4.y}, w1 = (f32x2){w4.z, w4.w}, b0 = (f32x2){b4.x, b4.y}, b1 = (f32x2){b4.z, b4.w};
                const f32x2 kp0 = (f32x2){k4.x, k4.y}, kp1 = (f32x2){k4.z, k4.w}, r0 = (f32x2){r4.x, r4.y}, r1 = (f32x2){r4.z, r4.w};
                f32x2 s0 = SL[2 * i] * w0; s0 -= saL * b0; s0 += vv * kp0; SL[2 * i] = s0; yL += s0 * r0;
                f32x2 s1 = SL[2 * i + 1] * w1; s1 -= saL * b1; s1 += vv * kp1; SL[2 * i + 1] = s1; yL += s1 * r1;
                f32x2 t0 = SI[2 * i] * w0; t0 -= saI * b0; SI[2 * i] = t0; yI += t0 * r0;
                f32x2 t1 = SI[2 * i + 1] * w1; t1 -= saI * b1; SI[2 * i + 1] = t1; yI += t1 * r1;
                if (i & 1) __builtin_amdgcn_sched_barrier(0); }
            const int t = sub * 4 + tl;
            ylp[(size_t)t * 256] = (bf16)f2bf(yL.x + yL.y); prp[(size_t)t * 256] = (bf16)f2bf(yI.x + yI.y);
        }
    }
#undef R1_DMA
    unsigned char* sg = ws + WS_RSEG + (size_t)u * RSEGB;
    bf16* PT = (bf16*)(sg + RS_PT); float* LT = (float*)(sg + RS_LT);
#pragma unroll
    for (int i = 0; i < 32; ++i) { LT[(2 * i) * 64 + lane] = SL[i].x; LT[(2 * i + 1) * 64 + lane] = SL[i].y; PT[(2 * i) * 64 + lane] = (bf16)f2bf(SI[i].x); PT[(2 * i + 1) * 64 + lane] = (bf16)f2bf(SI[i].y); }
}
__device__ __forceinline__ void hgrn_pass1(unsigned char* ws, LAS unsigned char* buf, int u, int lane) {
    const int bh = u >> 6, seg = u & 63, b = bh >> 2, hh = bh & 3;
    f32x2 S[32];
#pragma unroll
    for (int i = 0; i < 32; ++i) S[i] = (f32x2){0.f, 0.f};
    float cf = 1.f;
    const unsigned char* rec = ws + WS_HREC + ((size_t)(bh * T + seg * 64)) * HRECB;
    bf16* olp = (bf16*)(ws + WS_OL) + ((size_t)(b * T + seg * 64)) * 256 + hh * 64 + lane;
    bf16* qdp = (bf16*)(ws + WS_QD) + ((size_t)(b * T + seg * 64)) * 256 + hh * 64 + lane;
#define H1_DMA(sub) do { _Pragma("unroll") for (int c_ = 0; c_ < 5; ++c_) \
        __builtin_amdgcn_global_load_lds((const unsigned*)(rec + (size_t)(sub) * 5120 + c_ * 1024 + lane * 16), (LAS unsigned*)(buf + ((sub) & 1) * 5120 + c_ * 1024), 16, 0, 0); } while (0)
    H1_DMA(0);
#pragma unroll 1
    for (int sub = 0; sub < 8; ++sub) {
        asm volatile("s_waitcnt vmcnt(0)" ::: "memory");
        if (sub + 1 < 8) H1_DMA(sub + 1);
        const LAS unsigned char* cur = buf + (sub & 1) * 5120;
#pragma unroll 1
        for (int tl = 0; tl < 8; ++tl) {
            const LAS unsigned char* rp = cur + tl * HRECB;
            const LAS f32x4* F4 = (const LAS f32x4*)rp; const LAS f32x4* Q4 = (const LAS f32x4*)(rp + 256);
            const float iv = bf2f(*(const LAS unsigned short*)(rp + 512 + lane * 2));
            const float fl = *(const LAS float*)(rp + lane * 4), ql = *(const LAS float*)(rp + 256 + lane * 4);
            cf *= fl;
            const f32x2 iv2 = (f32x2){iv, iv};
            f32x2 o = (f32x2){0.f, 0.f};
#pragma unroll
            for (int i = 0; i < 16; ++i) { const f32x4 f4 = F4[i], q4 = Q4[i];
                f32x2 s0 = S[2 * i] - iv2; s0 = s0 * (f32x2){f4.x, f4.y} + iv2; S[2 * i] = s0; o += s0 * (f32x2){q4.x, q4.y};
                f32x2 s1 = S[2 * i + 1] - iv2; s1 = s1 * (f32x2){f4.z, f4.w} + iv2; S[2 * i + 1] = s1; o += s1 * (f32x2){q4.z, q4.w}; }
            const int t = sub * 8 + tl;
            olp[(size_t)t * 256] = (bf16)f2bf(o.x + o.y); qdp[(size_t)t * 256] = (bf16)f2bf(ql * cf);
        }
    }
#undef H1_DMA
    float* LT = (float*)(ws + WS_HSEG + (size_t)u * HSEGB + HS_LT) + lane * 64;
#pragma unroll
    for (int i = 0; i < 16; ++i) *(f32x4*)(LT + 4 * i) = (f32x4){S[2 * i].x, S[2 * i].y, S[2 * i + 1].x, S[2 * i + 1].y};
    ((float*)(ws + WS_HF))[(size_t)u * 64 + lane] = cf;
}
__device__ __forceinline__ void scan_carry(unsigned char* ws, LAS unsigned char* lds, int bh, const int tid) {
    const int lane = tid & 63, r32 = lane & 31, hi = lane >> 5; const int wid = __builtin_amdgcn_readfirstlane(tid >> 6);
    LAS unsigned char* Sb = lds;
    for (int i = tid; i < 64 * 36; i += 512) ((LAS unsigned*)Sb)[i] = 0u;
    const int ti = (wid >> 1) & 1, tv = wid & 1;
    __syncthreads();
#define CARRY_BAR() do { asm volatile("s_waitcnt lgkmcnt(0)" ::: "memory"); __builtin_amdgcn_s_barrier(); asm volatile("" ::: "memory"); } while (0)
    if (wid < 4) {
        f32x16 cw[3]; bf16x8 aw[3][4];
#define RC_LOAD(slot, g_) do { const unsigned char* sg_ = ws + WS_RSEG + ((size_t)bh * 64 + (g_)) * RSEGB; const float* LT_ = (const float*)(sg_ + RS_LT); const bf16* PT_ = (const bf16*)(sg_ + RS_PT); \
        _Pragma("unroll") for (int r = 0; r < 16; ++r) cw[slot][r] = LT_[(32 * ti + crow(r, hi)) * 64 + 32 * tv + r32]; \
        _Pragma("unroll") for (int ks = 0; ks < 4; ++ks) aw[slot][ks] = *(const bf16x8*)(PT_ + (32 * ti + r32) * 64 + 16 * ks + 8 * hi); } while (0)
#define RC_STEP(slot, g_) do { unsigned char* sg_ = ws + WS_RSEG + ((size_t)bh * 64 + (g_)) * RSEGB; \
        _Pragma("unroll") for (int k = 0; k < 2; ++k) { const int idx = tid * 2 + k, row = idx >> 3, ch = idx & 7; *(v4u*)(sg_ + RS_SS + row * 128 + ch * 16) = *(const LAS v4u*)(Sb + row * 144 + ch * 16); } \
        f32x16 acc = cw[slot]; \
        _Pragma("unroll") for (int ks = 0; ks < 4; ++ks) { const bf16x8 bb = *(const LAS bf16x8*)(Sb + (32 * tv + r32) * 144 + (16 * ks + 8 * hi) * 2); acc = __builtin_amdgcn_mfma_f32_32x32x16_bf16(aw[slot][ks], bb, acc, 0, 0, 0); } \
        if ((g_) + 3 < 64) RC_LOAD(slot, (g_) + 3); \
        CARRY_BAR(); \
        _Pragma("unroll") for (int q = 0; q < 4; ++q) *(LAS u32x2*)(Sb + (32 * tv + r32) * 144 + (32 * ti + 8 * q + 4 * hi) * 2) = (u32x2){pk2(acc[4 * q], acc[4 * q + 1]), pk2(acc[4 * q + 2], acc[4 * q + 3])}; \
        CARRY_BAR(); } while (0)
        RC_LOAD(0, 0); RC_LOAD(1, 1); RC_LOAD(2, 2);
#pragma unroll 1
        for (int g = 0; g < 63; g += 3) { RC_STEP(0, g); RC_STEP(1, g + 1); RC_STEP(2, g + 2); }
        RC_STEP(0, 63);
#undef RC_LOAD
#undef RC_STEP
    } else {
        const int e = tid - 256;
        float hs[16];
#pragma unroll
        for (int i = 0; i < 16; ++i) hs[i] = 0.f;
        f32x4 lw[3][4], fw[3][4];
#define HC_LOAD(slot, g_) do { const size_t u_ = (size_t)bh * 64 + (g_); const float* LT_ = (const float*)(ws + WS_HSEG + u_ * HSEGB + HS_LT) + e * 16; const float* F_ = (const float*)(ws + WS_HF) + u_ * 64 + (e & 3) * 16; \
        _Pragma("unroll") for (int q = 0; q < 4; ++q) { lw[slot][q] = *(const f32x4*)(LT_ + 4 * q); fw[slot][q] = *(const f32x4*)(F_ + 4 * q); } } while (0)
#define HC_STEP(slot, g_) do { unsigned char* sg_ = ws + WS_HSEG + ((size_t)bh * 64 + (g_)) * HSEGB; \
        { u32x4 o0, o1; o0.x = pk2(hs[0], hs[1]); o0.y = pk2(hs[2], hs[3]); o0.z = pk2(hs[4], hs[5]); o0.w = pk2(hs[6], hs[7]); \
          o1.x = pk2(hs[8], hs[9]); o1.y = pk2(hs[10], hs[11]); o1.z = pk2(hs[12], hs[13]); o1.w = pk2(hs[14], hs[15]); \
          *(u32x4*)(sg_ + HS_SS + e * 32) = o0; *(u32x4*)(sg_ + HS_SS + e * 32 + 16) = o1; } \
        _Pragma("unroll") for (int q = 0; q < 4; ++q) _Pragma("unroll") for (int k = 0; k < 4; ++k) hs[4 * q + k] = hs[4 * q + k] * fw[slot][q][k] + lw[slot][q][k]; \
        if ((g_) + 3 < 64) HC_LOAD(slot, (g_) + 3); \
        CARRY_BAR(); CARRY_BAR(); } while (0)
        HC_LOAD(0, 0); HC_LOAD(1, 1); HC_LOAD(2, 2);
#pragma unroll 1
        for (int g = 0; g < 63; g += 3) { HC_STEP(0, g); HC_STEP(1, g + 1); HC_STEP(2, g + 2); }
        HC_STEP(0, 63);
#undef HC_LOAD
#undef HC_STEP
    }
#undef CARRY_BAR
    __syncthreads();
}
template <int MIXER>
__device__ __forceinline__ void scan_fixup(const Args& A, unsigned char* ws, int l, int u, int lane) {
    const int bh = u >> 6, seg = u & 63, b = bh >> 2, hh = bh & 3, r32 = lane & 31, hi = lane >> 5;
    const bf16* SS = (const bf16*)(MIXER == 0 ? ws + WS_RSEG + (size_t)u * RSEGB + RS_SS : ws + WS_HSEG + (size_t)u * HSEGB + HS_SS);
    const size_t row0 = (size_t)b * T + seg * 64;
    const bf16* PRp = (const bf16*)(ws + (MIXER == 0 ? WS_PR : WS_QD)) + row0 * 256 + hh * 64;
    const bf16* LOC = (const bf16*)(ws + (MIXER == 0 ? WS_YL : WS_OL)) + row0 * 256 + hh * 64;
    f32x16 acc[2][2];
#pragma unroll
    for (int a = 0; a < 2; ++a)
#pragma unroll
        for (int c = 0; c < 2; ++c)
#pragma unroll
            for (int r = 0; r < 16; ++r) acc[a][c][r] = 0.f;
#pragma unroll
    for (int ks = 0; ks < 4; ++ks) {
        bf16x8 af[2], bfr[2];
#pragma unroll
        for (int x = 0; x < 2; ++x) { af[x] = *(const bf16x8*)(SS + (32 * x + r32) * 64 + 16 * ks + 8 * hi); bfr[x] = *(const bf16x8*)(PRp + (size_t)(32 * x + r32) * 256 + 16 * ks + 8 * hi); }
#pragma unroll
        for (int tv = 0; tv < 2; ++tv)
#pragma unroll
            for (int tt = 0; tt < 2; ++tt) acc[tv][tt] = __builtin_amdgcn_mfma_f32_32x32x16_bf16(af[tv], bfr[tt], acc[tv][tt], 0, 0, 0);
    }
    bf16* Yp = (bf16*)(ws + WS_Y) + row0 * 1024 + (MIXER == 0 ? 512 : 0) + hh * 64;
#pragma unroll
    for (int tt = 0; tt < 2; ++tt) {
        const int t = 32 * tt + r32;
        float y[2][16]; float sum = 0.f;
#pragma unroll
        for (int tv = 0; tv < 2; ++tv)
#pragma unroll
            for (int q = 0; q < 4; ++q) { const u32x2 w = *(const u32x2*)(LOC + (size_t)t * 256 + 32 * tv + 8 * q + 4 * hi);
                y[tv][4 * q] = acc[tv][tt][4 * q] + bflo(w.x); y[tv][4 * q + 1] = acc[tv][tt][4 * q + 1] + bfhi(w.x); y[tv][4 * q + 2] = acc[tv][tt][4 * q + 2] + bflo(w.y); y[tv][4 * q + 3] = acc[tv][tt][4 * q + 3] + bfhi(w.y); }
        if (MIXER == 0) {
#pragma unroll
            for (int tv = 0; tv < 2; ++tv)
#pragma unroll
                for (int r = 0; r < 16; ++r) sum += y[tv][r];
            const float mean = half_sum(sum) * (1.f / 64.f); float q2 = 0.f;
#pragma unroll
            for (int tv = 0; tv < 2; ++tv)
#pragma unroll
                for (int r = 0; r < 16; ++r) { y[tv][r] -= mean; q2 += y[tv][r] * y[tv][r]; }
            const float rstd = rsqrtf(half_sum(q2) * (1.f / 64.f) + 64e-5f);
            const float bon = ((const float*)(ws + WS_RB))[(row0 + t) * 4 + hh];
            const float* vp = (const float*)(ws + WS_RW + ((size_t)(bh * T + seg * 64 + t)) * RREC + 1280);
            const bf16* gp = (const bf16*)(ws + WS_RG) + (row0 + t) * 256 + hh * 64;
#pragma unroll
            for (int tv = 0; tv < 2; ++tv)
#pragma unroll
                for (int q = 0; q < 4; ++q) { const int v0 = 32 * tv + 8 * q + 4 * hi;
                    const f32x4 lw = *(const f32x4*)(A.in[20] + l * 256 + hh * 64 + v0), lb = *(const f32x4*)(A.in[21] + l * 256 + hh * 64 + v0), v4 = *(const f32x4*)(vp + v0);
                    const u32x2 gw = *(const u32x2*)(gp + v0); const float gg[4] = {bflo(gw.x), bfhi(gw.x), bflo(gw.y), bfhi(gw.y)};
                    float o[4];
#pragma unroll
                    for (int k = 0; k < 4; ++k) { o[k] = (y[tv][4 * q + k] * rstd * lw[k] + lb[k] + bon * v4[k]) * gg[k]; if (DBG_ZERO & 4) o[k] = 0.f; }
                    *(u32x2*)(Yp + (size_t)t * 1024 + v0) = (u32x2){pk2(o[0], o[1]), pk2(o[2], o[3])}; }
        } else {
#pragma unroll
            for (int tv = 0; tv < 2; ++tv)
#pragma unroll
                for (int r = 0; r < 16; ++r) sum += y[tv][r] * y[tv][r];
            const float rstd = rsqrtf(half_sum(sum) * (1.f / 64.f) + 1e-6f);
            const bf16* gp = (const bf16*)(ws + WS_HGATE) + (row0 + t) * 256 + hh * 64;
#pragma unroll
            for (int tv = 0; tv < 2; ++tv)
#pragma unroll
                for (int q = 0; q < 4; ++q) { const int v0 = 32 * tv + 8 * q + 4 * hi;
                    const f32x4 nw = *(const f32x4*)(A.in[9] + l * 64 + v0);
                    const u32x2 gw = *(const u32x2*)(gp + v0); const float gg[4] = {bflo(gw.x), bfhi(gw.x), bflo(gw.y), bfhi(gw.y)};
                    float o[4];
#pragma unroll
                    for (int k = 0; k < 4; ++k) { o[k] = y[tv][4 * q + k] * rstd * nw[k] * gg[k]; if (DBG_ZERO & 1) o[k] = 0.f; }
                    *(u32x2*)(Yp + (size_t)t * 1024 + v0) = (u32x2){pk2(o[0], o[1]), pk2(o[2], o[3])}; }
        }
    }
}
__device__ __forceinline__ void fox_cumsum_wave(unsigned char* ws, int bh, int lane) {
    const int b = bh >> 2, hh = bh & 3;
    const float* fl = (const float*)(ws + WS_FL) + (size_t)(b * T + 64 * lane) * 4 + hh;
    float s = 0.f;
    for (int i = 0; i < 64; ++i) s += fl[i * 4];
    float incl = s;
#pragma unroll
    for (int o = 1; o < 64; o <<= 1) { const float n = __int_as_float(__builtin_amdgcn_ds_bpermute(((lane - o) & 63) << 2, __float_as_int(incl))); if (lane >= o) incl += n; }
    float run = incl - s;
    float* fbp = (float*)(ws + WS_FB) + (size_t)bh * T + 64 * lane;
    for (int i = 0; i < 64; ++i) { run += fl[i * 4]; fbp[i] = -run * LOG2E; }
}

__device__ __forceinline__ void dsa_scores_unit(unsigned char* ws, int v, int lane) {
    const int b = v / 576, r = v - b * 576;
    int g8 = 1;
#pragma unroll
    for (int g = 2; g <= 8; ++g) if (r >= 8 * g * (g - 1)) g8 = g;
    const int rr = r - 8 * g8 * (g8 - 1); const int qg = 16 * (g8 - 1) + rr / g8, kc = rr % g8;
    const int nkvb = 2 * ((qg >> 1) + 1);
    const int q = lane & 31, hi = lane >> 5; const int trow = 32 * qg + q; const size_t grow = (size_t)b * T + trow;
    const bf16* QI = (const bf16*)(ws + WS_QI); const bf16* KI = (const bf16*)(ws + WS_KI); const float* WIp = (const float*)(ws + WS_WI);
    bf16x8 qf[8][2]; float wq[8];
#pragma unroll
    for (int h = 0; h < 8; ++h) { qf[h][0] = *(const bf16x8*)(QI + grow * 256 + h * 32 + hi * 8); qf[h][1] = *(const bf16x8*)(QI + grow * 256 + h * 32 + 16 + hi * 8); wq[h] = WIp[grow * 8 + h]; }
    float* srow = (float*)(ws + WS_SC) + sc_rowoff(b, trow);
    const int kb1 = (kc * 16 + 16 < nkvb) ? kc * 16 + 16 : nkvb;
#pragma unroll 1
    for (int kb = kc * 16; kb < kb1; ++kb) {
        const bf16* kp = KI + ((size_t)b * T + 32 * kb + q) * 32 + hi * 8;
        const bf16x8 k0 = *(const bf16x8*)kp, k1 = *(const bf16x8*)(kp + 16);
        f32x16 acc;
#pragma unroll
        for (int r = 0; r < 16; ++r) acc[r] = 0.f;
#pragma unroll
        for (int h = 0; h < 8; ++h) { f32x16 d;
#pragma unroll
            for (int r = 0; r < 16; ++r) d[r] = 0.f;
            d = __builtin_amdgcn_mfma_f32_32x32x16_bf16(k0, qf[h][0], d, 0, 0, 0);
            d = __builtin_amdgcn_mfma_f32_32x32x16_bf16(k1, qf[h][1], d, 0, 0, 0);
#pragma unroll
            for (int r = 0; r < 16; ++r) acc[r] += wq[h] * fmaxf(d[r], 0.f);
            if (h & 1) __builtin_amdgcn_sched_barrier(0); }
#pragma unroll
        for (int j = 0; j < 4; ++j) *(f32x4*)(srow + 32 * kb + 8 * j + 4 * hi) = (f32x4){acc[4 * j], acc[4 * j + 1], acc[4 * j + 2], acc[4 * j + 3]};
    }
}

__device__ __forceinline__ void dsa_select_row(unsigned char* ws, int row, int lane) {
    const int b = row >> 12, t = row & (T - 1); const int nreg = (t >> 6) + 1;
    const float* src = (const float*)(ws + WS_SC) + sc_rowoff(b, t);
    unsigned key[64];
#pragma unroll
    for (int g = 0; g < 4; ++g) {
        if (16 * g < nreg) {
#pragma unroll
            for (int jj = 0; jj < 16; ++jj) key[16 * g + jj] = __float_as_uint(src[64 * (16 * g + jj) + lane]);
        } else {
#pragma unroll
            for (int jj = 0; jj < 16; ++jj) key[16 * g + jj] = 0u;
        }
    }
#pragma unroll
    for (int j = 0; j < 64; ++j) { const unsigned bits = key[j]; unsigned u = bits ^ ((bits >> 31) ? 0xffffffffu : 0x80000000u); if (64 * j + lane > t) u = 0u; key[j] = u; }
    unsigned thr = 0u; int need = 0, neq = 0;
#define CNT8(G_, OP_, REF_, ACC_) do { unsigned long long m0_, m1_, m2_, m3_, m4_, m5_, m6_, m7_; \
        asm volatile(OP_ " %0, %8, %16\n\t" OP_ " %1, %9, %16\n\t" OP_ " %2, %10, %16\n\t" OP_ " %3, %11, %16\n\t" OP_ " %4, %12, %16\n\t" OP_ " %5, %13, %16\n\t" OP_ " %6, %14, %16\n\t" OP_ " %7, %15, %16" \
            : "=&s"(m0_), "=&s"(m1_), "=&s"(m2_), "=&s"(m3_), "=&s"(m4_), "=&s"(m5_), "=&s"(m6_), "=&s"(m7_) \
            : "v"(key[8 * (G_)]), "v"(key[8 * (G_) + 1]), "v"(key[8 * (G_) + 2]), "v"(key[8 * (G_) + 3]), "v"(key[8 * (G_) + 4]), "v"(key[8 * (G_) + 5]), "v"(key[8 * (G_) + 6]), "v"(key[8 * (G_) + 7]), "s"(REF_)); \
        ACC_ += (__builtin_popcountll(m0_) + __builtin_popcountll(m1_)) + (__builtin_popcountll(m2_) + __builtin_popcountll(m3_)) + (__builtin_popcountll(m4_) + __builtin_popcountll(m5_)) + (__builtin_popcountll(m6_) + __builtin_popcountll(m7_)); } while (0)
    if (t >= 256) {
        bool exact = false;
        REP(43) { thr = 0u; exact = false; for (int bit = 31; bit >= 0; --bit) {
            const unsigned cand = thr | (1u << bit); int cnt = 0;
#pragma unroll
            for (int g = 0; g < 8; ++g) if (8 * g < nreg) CNT8(g, "v_cmp_ge_u32_e64", cand, cnt);
            if (cnt >= 256) { thr = cand; if (cnt == 256) { exact = true; break; } }
        } }
        if (exact) { need = 0; neq = 0; }
        else { int gt = 0, ge = 0;
#pragma unroll
            for (int g = 0; g < 8; ++g) if (8 * g < nreg) { CNT8(g, "v_cmp_gt_u32_e64", thr, gt); CNT8(g, "v_cmp_ge_u32_e64", thr, ge); }
            need = 256 - gt; neq = ge - gt; }
    }
#undef CNT8
    unsigned mylo = 0u, myhi = 0u;
    REP(44) {
    if (t < 256 || neq == need) {
        const unsigned ref = thr > 1u ? thr : 1u;
#pragma unroll
        for (int j = 0; j < 64; ++j) { unsigned long long m_; asm volatile("v_cmp_ge_u32_e64 %0, %1, %2" : "=s"(m_) : "v"(key[j]), "s"(ref));
            const unsigned wl_ = (unsigned)m_, wh_ = (unsigned)(m_ >> 32);
            asm volatile("s_nop 4\n\tv_writelane_b32 %0, %1, %2" : "+v"(mylo) : "s"(wl_), "n"(j)); asm volatile("v_writelane_b32 %0, %1, %2" : "+v"(myhi) : "s"(wh_), "n"(j)); }
    } else {
#pragma unroll
        for (int j = 0; j < 64; ++j) {
            const bool eq = key[j] == thr; const unsigned long long eqm = __ballot(eq);
            const int rank = (int)__builtin_amdgcn_mbcnt_hi((unsigned)(eqm >> 32), __builtin_amdgcn_mbcnt_lo((unsigned)eqm, 0u));
            const bool sel = (key[j] > thr) || (eq && rank < need);
            need -= __popcll(eqm);
            const unsigned long long word = __ballot(sel);
            { const unsigned wl_ = (unsigned)word, wh_ = (unsigned)(word >> 32);
              asm volatile("s_nop 4\n\tv_writelane_b32 %0, %1, %2" : "+v"(mylo) : "s"(wl_), "n"(j)); asm volatile("v_writelane_b32 %0, %1, %2" : "+v"(myhi) : "s"(wh_), "n"(j)); }
            if ((j & 3) == 3) __builtin_amdgcn_sched_barrier(0);
        }
    }
    ((unsigned long long*)(ws + WS_MASK))[((size_t)b * 64 + lane) * T + t] = ((unsigned long long)myhi << 32) | mylo;
    }
}

constexpr int AT_KS = 0, AT_VS = 9216, AT_WSF = 9216 + 8704, AT_BYTES = AT_WSF + 8 * 256;
template <int MODE>
__device__ __forceinline__ void attn_unit(LAS unsigned char* lds, int b, int hh, int qb, const bf16* Q, const bf16* K, const bf16* VT, const float* FBp, const unsigned long long* MT, bf16* Y, int ycol, const int tid) {
    const int lane = tid & 63, r32 = lane & 31, hi = lane >> 5; const int wid = __builtin_amdgcn_readfirstlane(tid >> 6);
    const int q0 = qb * 256, qw0 = q0 + wid * 32; const size_t rowbase = (size_t)b * T;
    bf16x8 qr[4];
#pragma unroll
    for (int d0 = 0; d0 < 4; ++d0) qr[d0] = *(const bf16x8*)(Q + (rowbase + qw0 + r32) * 256 + hh * 64 + d0 * 16 + hi * 8);
    f32x16 o0, o1;
#pragma unroll
    for (int r = 0; r < 16; ++r) { o0[r] = 0.f; o1[r] = 0.f; }
    float m_run = -1e30f, l_run = 0.f;
    const int NT = (q0 + 256) / 64;
    const int lrow = tid >> 3, lch = tid & 7;
    const bf16* kg = K + (rowbase + lrow) * 256 + hh * 64 + lch * 8;
    const bf16* vg = VT + ((size_t)((b * NH + hh) * 64 + lrow)) * T + lch * 8;
    v4u kreg = *(const v4u*)kg, vreg = *(const v4u*)vg;
    LAS unsigned char* Ks = lds + AT_KS; LAS unsigned char* Vs = lds + AT_VS; LAS float* wsf = (LAS float*)(lds + AT_WSF) + wid * 64;
    const float* fbh = FBp + (size_t)(b * NH + hh) * T;
    const int qabs = qw0 + r32;
    for (int t = 0; t < NT; ++t) {
        __syncthreads();
        *(LAS v4u*)(Ks + lrow * 144 + lch * 16) = kreg;
        *(LAS u32x2*)(Vs + lrow * 136 + lch * 16) = (u32x2){vreg.x, vreg.y}; *(LAS u32x2*)(Vs + lrow * 136 + lch * 16 + 8) = (u32x2){vreg.z, vreg.w};
        __syncthreads();
        if (t + 1 < NT) { kreg = *(const v4u*)(kg + (size_t)(t + 1) * 64 * 256); vreg = *(const v4u*)(vg + (t + 1) * 64); }
        if (64 * t <= qw0 + 31) {
            f32x16 p0, p1;
#pragma unroll
            for (int r = 0; r < 16; ++r) { p0[r] = 0.f; p1[r] = 0.f; }
#pragma unroll
            for (int d0 = 0; d0 < 4; ++d0) {
                const bf16x8 kf0 = *(const LAS bf16x8*)(Ks + r32 * 144 + d0 * 32 + hi * 16), kf1 = *(const LAS bf16x8*)(Ks + (r32 + 32) * 144 + d0 * 32 + hi * 16);
                p0 = __builtin_amdgcn_mfma_f32_32x32x16_bf16(kf0, qr[d0], p0, 0, 0, 0);
                p1 = __builtin_amdgcn_mfma_f32_32x32x16_bf16(kf1, qr[d0], p1, 0, 0, 0);
            }
            if (MODE == 0) {
#pragma unroll
                for (int j = 0; j < 4; ++j) { const f32x4 b0 = *(const f32x4*)(fbh + 64 * t + 8 * j + 4 * hi), b1 = *(const f32x4*)(fbh + 64 * t + 32 + 8 * j + 4 * hi);
#pragma unroll
                    for (int e = 0; e < 4; ++e) { p0[4 * j + e] += b0[e]; p1[4 * j + e] += b1[e]; } }
            } else {
                const unsigned long long word = MT[((size_t)b * 64 + t) * T + qabs];
                const unsigned wlo = (unsigned)word, whi = (unsigned)(word >> 32);
#pragma unroll
                for (int r = 0; r < 16; ++r) { const int kv = crow(r, hi); if (!((wlo >> kv) & 1u)) p0[r] = NEGBIG; if (!((whi >> kv) & 1u)) p1[r] = NEGBIG; }
            }
            if (64 * t + 63 > qw0) {
#pragma unroll
                for (int r = 0; r < 16; ++r) { const int kv = 64 * t + crow(r, hi); if (kv > qabs) p0[r] = NEGBIG; if (kv + 32 > qabs) p1[r] = NEGBIG; }
            }
            float mx = p0[0];
#pragma unroll
            for (int r = 1; r < 16; ++r) mx = fmaxf(mx, p0[r]);
#pragma unroll
            for (int r = 0; r < 16; ++r) mx = fmaxf(mx, p1[r]);
            mx = half_max(mx);
            const float m_new = fmaxf(m_run, mx); const float f = __builtin_amdgcn_exp2f(m_run - m_new); m_run = m_new;
            float rs = 0.f;
#pragma unroll
            for (int r = 0; r < 16; ++r) { p0[r] = __builtin_amdgcn_exp2f(p0[r] - m_new); p1[r] = __builtin_amdgcn_exp2f(p1[r] - m_new); rs += p0[r] + p1[r]; }
            l_run = l_run * f + rs;
            if (hi == 0) wsf[r32] = f;
            __builtin_amdgcn_wave_barrier(); LDS_WAIT();
#pragma unroll
            for (int r = 0; r < 16; ++r) { const float fr_ = wsf[crow(r, hi)]; o0[r] *= fr_; o1[r] *= fr_; }
            __builtin_amdgcn_wave_barrier();
            u32x4 pw[4];
            pw[0] = (u32x4){pk2(p0[0], p0[1]), pk2(p0[2], p0[3]), pk2(p0[4], p0[5]), pk2(p0[6], p0[7])};
            pw[1] = (u32x4){pk2(p0[8], p0[9]), pk2(p0[10], p0[11]), pk2(p0[12], p0[13]), pk2(p0[14], p0[15])};
            pw[2] = (u32x4){pk2(p1[0], p1[1]), pk2(p1[2], p1[3]), pk2(p1[4], p1[5]), pk2(p1[6], p1[7])};
            pw[3] = (u32x4){pk2(p1[8], p1[9]), pk2(p1[10], p1[11]), pk2(p1[12], p1[13]), pk2(p1[14], p1[15])};
#pragma unroll
            for (int k = 0; k < 4; ++k) {
                const bf16x8 pa = __builtin_bit_cast(bf16x8, pw[k]);
                { const LAS unsigned char* vp = Vs + r32 * 136 + (16 * k + 4 * hi) * 2; const u32x2 lo = *(const LAS u32x2*)vp, h2 = *(const LAS u32x2*)(vp + 16);
                  const bf16x8 vb = __builtin_bit_cast(bf16x8, (u32x4){lo.x, lo.y, h2.x, h2.y}); o0 = __builtin_amdgcn_mfma_f32_32x32x16_bf16(pa, vb, o0, 0, 0, 0); }
                { const LAS unsigned char* vp = Vs + (r32 + 32) * 136 + (16 * k + 4 * hi) * 2; const u32x2 lo = *(const LAS u32x2*)vp, h2 = *(const LAS u32x2*)(vp + 16);
                  const bf16x8 vb = __builtin_bit_cast(bf16x8, (u32x4){lo.x, lo.y, h2.x, h2.y}); o1 = __builtin_amdgcn_mfma_f32_32x32x16_bf16(pa, vb, o1, 0, 0, 0); }
            }
        }
    }
    const float l_tot = half_sum(l_run);
    __builtin_amdgcn_wave_barrier();
    if (hi == 0) wsf[r32] = 1.f / l_tot;
    __builtin_amdgcn_wave_barrier(); LDS_WAIT();
#pragma unroll
    for (int r = 0; r < 16; ++r) { const int qr_ = crow(r, hi); const float rl = wsf[qr_];
        bf16* yp = Y + (rowbase + qw0 + qr_) * 1024 + ycol + hh * 64 + r32;
        float y0 = o0[r] * rl, y1 = o1[r] * rl; if (DBG_ZERO & (MODE == 0 ? 8 : 2)) { y0 = 0.f; y1 = 0.f; }
        yp[0] = (bf16)f2bf(y0); yp[32] = (bf16)f2bf(y1); }
    __builtin_amdgcn_wave_barrier();
}

__device__ __forceinline__ void load_args(Args& A) {
#if defined(__HIP_DEVICE_COMPILE__)
    const __attribute__((address_space(4))) unsigned long long* p = (const __attribute__((address_space(4))) unsigned long long*)__builtin_amdgcn_kernarg_segment_ptr();
    asm volatile("" : "+s"(p));
#pragma unroll
    for (int i = 0; i < 27; ++i) A.in[i] = (const float*)(const GAS float*)p[i];
    A.out = (float*)(GAS float*)p[27]; A.ws = (unsigned char*)(GAS unsigned char*)p[28];
    A.l_lo = 0; A.l_hi = 0;
#endif
}
#ifndef MK_MULTI
#define MK_MULTI 0
#endif
constexpr int NPH = 13;
constexpr int LDS_BYTES = 155648;
constexpr int RING_BYTES = 131072, MISC_OFF = RING_BYTES + 320;

template <int PLO, int PHI> __global__ void __launch_bounds__(NWAVES * 64, 2) mk_fwd(Args KA) {
    extern __shared__ __attribute__((aligned(16))) unsigned char lds_raw[];
    LAS unsigned char* lds = (LAS unsigned char*)lds_raw;
    volatile LAS unsigned* MISC = (volatile LAS unsigned*)(lds + MISC_OFF);
    for (int u = threadIdx.x; u < (LDS_BYTES - RING_BYTES) / 4; u += NWAVES * 64) ((LAS unsigned*)(lds + RING_BYTES))[u] = 0u;
    __syncthreads();
#if MK_MULTI
#define GRID_BAR() do { } while (0)
#else
    XcdBarrier bar = xcd_barrier_post((unsigned*)(KA.ws + WS_CTL) + CW_BAR, MISC + 8);
#define GRID_BAR() do { XcdBarrier b_ = bar; asm volatile("" : "+s"(b_.bar), "+s"(b_.x)); xcd_barrier(b_); } while (0)
#endif
#ifdef ONLY_PH
#define IN(k) ((k) == ONLY_PH && PLO <= (k) && (k) < PHI)
#else
#define IN(k) (PLO <= (k) && (k) < PHI)
#endif
#define PHASE_IDS() int tid = threadIdx.x, bx = blockIdx.x, G = gridDim.x; asm volatile("" : "+v"(tid), "+s"(bx), "+s"(G)); Args A; load_args(A); unsigned char* ws = A.ws; \
    const int lane = tid & 63, wave = __builtin_amdgcn_readfirstlane(tid >> 6); const int gw = bx * NWAVES + wave, NGW = G * NWAVES; bf16* XN = (bf16*)(ws + WS_XN); (void)lane; (void)gw; (void)NGW; (void)XN
    for (int l = KA.l_lo; l < KA.l_hi; ++l) {
        for (int rep_ = 0; rep_ < ((PROBE_DUP == 0) ? 2 : 1); ++rep_) if (IN(0)) { PHASE_IDS();
            LAS float* scr = (LAS float*)(lds + wave * 16384);
            const float* gpre = A.in[1] + l * D; const float* gmlp = A.in[3] + l * D;
            const float* win = A.in[5] + (size_t)l * D * IN_COLS; const float* wbr = A.in[6] + (size_t)l * 4 * 256 * 1024; const float* wout = A.in[7] + (size_t)l * D * D;
            const float* wup = A.in[25] + (size_t)l * D * FF; const float* wdn = A.in[26] + (size_t)l * FF * D;
            constexpr int I_IN = 16 * 120, I_G = 16 * 128, I_B = 4 * 32, I_O = 16 * 32, I_UP = 16 * 128, I_DN = 64 * 32;
            constexpr int NIT = I_IN + I_G + 4 * I_B + I_O + I_UP + I_DN;
            for (int it = gw; it < NIT; it += NGW) {
                int r = it;
                if (r < I_IN) { wt_item(win, IN_COLS, 1, 0, gpre, (bf16*)(ws + WS_WIN), D, r / 120, r % 120, scr, lane); continue; } r -= I_IN;
                if (r < I_G) { wt_item(win, IN_COLS, 0, 3756, gpre, (bf16*)(ws + WS_WG), D, r / 128, r % 128, scr, lane); continue; } r -= I_G;
                if (r < 4 * I_B) { const int n = r / I_B, q = r % I_B; wt_item(wbr + (size_t)n * 256 * 1024, 1024, 0, 0, nullptr, (bf16*)(ws + WS_WB) + (size_t)n * 1024 * 256, 256, q / 32, q % 32, scr, lane); continue; } r -= 4 * I_B;
                if (r < I_O) { wt_item(wout, D, 0, 0, nullptr, (bf16*)(ws + WS_WO), D, r / 32, r % 32, scr, lane); continue; } r -= I_O;
                if (r < I_UP) { wt_item(wup, FF, 0, 0, gmlp, (bf16*)(ws + WS_WUP), D, r / 128, r % 128, scr, lane); continue; } r -= I_UP;
                wt_item(wdn, D, 0, 0, nullptr, (bf16*)(ws + WS_WDN), FF, r / 32, r % 32, scr, lane);
            }
            if (l == 0) for (int m = gw; m < M; m += 4 * NGW) rms_rows_to_bf16<4>(A.in[0] + (size_t)m * D, XN + (size_t)m * D, (size_t)NGW, lane);
            GRID_BAR();
        }
        for (int rep_ = 0; rep_ < ((PROBE_DUP == 1) ? 2 : 1); ++rep_) if (IN(1)) { PHASE_IDS();
            pg8::Gemm g{XN, (const bf16*)(ws + WS_WIN), M, PP, D, D, D, 0, 0}; pg8::StaticOrder S; S.init(M, PP, G, bx);
            pg8::EpiIn E{(bf16*)(ws + WS_P), (float*)(ws + WS_SMALL)};
            pg8::gemm_phase<pg8::EpiIn, pg8::StaticOrder, true, true>(lds, g, S, E, tid);
            GRID_BAR();
        }
        for (int rep_ = 0; rep_ < ((PROBE_DUP == 2) ? 2 : 1); ++rep_) if (IN(2)) { PHASE_IDS();
            REP(21) for (int m = gw; m < M; m += NGW) prep_token(A, ws, l, m, lane);
            REP(22) for (int it = gw; it < 2048; it += NGW) prep_vt(ws, it, lds + wave * 8448, lane);
            __syncthreads();
            REP(23) prep_rwkv(A, ws, l, lds, tid, bx, G);
            GRID_BAR();
        }
        for (int rep_ = 0; rep_ < ((PROBE_DUP == 3) ? 2 : 1); ++rep_) if (IN(3)) { PHASE_IDS();
            const int w4 = wave & 3;
            if (wave < 4) { REP(31) for (int u = bx * 4 + w4; u < 1024; u += G * 4) rwkv_pass1(ws, lds + w4 * 12288, u, lane); }
            else {
                REP(32) for (int u = bx * 4 + w4; u < 1024; u += G * 4) hgrn_pass1(ws, lds + 49152 + w4 * 10240, u, lane);
                REP(33) for (int u = bx * 4 + w4; u < 2304; u += G * 4) dsa_scores_unit(ws, u, lane);
                if (bx * 4 + w4 < 16) fox_cumsum_wave(ws, bx * 4 + w4, lane);
            }
            GRID_BAR();
        }
        for (int rep_ = 0; rep_ < ((PROBE_DUP == 4) ? 2 : 1); ++rep_) if (IN(4)) { PHASE_IDS();
            if (bx < 16) { REP(41) for (int bh = bx; bh < 16; bh += G) scan_carry(ws, lds, bh, tid); }
            if (G <= 16) { for (int row = gw; row < M; row += NGW) dsa_select_row(ws, row, lane); }
            else if (bx >= 16) { REP(42) for (int row = (bx - 16) * NWAVES + wave; row < M; row += (G - 16) * NWAVES) dsa_select_row(ws, row, lane); }
            GRID_BAR();
        }
        for (int rep_ = 0; rep_ < ((PROBE_DUP == 5) ? 2 : 1); ++rep_) if (IN(5)) { PHASE_IDS();
            REP(51) for (int u = gw; u < 2048; u += NGW) { if (u < 1024) scan_fixup<0>(A, ws, l, u, lane); else scan_fixup<1>(A, ws, l, u - 1024, lane); }
            REP(52) { const float* xs = (l == 0) ? A.in[0] : A.out; for (int m = gw; m < M; m += 4 * NGW) rms_rows_to_bf16<4>(xs + (size_t)m * D, XN + (size_t)m * D, (size_t)NGW, lane); }
            for (int u = bx; u < 256; u += G) {
                const int bh = u >> 4, s = u & 15;
                REP(53) attn_unit<0>(lds, bh >> 2, bh & 3, s, (const bf16*)(ws + WS_DQ), (const bf16*)(ws + WS_DK), (const bf16*)(ws + WS_DVT), (const float*)(ws + WS_FB), nullptr, (bf16*)(ws + WS_Y), 768, tid);
                REP(54) attn_unit<1>(lds, bh >> 2, bh & 3, 15 - s, (const bf16*)(ws + WS_BQ), (const bf16*)(ws + WS_BK), (const bf16*)(ws + WS_BVT), (const float*)(ws + WS_FB), (const unsigned long long*)(ws + WS_MASK), (bf16*)(ws + WS_Y), 256, tid);
            }
            __syncthreads();
            GRID_BAR();
        }
        for (int rep_ = 0; rep_ < ((PROBE_DUP == 6) ? 2 : 1); ++rep_) if (IN(6)) { PHASE_IDS();
            pg8::Gemm g{XN, (const bf16*)(ws + (DBG_MERGE == 4 ? WS_WUP : WS_WG)), M, NG, D, D, D, 0, 0}; pg8::StaticOrder S; S.init(M, NG, G, bx);
            pg8::EpiAct<0> E{(bf16*)(ws + WS_G), NG};
            pg8::gemm_phase<pg8::EpiAct<0>, pg8::StaticOrder, true, true>(lds, g, S, E, tid);
            GRID_BAR();
        }
        for (int rep_ = 0; rep_ < ((PROBE_DUP == 7) ? 2 : 1); ++rep_) if (IN(7)) { PHASE_IDS();
            int kmerge = 256; asm volatile("" : "+s"(kmerge));
            pg8::Gemm g{(const bf16*)(ws + WS_Y), (const bf16*)(ws + WS_WB), M, 4096, kmerge, 1024, 256, 4, 512}; pg8::MergeOrder S{G, bx};
            pg8::EpiMerge E{(const bf16*)(ws + WS_G), (bf16*)(ws + WS_Z)};
            pg8::gemm_phase<pg8::EpiMerge, pg8::MergeOrder, true, true>(lds, g, S, E, tid);
            GRID_BAR();
        }
        for (int rep_ = 0; rep_ < ((PROBE_DUP == 8) ? 2 : 1); ++rep_) if (IN(8)) { PHASE_IDS();
            pg8::Gemm g{(const bf16*)(ws + WS_Z), (const bf16*)(ws + WS_WO), M, D, D, D, D, 0, 0}; pg8::StaticOrder S; S.init(M, D, G, bx);
            pg8::EpiF32 E{(float*)(ws + WS_MIX), D};
            pg8::gemm_phase<pg8::EpiF32, pg8::StaticOrder, true, true>(lds, g, S, E, tid);
            GRID_BAR();
        }
        for (int rep_ = 0; rep_ < ((PROBE_DUP == 9) ? 2 : 1); ++rep_) if (IN(9)) { PHASE_IDS();
            const float* xold = (l == 0) ? A.in[0] : A.out;
            for (int m = gw; m < M; m += 2 * NGW) post_rows<2>((const float*)(ws + WS_MIX) + (size_t)m * D, xold + (size_t)m * D, A.in[2] + l * D, A.out + (size_t)m * D, XN + (size_t)m * D, (size_t)NGW, lane);
            GRID_BAR();
        }
        for (int rep_ = 0; rep_ < ((PROBE_DUP == 10) ? 2 : 1); ++rep_) if (IN(10)) { PHASE_IDS();
            pg8::Gemm g{XN, (const bf16*)(ws + WS_WUP), M, FF, D, D, D, 0, 0}; pg8::StaticOrder S; S.init(M, FF, G, bx);
            pg8::EpiAct<1> E{(bf16*)(ws + WS_U), FF};
            pg8::gemm_phase<pg8::EpiAct<1>, pg8::StaticOrder, true, true>(lds, g, S, E, tid);
            GRID_BAR();
        }
        for (int rep_ = 0; rep_ < ((PROBE_DUP == 11) ? 2 : 1); ++rep_) if (IN(11)) { PHASE_IDS();
            pg8::Gemm g{(const bf16*)(ws + WS_U), (const bf16*)(ws + WS_WDN), M, D, FF, FF, FF, 0, 0}; pg8::StaticOrder S; S.init(M, D, G, bx);
            pg8::EpiF32 E{(float*)(ws + WS_MIX), D};
            pg8::gemm_phase<pg8::EpiF32, pg8::StaticOrder, true, true>(lds, g, S, E, tid);
            GRID_BAR();
        }
        for (int rep_ = 0; rep_ < ((PROBE_DUP == 12) ? 2 : 1); ++rep_) if (IN(12)) { PHASE_IDS();
            for (int m = gw; m < M; m += 2 * NGW) post_rows<2>((const float*)(ws + WS_MIX) + (size_t)m * D, A.out + (size_t)m * D, A.in[4] + l * D, A.out + (size_t)m * D, (l + 1 < DEPTH) ? XN + (size_t)m * D : nullptr, (size_t)NGW, lane);
            GRID_BAR();
        }
    }
#undef IN
}

template <int PH> static void launch_ph(int grid, hipStream_t stream, const Args& a) { hipLaunchKernelGGL((mk_fwd<PH, PH + 1>), dim3(grid), dim3(NWAVES * 64), LDS_BYTES, stream, a); }
template <int PH> static void set_lds_ph() { (void)hipFuncSetAttribute((const void*)mk_fwd<PH, PH + 1>, hipFuncAttributeMaxDynamicSharedMemorySize, LDS_BYTES); }
extern "C" void kernel_launch(void* const* d_in, const int* in_sizes, int n_in, void* d_out, int out_size, void* d_ws, size_t ws_size, hipStream_t stream) {
    static int grid = 0;
    if (grid == 0) {
        if (n_in != 27 || out_size != M * D || ws_size < WS_END) { fprintf(stderr, "kernel_launch: unexpected shapes (n_in %d, out %d, ws %zu < %zu)\n", n_in, out_size, ws_size, (size_t)WS_END); grid = -1; return; }
        int dev = 0, cus = 0, per_cu = 0;
        if (hipGetDevice(&dev) != hipSuccess || hipDeviceGetAttribute(&cus, hipDeviceAttributeMultiprocessorCount, dev) != hipSuccess) { grid = -1; return; }
#if MK_MULTI
        set_lds_ph<0>(); set_lds_ph<1>(); set_lds_ph<2>(); set_lds_ph<3>(); set_lds_ph<4>(); set_lds_ph<5>(); set_lds_ph<6>(); set_lds_ph<7>(); set_lds_ph<8>(); set_lds_ph<9>(); set_lds_ph<10>(); set_lds_ph<11>(); set_lds_ph<12>();
#else
        if (hipFuncSetAttribute((const void*)mk_fwd<0, NPH>, hipFuncAttributeMaxDynamicSharedMemorySize, LDS_BYTES) != hipSuccess) { fprintf(stderr, "kernel_launch: hipFuncSetAttribute failed\n"); grid = -1; return; }
        if (hipOccupancyMaxActiveBlocksPerMultiprocessor(&per_cu, (const void*)mk_fwd<0, NPH>, NWAVES * 64, LDS_BYTES) != hipSuccess || per_cu < 1) fprintf(stderr, "kernel_launch: occupancy query reports %d\n", per_cu);
#endif
        (void)hipGetLastError();
        grid = cus;
    }
    if (grid < 0) return;
    if (hipMemsetAsync((char*)d_ws + WS_CTL, 0, CTL_ZERO_BYTES, stream) != hipSuccess) return;
    Args a{};
    for (int i = 0; i < 27; ++i) a.in[i] = (const float*)d_in[i];
    a.out = (float*)d_out; a.ws = (unsigned char*)d_ws;
#if MK_MULTI
    for (int l = 0; l < DEPTH; ++l) { a.l_lo = l; a.l_hi = l + 1;
        launch_ph<0>(grid, stream, a); launch_ph<1>(grid, stream, a); launch_ph<2>(grid, stream, a); launch_ph<3>(grid, stream, a); launch_ph<4>(grid, stream, a); launch_ph<5>(grid, stream, a); launch_ph<6>(grid, stream, a);
        launch_ph<7>(grid, stream, a); launch_ph<8>(grid, stream, a); launch_ph<9>(grid, stream, a); launch_ph<10>(grid, stream, a); launch_ph<11>(grid, stream, a); launch_ph<12>(grid, stream, a); }
#else
    a.l_lo = 0; a.l_hi = DEPTH;
    hipLaunchKernelGGL((mk_fwd<0, NPH>), dim3(grid), dim3(NWAVES * 64), LDS_BYTES, stream, a);
#endif
}
```

```cpp
#include <hip/hip_runtime.h>
#include <cstdio>
#include <cstdint>
namespace pg8 {
#define PG8_LAS __attribute__((address_space(3)))
typedef unsigned short bf16_t;
typedef short bf16x8 __attribute__((ext_vector_type(8)));
typedef float f32x4 __attribute__((ext_vector_type(4)));
typedef unsigned u32x4 __attribute__((ext_vector_type(4)));
constexpr int BM = 256, BK = 64, HALF = 128, HTB = HALF * BK * 2  , STAGE_BYTES = 8 * HTB, NXCD = 8, WGM = 8;

__host__ __device__ __forceinline__ int lds_byte(int r, int c) { const int st = (r >> 4) * 2 + (c >> 5), rr = r & 15, cc = c & 31, ob = rr * 64 + cc * 2; return st * 1024 + (ob ^ (((ob >> 9) & 1) << 5)); }
__host__ __device__ __forceinline__ void stage_rc(int b, int& R, int& C) { const int st = b / 1024, sb = b % 1024, swz = sb ^ (((sb >> 9) & 1) << 5); R = (st >> 1) * 16 + swz / 64; C = (st & 1) * 32 + (swz % 64) / 2; }
__host__ __device__ __forceinline__ int perm32(int rho) { const int n = rho >> 4, i = rho & 15; return 8 * (i >> 2) + 4 * n + (i & 3); }

struct Unit { int pm, pn; };
struct Gemm { const bf16_t* A; const bf16_t* Bt; int M, N, K; int lda, ldb; int agrp, astep; };

struct StaticOrder {
    int nM, nN, nwg, G, c;
    __host__ __device__ void init(int M, int N, int G_, int c_) { nM = M / BM; nN = N / BM; nwg = nM * nN; G = G_; c = c_; }
    __host__ __device__ bool next(int i, Unit& u) const {
        const long L = (long)i * G + c; if (L >= nwg) return false;
        int wgid = (int)L; { const int q = nwg / NXCD, r = nwg % NXCD, xcd = wgid % NXCD, off = wgid / NXCD; wgid = (xcd < r ? xcd * (q + 1) : r * (q + 1) + (xcd - r) * q) + off; }
        const int nig = WGM * nN, gid = wgid / nig, fm = gid * WGM, gsz = (nM - fm) < WGM ? (nM - fm) : WGM;
        u.pm = fm + ((wgid % nig) % gsz); u.pn = (wgid % nig) / gsz; return true;
    }
    __device__ __forceinline__ void a_ready(const Unit&) const {}
    __device__ __forceinline__ void done(const Unit&) const {}
};

typedef float cvt_f32x2_t __attribute__((ext_vector_type(2))); typedef __bf16 cvt_bf16x2_t __attribute__((ext_vector_type(2)));
__device__ __forceinline__ unsigned cvt_pk_bf16(float lo, float hi) { cvt_f32x2_t v = {lo, hi}; cvt_bf16x2_t b = __builtin_convertvector(v, cvt_bf16x2_t); return __builtin_bit_cast(unsigned, b); }
typedef float f32x2 __attribute__((ext_vector_type(2)));
__device__ __forceinline__ f32x2 gelu_pk(f32x2 v) {
    const f32x2 av = __builtin_elementwise_abs(v), d = av * 0.2316418882f + 1.0f;
    f32x2 t; t.x = __builtin_amdgcn_rcpf(d.x); t.y = __builtin_amdgcn_rcpf(d.y);
    f32x2 q = t * 0.5307027145f + (-0.7265760135f); q = q * t + 0.7107068705f; q = q * t + (-0.142248368f); q = q * t + 0.127414796f; q = q * t;
    const f32x2 s = (v * v) * (-0.72134752044f);
    f32x2 e; e.x = __builtin_amdgcn_exp2f(s.x); e.y = __builtin_amdgcn_exp2f(s.y);
    const f32x2 m = v * (q * e), r = v - m;
    f32x2 o; o.x = v.x < 0.f ? m.x : r.x; o.y = v.y < 0.f ? m.y : r.y; return o;
}

template <int ACT  > struct EpiBf16 {
    static constexpr bool PERM = true, AFTER_DRAIN = false; static_assert(ACT == 0 || ACT == 1, "EpiBf16: ACT is 0 (none) or 1 (gelu_pk)");
    bf16_t* O; int ldc; const float* bias; int split_cols; size_t split_stride; float scale0;
    __device__ __forceinline__ void operator()(const f32x4 (&acc)[2][2][4][2], const Unit& u, int wr, int wc, int fr, int fq) const {
        const int row0 = u.pm * BM + wr * 64 + fr; int colt = u.pn * BM; bf16_t* base = O;
        float sc = 1.f; if (split_cols) { const int t = colt / split_cols; base += (size_t)t * split_stride; colt -= t * split_cols; if (t == 0) sc = scale0; }
        const int col0 = colt + wc * 32 + 8 * fq, bcol0 = u.pn * BM + wc * 32 + 8 * fq;
        f32x4 bv[2][2];
#pragma unroll
        for (int bj = 0; bj < 2; ++bj)
#pragma unroll
            for (int n = 0; n < 2; ++n) bv[bj][n] = bias ? *(const f32x4*)(bias + bcol0 + bj * HALF + 4 * n) : (f32x4){0.f, 0.f, 0.f, 0.f};
#pragma unroll
        for (int ai = 0; ai < 2; ++ai)
#pragma unroll
            for (int m = 0; m < 4; ++m) { bf16_t* rowp = base + (size_t)(row0 + ai * HALF + m * 16) * ldc + col0;
#pragma unroll
                for (int bj = 0; bj < 2; ++bj) { f32x4 v0 = acc[ai][bj][m][0] + bv[bj][0], v1 = acc[ai][bj][m][1] + bv[bj][1];
                    if (ACT == 1) { f32x2 a = gelu_pk((f32x2){v0[0], v0[1]}), b = gelu_pk((f32x2){v0[2], v0[3]}), c = gelu_pk((f32x2){v1[0], v1[1]}), d = gelu_pk((f32x2){v1[2], v1[3]});
                        v0 = (f32x4){a.x, a.y, b.x, b.y}; v1 = (f32x4){c.x, c.y, d.x, d.y}; }
                    v0 = v0 * sc; v1 = v1 * sc; u32x4 w; w.x = cvt_pk_bf16(v0[0], v0[1]); w.y = cvt_pk_bf16(v0[2], v0[3]); w.z = cvt_pk_bf16(v1[0], v1[1]); w.w = cvt_pk_bf16(v1[2], v1[3]);
                    *(u32x4*)(rowp + bj * HALF) = w; } }
    }
};

template <class Epi, class Sched, bool ALIGN_EPI = false, bool SP2 = false>
__device__ __forceinline__ void gemm_phase(PG8_LAS unsigned char* lds, const Gemm g, const Sched& S, const Epi& E, const int tid) {
    const int wid = __builtin_amdgcn_readfirstlane(tid >> 6), lane = tid & 63, wr = wid >> 2, wc = wid & 3, fr = lane & 15, fq = lane >> 4;
    const int K = g.K, nt = K / BK;
    unsigned voffA[2], voffB[2];
#pragma unroll
    for (int i = 0; i < 2; ++i) { int R, C; stage_rc(tid * 16 + i * 8192, R, C); const int Rb = Epi::PERM ? ((R & ~31) + perm32(R & 31)) : R;
        voffA[i] = (unsigned)(R * g.lda + C) * 2u; voffB[i] = (unsigned)(Rb * g.ldb + C) * 2u; }
    const size_t kstep = (size_t)(BK * 2);
    const size_t hstepA = (size_t)HALF * g.lda * 2, hstepB = (size_t)HALF * g.ldb * 2;
    const size_t tstepA = 2 * hstepA, tstepB = 2 * hstepB;
    const unsigned ldsw = (unsigned)wid * 1024u;
    const int aoff = lds_byte(wr * 64 + fr, fq * 8), boff = lds_byte(wc * 32 + fr, fq * 8);
#define PG8_SA(b, h) (((b) * 2 + (h)) * HTB)
#define PG8_SB(b, h) ((4 + (b) * 2 + (h)) * HTB)
#define PG8_STAGE(bufoff, gbase, voff) do { _Pragma("unroll") for (int _i = 0; _i < 2; ++_i) \
        __builtin_amdgcn_global_load_lds((const unsigned*)((const char*)(gbase) + (voff)[_i]), (PG8_LAS unsigned*)(lds + (bufoff) + ldsw + _i * 8192), 16, 0, 0); } while (0)
#define PG8_LDA(dst, b, h) do { _Pragma("unroll") for (int m = 0; m < 4; ++m) _Pragma("unroll") for (int k = 0; k < 2; ++k) dst[m][k] = *(const PG8_LAS bf16x8*)(lds + PG8_SA(b, h) + aoff + m * 2048 + k * 1024); } while (0)
#define PG8_LDB(dst, b, h) do { _Pragma("unroll") for (int n = 0; n < 2; ++n) _Pragma("unroll") for (int k = 0; k < 2; ++k) dst[n][k] = *(const PG8_LAS bf16x8*)(lds + PG8_SB(b, h) + boff + n * 2048 + k * 1024); } while (0)
#define PG8_MMA(ai, bj, At, Bt) do { __builtin_amdgcn_s_setprio(1); _Pragma("unroll") for (int m = 0; m < 4; ++m) _Pragma("unroll") for (int n = 0; n < 2; ++n) _Pragma("unroll") for (int k = 0; k < 2; ++k) \
        acc[ai][bj][m][n] = __builtin_amdgcn_mfma_f32_16x16x32_bf16(Bt[n][k], At[m][k], acc[ai][bj][m][n], 0, 0, 0); __builtin_amdgcn_s_setprio(0); } while (0)
#define PG8_WAIT_V(n) asm volatile("s_waitcnt vmcnt(" #n ")" ::: "memory")
#define PG8_WAIT_L(n) asm volatile("s_waitcnt lgkmcnt(" #n ")" ::: "memory")
#define PG8_BAR __builtin_amdgcn_s_barrier()
#define PG8_SCHED __builtin_amdgcn_sched_barrier(0)
    Unit cur, nxt; int ui = 0;
    if (!S.next(0, cur)) return;
    f32x4 acc[2][2][4][2];
#pragma unroll
    for (int a = 0; a < 2; ++a)
#pragma unroll
        for (int b = 0; b < 2; ++b)
#pragma unroll
            for (int m = 0; m < 4; ++m)
#pragma unroll
                for (int n = 0; n < 2; ++n) acc[a][b][m][n] = (f32x4){0.f, 0.f, 0.f, 0.f};
    bf16x8 At[4][2], B0[2][2], B1[2][2];
    const char* cA = (const char*)g.A + (size_t)cur.pm * tstepA + (g.agrp ? (size_t)(cur.pn / g.agrp) * g.astep : (size_t)0); const char* cB = (const char*)g.Bt + (size_t)cur.pn * tstepB;
    S.a_ready(cur);
    if constexpr (SP2) {
        PG8_STAGE(PG8_SB(0, 0), cB, voffB); PG8_STAGE(PG8_SB(0, 1), cB + hstepB, voffB); PG8_STAGE(PG8_SA(0, 0), cA, voffA); PG8_STAGE(PG8_SA(0, 1), cA + hstepA, voffA);
        if (wr == 1) PG8_BAR;
        PG8_WAIT_V(2); PG8_BAR;
        PG8_STAGE(PG8_SB(1, 0), cB + kstep, voffB); PG8_STAGE(PG8_SA(1, 0), cA + kstep, voffA); PG8_STAGE(PG8_SB(1, 1), cB + hstepB + kstep, voffB);
        PG8_WAIT_V(6); PG8_BAR;
    } else {
        PG8_STAGE(PG8_SB(0, 0), cB, voffB); PG8_STAGE(PG8_SA(0, 0), cA, voffA); PG8_STAGE(PG8_SB(0, 1), cB + hstepB, voffB); PG8_STAGE(PG8_SA(0, 1), cA + hstepA, voffA);
        if (wr == 1) PG8_BAR;
        PG8_WAIT_V(4); PG8_BAR;
        PG8_STAGE(PG8_SB(1, 0), cB + kstep, voffB); PG8_STAGE(PG8_SA(1, 0), cA + kstep, voffA); PG8_STAGE(PG8_SB(1, 1), cB + hstepB + kstep, voffB);
        PG8_WAIT_V(6); PG8_BAR;
    }
    for (;;) {
        const bool has_next = S.next(ui + 1, nxt);
        const char* nA = has_next ? (const char*)g.A + (size_t)nxt.pm * tstepA + (g.agrp ? (size_t)(nxt.pn / g.agrp) * g.astep : (size_t)0) : cA; const char* nB = has_next ? (const char*)g.Bt + (size_t)nxt.pn * tstepB : cB;
        for (int t = 0; t < nt; t += 2) {
            const bool last = (t == nt - 2);
            const char* a1 = cA + (size_t)(t + 1) * kstep;
            const char* a2 = last ? nA : cA + (size_t)(t + 2) * kstep; const char* b2 = last ? nB : cB + (size_t)(t + 2) * kstep;
            const char* a3 = a2 + kstep; const char* b3 = b2 + kstep;
            if (last && has_next) S.a_ready(nxt);
            if constexpr (SP2) {
            PG8_LDB(B0, 0, 0); PG8_LDB(B1, 0, 1); PG8_SCHED; PG8_LDA(At, 0, 0); PG8_STAGE(PG8_SA(1, 1), a1 + hstepA, voffA);
            PG8_WAIT_V(8); PG8_WAIT_L(0); PG8_BAR; PG8_MMA(0, 0, At, B0); PG8_MMA(0, 1, At, B1); PG8_BAR; PG8_SCHED;
            PG8_LDA(At, 0, 1); PG8_STAGE(PG8_SB(0, 0), b2, voffB); PG8_STAGE(PG8_SB(0, 1), b2 + hstepB, voffB); PG8_STAGE(PG8_SA(0, 0), a2, voffA);
            PG8_WAIT_V(8); PG8_WAIT_L(0); PG8_BAR; PG8_MMA(1, 0, At, B0); PG8_MMA(1, 1, At, B1); PG8_BAR; PG8_SCHED;
            PG8_LDB(B0, 1, 0); PG8_LDB(B1, 1, 1); PG8_SCHED; PG8_LDA(At, 1, 0); PG8_STAGE(PG8_SA(0, 1), a2 + hstepA, voffA);
            PG8_WAIT_V(8); PG8_WAIT_L(0); PG8_BAR; PG8_MMA(0, 0, At, B0); PG8_MMA(0, 1, At, B1); PG8_BAR; PG8_SCHED;
            PG8_LDA(At, 1, 1); PG8_STAGE(PG8_SB(1, 0), b3, voffB); PG8_STAGE(PG8_SB(1, 1), b3 + hstepB, voffB); PG8_STAGE(PG8_SA(1, 0), a3, voffA);
            PG8_WAIT_V(8); PG8_WAIT_L(0); PG8_BAR; PG8_MMA(1, 0, At, B0); PG8_MMA(1, 1, At, B1); PG8_BAR; PG8_SCHED;
            } else {
            PG8_LDB(B0, 0, 0); PG8_SCHED; PG8_LDA(At, 0, 0); PG8_STAGE(PG8_SA(1, 1), a1 + hstepA, voffA);
            PG8_WAIT_L(8); PG8_BAR; PG8_WAIT_L(0); PG8_MMA(0, 0, At, B0); PG8_BAR; PG8_SCHED;
            PG8_LDB(B1, 0, 1); PG8_STAGE(PG8_SB(0, 0), b2, voffB);
            PG8_BAR; PG8_WAIT_L(0); PG8_MMA(0, 1, At, B1); PG8_BAR;
            PG8_LDA(At, 0, 1); PG8_STAGE(PG8_SA(0, 0), a2, voffA);
            PG8_BAR; PG8_WAIT_L(0); PG8_MMA(1, 0, At, B0); PG8_BAR; PG8_SCHED;
            PG8_STAGE(PG8_SB(0, 1), b2 + hstepB, voffB);
            PG8_WAIT_V(6); PG8_BAR; PG8_MMA(1, 1, At, B1); PG8_BAR;
            PG8_LDB(B0, 1, 0); PG8_SCHED; PG8_LDA(At, 1, 0); PG8_STAGE(PG8_SA(0, 1), a2 + hstepA, voffA);
            PG8_WAIT_L(8); PG8_BAR; PG8_WAIT_L(0); PG8_MMA(0, 0, At, B0); PG8_BAR; PG8_SCHED;
            PG8_LDB(B1, 1, 1); PG8_STAGE(PG8_SB(1, 0), b3, voffB);
            PG8_BAR; PG8_WAIT_L(0); PG8_MMA(0, 1, At, B1); PG8_BAR;
            PG8_LDA(At, 1, 1); PG8_STAGE(PG8_SA(1, 0), a3, voffA);
            PG8_BAR; PG8_WAIT_L(0); PG8_MMA(1, 0, At, B0); PG8_BAR; PG8_SCHED;
            PG8_STAGE(PG8_SB(1, 1), b3 + hstepB, voffB);
            PG8_WAIT_V(6); PG8_BAR; PG8_MMA(1, 1, At, B1); PG8_BAR;
            }
        }
        if constexpr (ALIGN_EPI) { if (wr == 0) PG8_BAR; }
        if constexpr (!Epi::AFTER_DRAIN) { E(acc, cur, wr, wc, fr, fq); S.done(cur); }
        if (!has_next) break;
#pragma unroll
        for (int a = 0; a < 2; ++a)
#pragma unroll
            for (int b = 0; b < 2; ++b)
#pragma unroll
                for (int m = 0; m < 4; ++m)
#pragma unroll
                    for (int n = 0; n < 2; ++n) acc[a][b][m][n] = (f32x4){0.f, 0.f, 0.f, 0.f};
        cur = nxt; cA = nA; cB = nB; ++ui;
        if constexpr (ALIGN_EPI) { if (wr == 1) PG8_BAR; }
    }
    PG8_WAIT_V(0);
    if constexpr (!ALIGN_EPI) { if (wr == 0) PG8_BAR; }
    PG8_BAR;
    if constexpr (Epi::AFTER_DRAIN) { E.fused(acc, cur, wr, wc, fr, fq, lds, wid, lane); S.done(cur); }
#undef PG8_SA
#undef PG8_SB
#undef PG8_STAGE
#undef PG8_LDA
#undef PG8_LDB
#undef PG8_MMA
#undef PG8_WAIT_V
#undef PG8_WAIT_L
#undef PG8_BAR
#undef PG8_SCHED
}
}
#define GAS __attribute__((address_space(1)))
#define LAS __attribute__((address_space(3)))
typedef unsigned short bf16;
typedef unsigned v4u __attribute__((ext_vector_type(4)));
typedef float f32x4 __attribute__((ext_vector_type(4)));
typedef short bf16x8 __attribute__((ext_vector_type(8)));
typedef GAS unsigned gu32;
typedef GAS unsigned long long gu64;
#define RLX_AGENT __ATOMIC_RELAXED, __HIP_MEMORY_SCOPE_AGENT
#define LDS_WAIT() asm volatile("s_waitcnt lgkmcnt(0)" ::: "memory")
#define VM_WAIT() asm volatile("s_waitcnt vmcnt(0)" ::: "memory")
__device__ __forceinline__ unsigned long long rt() { return __builtin_amdgcn_s_memrealtime(); }
__device__ __forceinline__ unsigned f2bf(float f) { unsigned u = __builtin_bit_cast(unsigned, f); return (u + 0x7fffu + ((u >> 16) & 1u)) >> 16; }
__device__ __forceinline__ unsigned pk2(float lo, float hi) { return pg8::cvt_pk_bf16(lo, hi); }

#define XB_TMO      128
#define XB_XCNT(j)  (256  + 64 * (j))
#define XB_XSUB(j)  (1280 + 64 * (j))
#define XB_XGEN(j)  (2304 + 64 * (j))
#define XB_TOP      3328
#define XB_TOPGEN   3392
#define XCD_BAR_WORDS 3456
#define XB_SPIN_CAP (1u << 18)

__device__ __forceinline__ unsigned xb_ld(unsigned* p)              { return __hip_atomic_load(p, __ATOMIC_RELAXED, __HIP_MEMORY_SCOPE_AGENT); }
__device__ __forceinline__ unsigned xb_add(unsigned* p, unsigned v) { return __hip_atomic_fetch_add(p, v, __ATOMIC_RELAXED, __HIP_MEMORY_SCOPE_AGENT); }
__device__ __forceinline__ unsigned xb_xcc_id() { return (unsigned)__builtin_amdgcn_s_getreg((3 << 11) | 20) & 0xFu; }
#define XB_SPIN(cond, bar) do { unsigned _sp = 0; while (cond) { __builtin_amdgcn_s_sleep(1); \
    if ((++_sp & 255u) == 0u) { if (xb_ld(&(bar)[XB_TMO])) break; if (_sp > XB_SPIN_CAP) { atomicAdd(&(bar)[XB_TMO], 1u); break; } } } } while (0)

struct XcdBarrier {
    unsigned* bar; unsigned x;
    volatile LAS unsigned* st;
};

__device__ __forceinline__ XcdBarrier xcd_barrier_post(unsigned* bar, volatile LAS unsigned* st) {
    XcdBarrier b; b.bar = bar; b.x = xb_xcc_id(); b.st = st;
    if (threadIdx.x == 0) (void)xb_add(&bar[XB_XCNT(b.x)], 1u);
    return b;
}
__device__ __forceinline__ void xcd_barrier_complete(unsigned* bar, unsigned x, unsigned& nloc, unsigned& nx) {
    const unsigned G = gridDim.x * gridDim.y * gridDim.z;
    unsigned sum, cnt, mine, sp = 0u;
    for (;;) {
        sum = 0u; cnt = 0u; mine = 0u;
#pragma unroll
        for (unsigned j = 0; j < 16; ++j) { const unsigned c = xb_ld(&bar[XB_XCNT(j)]); sum += c; cnt += (c > 0u) ? 1u : 0u; mine = (j == x) ? c : mine; }
        if (sum == G) break;
        __builtin_amdgcn_s_sleep(1);
        if ((++sp & 255u) == 0u) { if (xb_ld(&bar[XB_TMO])) break; if (sp > XB_SPIN_CAP) { atomicAdd(&bar[XB_TMO], 1u); break; } }
    }
    nloc = mine > 0u ? mine : 1u; nx = cnt > 0u ? cnt : 1u;
}

__device__ __forceinline__ void xcd_barrier(const XcdBarrier& b) {
    asm volatile("s_waitcnt vmcnt(0)" ::: "memory");
    __syncthreads();
    if (threadIdx.x == 0) {
        unsigned* bar = b.bar;
        __builtin_amdgcn_s_waitcnt(0);
        unsigned nloc = b.st[0], nx = b.st[1];
        if (nloc == 0u) { xcd_barrier_complete(bar, b.x, nloc, nx); b.st[0] = nloc; b.st[1] = nx; }
        const unsigned old = xb_add(&bar[XB_XSUB(b.x)], 1u);
        const unsigned gen = old / nloc;
        if (old + 1u == (gen + 1u) * nloc) {
            __builtin_amdgcn_fence(__ATOMIC_RELEASE, "agent");
            asm volatile("s_waitcnt vmcnt(0)" ::: "memory");
            const unsigned og = xb_add(&bar[XB_TOP], 1u);
            const unsigned tg = og / nx;
            if (og + 1u == (tg + 1u) * nx) xb_add(&bar[XB_TOPGEN], 1u);
            else XB_SPIN(xb_ld(&bar[XB_TOPGEN]) == tg, bar);
            __builtin_amdgcn_fence(__ATOMIC_ACQUIRE, "agent");
            xb_add(&bar[XB_XGEN(b.x)], 1u);
            asm volatile("s_waitcnt vmcnt(0)" ::: "memory");
        } else {
            XB_SPIN(xb_ld(&bar[XB_XGEN(b.x)]) == gen, bar);
            __builtin_amdgcn_fence(__ATOMIC_ACQUIRE, "agent");
            asm volatile("s_waitcnt vmcnt(0)" ::: "memory");
        }
    }
    __syncthreads();
}

constexpr int T_ = 4096;
constexpr int NB = 4, T = 4096, D = 1024, M = NB * T, NH = 4, HD = 64, BW = 256, FF = 4096, DEPTH = 4;
constexpr int IN_COLS = 7852, PP = 3840, NG = 4096;
constexpr int NWAVES = 8;
#ifndef PROBE_DUP
#define PROBE_DUP -1
#endif
#ifndef PROBE_SUB
#define PROBE_SUB -1
#endif
#define REP(k) for (int rp_ = 0; rp_ < ((PROBE_SUB == (k)) ? 2 : 1); ++rp_)
#ifndef DBG_MERGE
#define DBG_MERGE 0
#endif
#ifndef DBG_ZERO
#define DBG_ZERO 0
#endif
constexpr float C2 = 0.125f * 1.4426950408889634f;
constexpr float LOG2E = 1.4426950408889634f;
constexpr float NEGBIG = -30000.f;
typedef float f32x16 __attribute__((ext_vector_type(16)));
typedef float f32x2 __attribute__((ext_vector_type(2)));
typedef unsigned u32x2 __attribute__((ext_vector_type(2)));
typedef unsigned u32x4 __attribute__((ext_vector_type(4)));
typedef const __attribute__((address_space(4))) f32x2* c4f2;
typedef const __attribute__((address_space(4))) unsigned* c4u;
typedef const __attribute__((address_space(4))) float* c4f;

constexpr size_t MiB = 1u << 20;
constexpr size_t WS_CTL = 0, CTL_ZERO_BYTES = 1 * MiB;
constexpr size_t WS_WIN = 1 * MiB, WS_WG = 9 * MiB, WS_WB = 17 * MiB, WS_WO = 19 * MiB, WS_WUP = 21 * MiB, WS_WDN = 29 * MiB;
constexpr size_t WS_VFIRST = 37 * MiB;
constexpr size_t WS_XN = 53 * MiB, WS_P = 85 * MiB, WS_SMALL = 205 * MiB;
constexpr size_t WS_SC = 53 * MiB, WS_MASK = 183 * MiB, WS_YL = 191 * MiB, WS_PR = 199 * MiB, WS_OL = 207 * MiB, WS_QD = 215 * MiB;
constexpr size_t WS_BQ = 223 * MiB, WS_BK = 231 * MiB, WS_BVT = 239 * MiB, WS_QI = 247 * MiB, WS_KI = 255 * MiB, WS_WI = 256 * MiB, WS_DQ = 257 * MiB, WS_DK = 265 * MiB, WS_DVT = 273 * MiB;
constexpr size_t WS_FL = 281 * MiB, WS_FB = WS_FL + 256 * 1024, WS_RB = WS_FB + 256 * 1024, WS_HF = WS_RB + 256 * 1024;
constexpr size_t WS_RG = 282 * MiB, WS_HREC = 290 * MiB, WS_HGATE = 330 * MiB, WS_RW = 338 * MiB;
constexpr size_t WS_RSEG = 434 * MiB, WS_HSEG = 466 * MiB, WS_END = 490 * MiB;
constexpr size_t WS_Y = 85 * MiB, WS_G = 117 * MiB, WS_Z = 245 * MiB, WS_MIX = 277 * MiB, WS_U = 117 * MiB;
constexpr size_t SC_PB = (size_t)4096 * 2080;
static_assert(WS_SC + 4 * SC_PB * 4 <= WS_MASK, "scores fit");
constexpr int RREC = 1536;
constexpr int HRECB = 640;
constexpr int RSEGB = 32768, RS_PT = 0, RS_LT = 8192, RS_SS = 24576;
constexpr int HSEGB = 24576, HS_LT = 0, HS_SS = 16384;
static_assert(WS_RW + (size_t)16 * T_ * RREC <= WS_RSEG && WS_HSEG + (size_t)1024 * HSEGB <= WS_END + MiB / 4 && WS_HREC + (size_t)16 * T_ * HRECB <= WS_HGATE, "map");
constexpr int CW_BAR = 4096;

__device__ __forceinline__ float bf2f(unsigned short v) { return __uint_as_float((unsigned)v << 16); }
__device__ __forceinline__ float bflo(unsigned w) { return __uint_as_float(w << 16); }
__device__ __forceinline__ float bfhi(unsigned w) { return __uint_as_float(w & 0xffff0000u); }
template <int O> __device__ __forceinline__ float swz_xor(float v) { return __int_as_float(__builtin_amdgcn_ds_swizzle(__float_as_int(v), (O << 10) | 0x1f)); }
__device__ __forceinline__ float half_sum(float v) { auto rr = __builtin_amdgcn_permlane32_swap(__float_as_uint(v), __float_as_uint(v), false, false); return __uint_as_float(rr[0]) + __uint_as_float(rr[1]); }
__device__ __forceinline__ float half_max(float v) { auto rr = __builtin_amdgcn_permlane32_swap(__float_as_uint(v), __float_as_uint(v), false, false); return fmaxf(__uint_as_float(rr[0]), __uint_as_float(rr[1])); }
__device__ __forceinline__ unsigned wave_sum_u32(unsigned v) {
    v += (unsigned)__builtin_amdgcn_update_dpp(0, (int)v, 0xB1, 0xf, 0xf, false);
    v += (unsigned)__builtin_amdgcn_update_dpp(0, (int)v, 0x4E, 0xf, 0xf, false);
    v += (unsigned)__builtin_amdgcn_update_dpp(0, (int)v, 0x124, 0xf, 0xf, false);
    v += (unsigned)__builtin_amdgcn_update_dpp(0, (int)v, 0x128, 0xf, 0xf, false);
    v += (unsigned)__builtin_amdgcn_ds_swizzle((int)v, (16 << 10) | 0x1f);
    auto rr = __builtin_amdgcn_permlane32_swap(v, v, false, false); return rr[0] + rr[1];
}
__device__ __forceinline__ float wave_sum(float v) {
    v += swz_xor<1>(v); v += swz_xor<2>(v); v += swz_xor<4>(v); v += swz_xor<8>(v); v += swz_xor<16>(v);
    return half_sum(v);
}
__device__ __forceinline__ float sigmoidf_(float x) { return __builtin_amdgcn_rcpf(1.f + __builtin_amdgcn_exp2f(-1.4426950408889634f * x)); }
__device__ __forceinline__ int crow(int r, int hi) { return (r & 3) + 8 * (r >> 2) + 4 * hi; }
__device__ __forceinline__ size_t sc_rowoff(int b, int t) { const int k = t >> 6; return (size_t)b * SC_PB + (size_t)64 * ((size_t)32 * k * (k + 1) + (size_t)(t - 64 * k) * (k + 1)); }

namespace pg8 {
struct EpiIn {
    static constexpr bool PERM = true, AFTER_DRAIN = false;
    bf16_t* P; float* SM;
    __device__ __forceinline__ void operator()(const f32x4 (&acc)[2][2][4][2], const Unit& u, int wr, int wc, int fr, int fq) const {
        const int row0 = u.pm * BM + wr * 64 + fr; const int col0 = wc * 32 + 8 * fq;
        if (u.pn == 11) {
#pragma unroll
            for (int ai = 0; ai < 2; ++ai)
#pragma unroll
                for (int m = 0; m < 4; ++m) { float* rowp = SM + (size_t)(row0 + ai * HALF + m * 16) * 256 + col0;
#pragma unroll
                    for (int bj = 0; bj < 2; ++bj) { *(f32x4*)(rowp + bj * HALF) = acc[ai][bj][m][0]; *(f32x4*)(rowp + bj * HALF + 4) = acc[ai][bj][m][1]; } }
        } else {
#pragma unroll
            for (int ai = 0; ai < 2; ++ai)
#pragma unroll
                for (int m = 0; m < 4; ++m) { bf16_t* rowp = P + (size_t)(row0 + ai * HALF + m * 16) * PP + u.pn * BM + col0;
#pragma unroll
                    for (int bj = 0; bj < 2; ++bj) { const f32x4 v0 = acc[ai][bj][m][0], v1 = acc[ai][bj][m][1];
                        u32x4 w; w.x = cvt_pk_bf16(v0[0], v0[1]); w.y = cvt_pk_bf16(v0[2], v0[3]); w.z = cvt_pk_bf16(v1[0], v1[1]); w.w = cvt_pk_bf16(v1[2], v1[3]);
                        *(u32x4*)(rowp + bj * HALF) = w; } }
        }
    }
};
template <int ACT> struct EpiAct {
    static constexpr bool PERM = true, AFTER_DRAIN = false;
    bf16_t* O; int ldc;
    __device__ __forceinline__ float f(float x) const { if (ACT == 0 && DBG_MERGE == 3) return 1.f; if (ACT == 0) return __builtin_amdgcn_rcpf(1.f + __builtin_amdgcn_exp2f(-1.4426950408889634f * x)); const float r = x > 0.f ? x : 0.f; return r * r; }
    __device__ __forceinline__ void operator()(const f32x4 (&acc)[2][2][4][2], const Unit& u, int wr, int wc, int fr, int fq) const {
        const int row0 = u.pm * BM + wr * 64 + fr; const int col0 = u.pn * BM + wc * 32 + 8 * fq;
#pragma unroll
        for (int ai = 0; ai < 2; ++ai)
#pragma unroll
            for (int m = 0; m < 4; ++m) { bf16_t* rowp = O + (size_t)(row0 + ai * HALF + m * 16) * ldc + col0;
#pragma unroll
                for (int bj = 0; bj < 2; ++bj) { const f32x4 v0 = acc[ai][bj][m][0], v1 = acc[ai][bj][m][1];
                    u32x4 w; w.x = cvt_pk_bf16(f(v0[0]), f(v0[1])); w.y = cvt_pk_bf16(f(v0[2]), f(v0[3])); w.z = cvt_pk_bf16(f(v1[0]), f(v1[1])); w.w = cvt_pk_bf16(f(v1[2]), f(v1[3]));
                    *(u32x4*)(rowp + bj * HALF) = w; } }
    }
};
struct EpiMerge {
    static constexpr bool PERM = true, AFTER_DRAIN = false;
    const bf16_t* G; bf16_t* Z;
    __device__ __forceinline__ void operator()(const f32x4 (&acc)[2][2][4][2], const Unit& u, int wr, int wc, int fr, int fq) const {
        const int n = u.pn >> 2, ct = u.pn & 3;
        asm volatile("" : "+v"(fr), "+v"(fq));
        const int row0 = u.pm * BM + wr * 64 + fr; const int col0 = wc * 32 + 8 * fq;
#pragma unroll
        for (int ai = 0; ai < 2; ++ai)
#pragma unroll
            for (int m = 0; m < 4; ++m) { const size_t row = (size_t)(row0 + ai * HALF + m * 16);
                const bf16_t* gp = G + row * NG + u.pn * BM + col0; bf16_t* zp = Z + row * D + ct * BM + col0;
#pragma unroll
                for (int bj = 0; bj < 2; ++bj) { const f32x4 v0 = acc[ai][bj][m][0], v1 = acc[ai][bj][m][1];
                    u32x4 gw = *(const u32x4*)(gp + bj * HALF);
                    if (DBG_MERGE == 1) gw = (u32x4){0x3f803f80u, 0x3f803f80u, 0x3f803f80u, 0x3f803f80u};
                    if (DBG_MERGE == 2 && n > 0) continue;
                    float o[8];
                    o[0] = v0[0] * __uint_as_float(gw.x << 16); o[1] = v0[1] * __uint_as_float(gw.x & 0xffff0000u);
                    o[2] = v0[2] * __uint_as_float(gw.y << 16); o[3] = v0[3] * __uint_as_float(gw.y & 0xffff0000u);
                    o[4] = v1[0] * __uint_as_float(gw.z << 16); o[5] = v1[1] * __uint_as_float(gw.z & 0xffff0000u);
                    o[6] = v1[2] * __uint_as_float(gw.w << 16); o[7] = v1[3] * __uint_as_float(gw.w & 0xffff0000u);
                    if (n > 0) { const u32x4 zw = *(const u32x4*)(zp + bj * HALF);
                        o[0] += __uint_as_float(zw.x << 16); o[1] += __uint_as_float(zw.x & 0xffff0000u); o[2] += __uint_as_float(zw.y << 16); o[3] += __uint_as_float(zw.y & 0xffff0000u);
                        o[4] += __uint_as_float(zw.z << 16); o[5] += __uint_as_float(zw.z & 0xffff0000u); o[6] += __uint_as_float(zw.w << 16); o[7] += __uint_as_float(zw.w & 0xffff0000u); }
                    u32x4 w; w.x = cvt_pk_bf16(o[0], o[1]); w.y = cvt_pk_bf16(o[2], o[3]); w.z = cvt_pk_bf16(o[4], o[5]); w.w = cvt_pk_bf16(o[6], o[7]);
                    *(u32x4*)(zp + bj * HALF) = w; }
                asm volatile("" ::: "memory"); }
    }
};
struct EpiF32 {
    static constexpr bool PERM = false, AFTER_DRAIN = false;
    float* O; int ldc;
    __device__ __forceinline__ void operator()(const f32x4 (&acc)[2][2][4][2], const Unit& u, int wr, int wc, int fr, int fq) const {
        const int row0 = u.pm * BM + wr * 64 + fr; const int col0 = u.pn * BM + wc * 32 + 4 * fq;
#pragma unroll
        for (int ai = 0; ai < 2; ++ai)
#pragma unroll
            for (int m = 0; m < 4; ++m) { float* rowp = O + (size_t)(row0 + ai * HALF + m * 16) * ldc + col0;
#pragma unroll
                for (int bj = 0; bj < 2; ++bj)
#pragma unroll
                    for (int n = 0; n < 2; ++n) *(f32x4*)(rowp + bj * HALF + n * 16) = acc[ai][bj][m][n]; }
    }
};
struct MergeOrder {
    int G, c;
    __host__ __device__ bool next(int i, Unit& u) const { const int ot = c + (i >> 2) * G; if (ot >= 256) return false; u.pm = ot >> 2; u.pn = (i & 3) * 4 + (ot & 3); return true; }
    __device__ __forceinline__ void a_ready(const Unit&) const {}
    __device__ __forceinline__ void done(const Unit&) const {}
};
}

__device__ __forceinline__ int in_src(int c, float& sc) {
    const int t = c >> 8, j = c & 255; sc = 1.f;
    switch (t) {
        case 0: sc = 0.125f; return j;
        case 1: return 256 + j;
        case 2: return 512 + j;
        case 3: return 768 + j;
        case 4: sc = C2; return 1024 + j;
        case 5: return 1280 + j;
        case 6: return 1536 + j;
        case 7: sc = 0.17677669529663687f; return 1792 + j;
        case 8: return 2088 + j;
        case 9: return 2344 + j;
        case 10: return 2600 + j;
        case 11: if (j < 128) return 2856 + j; if (j < 160) return 2048 + (j - 128); if (j < 168) { sc = 0.35355339059327373f; return 2080 + (j - 160); } if (j < 172) return 3752 + (j - 168); return -1;
        case 12: sc = C2; return 2984 + j;
        case 13: return 3240 + j;
        default: return 3496 + j;
    }
}
__device__ __forceinline__ void wt_item(const float* W, int ldw, int kind, int coff, const float* gk, bf16* WT, int K, int kb, int nb, LAS float* scr, int lane) {
    const int k0 = 64 * kb, n0 = 32 * nb;
    const int c = n0 + (lane & 31); float sc = 1.f; const int src = (kind == 1) ? in_src(c, sc) : coff + c;
#pragma unroll 8
    for (int i = 0; i < 32; ++i) { const int kk = 2 * i + (lane >> 5); float v = 0.f; if (src >= 0) v = W[(size_t)(k0 + kk) * ldw + src] * sc; if (gk) v *= gk[k0 + kk]; scr[kk * 33 + (lane & 31)] = v; }
    LDS_WAIT(); asm volatile("" ::: "memory");
    const int cc = lane & 7;
#pragma unroll
    for (int j = 0; j < 4; ++j) { const int n = (lane >> 3) + 8 * j; const LAS float* s = scr + (8 * cc) * 33 + n;
        v4u o; o.x = pk2(s[0 * 33], s[1 * 33]); o.y = pk2(s[2 * 33], s[3 * 33]); o.z = pk2(s[4 * 33], s[5 * 33]); o.w = pk2(s[6 * 33], s[7 * 33]);
        *(GAS v4u*)(WT + (size_t)(n0 + n) * K + k0 + 8 * cc) = o; }
    LDS_WAIT(); asm volatile("" ::: "memory");
}
template <int R>
__device__ __forceinline__ void rms_rows_to_bf16(const float* x0, bf16* o0, size_t rstride, int lane) {
    f32x4 v[R][4]; float s[R];
#pragma unroll
    for (int r = 0; r < R; ++r) { const GAS f32x4* xr = (const GAS f32x4*)(x0 + r * rstride * D) + lane; s[r] = 0.f;
#pragma unroll
        for (int j = 0; j < 4; ++j) v[r][j] = xr[64 * j]; }
#pragma unroll
    for (int r = 0; r < R; ++r)
#pragma unroll
        for (int j = 0; j < 4; ++j) s[r] += (v[r][j].x * v[r][j].x + v[r][j].y * v[r][j].y) + (v[r][j].z * v[r][j].z + v[r][j].w * v[r][j].w);
#pragma unroll
    for (int r = 0; r < R; ++r) s[r] = wave_sum(s[r]);
#pragma unroll
    for (int r = 0; r < R; ++r) { const float rstd = __builtin_amdgcn_rsqf(s[r] * (1.f / D) + 1e-6f);
        GAS unsigned long long* o8 = (GAS unsigned long long*)(o0 + r * rstride * D) + lane;
#pragma unroll
        for (int j = 0; j < 4; ++j) o8[64 * j] = (unsigned long long)pk2(v[r][j].x * rstd, v[r][j].y * rstd) | ((unsigned long long)pk2(v[r][j].z * rstd, v[r][j].w * rstd) << 32); }
}
template <int R>
__device__ __forceinline__ void post_rows(const float* mix0, const float* xold0, const float* g, float* xout0, bf16* xn0, size_t rstride, int lane) {
    f32x4 v[R][4], xo[R][4]; float s[R], s2[R];
    const GAS f32x4* gr = (const GAS f32x4*)g + lane;
#pragma unroll
    for (int r = 0; r < R; ++r) { const GAS f32x4* mr = (const GAS f32x4*)(mix0 + r * rstride * D) + lane; const GAS f32x4* xr = (const GAS f32x4*)(xold0 + r * rstride * D) + lane; s[r] = 0.f; s2[r] = 0.f;
#pragma unroll
        for (int j = 0; j < 4; ++j) { v[r][j] = mr[64 * j]; xo[r][j] = xr[64 * j]; } }
#pragma unroll
    for (int r = 0; r < R; ++r)
#pragma unroll
        for (int j = 0; j < 4; ++j) s[r] += (v[r][j].x * v[r][j].x + v[r][j].y * v[r][j].y) + (v[r][j].z * v[r][j].z + v[r][j].w * v[r][j].w);
#pragma unroll
    for (int r = 0; r < R; ++r) s[r] = wave_sum(s[r]);
#pragma unroll
    for (int r = 0; r < R; ++r) { const float rstd = __builtin_amdgcn_rsqf(s[r] * (1.f / D) + 1e-6f);
        GAS f32x4* orow = (GAS f32x4*)(xout0 + r * rstride * D) + lane;
#pragma unroll
        for (int j = 0; j < 4; ++j) { const f32x4 gg = gr[64 * j]; v[r][j] = xo[r][j] + v[r][j] * rstd * gg; s2[r] += (v[r][j].x * v[r][j].x + v[r][j].y * v[r][j].y) + (v[r][j].z * v[r][j].z + v[r][j].w * v[r][j].w); orow[64 * j] = v[r][j]; } }
    if (xn0) {
#pragma unroll
        for (int r = 0; r < R; ++r) s2[r] = wave_sum(s2[r]);
#pragma unroll
        for (int r = 0; r < R; ++r) { const float rstd2 = __builtin_amdgcn_rsqf(s2[r] * (1.f / D) + 1e-6f);
            GAS unsigned long long* o8 = (GAS unsigned long long*)(xn0 + r * rstride * D) + lane;
#pragma unroll
            for (int j = 0; j < 4; ++j) o8[64 * j] = (unsigned long long)pk2(v[r][j].x * rstd2, v[r][j].y * rstd2) | ((unsigned long long)pk2(v[r][j].z * rstd2, v[r][j].w * rstd2) << 32); }
    }
}

struct Args { const float* in[27]; float* out; unsigned char* ws; int l_lo, l_hi; };

__device__ __forceinline__ void rope_pair(float a, float b, float ang, float& oa, float& ob) {
    float rev = ang * 0.15915494309189535f; rev -= floorf(rev);
    const float sn = __builtin_amdgcn_sinf(rev), cs = __builtin_amdgcn_cosf(rev);
    oa = a * cs - b * sn; ob = b * cs + a * sn;
}
__device__ __forceinline__ void prep_token(const Args& A, unsigned char* ws, int l, int m, int lane) {
    const bf16* prow = (const bf16*)(ws + WS_P) + (size_t)m * PP; const float* srow = (const float*)(ws + WS_SMALL) + (size_t)m * 256;
    const int t = m & (T - 1);
    {
        const u32x2 w = *(const u32x2*)(prow + 256 + 4 * lane);
        const float fl[4] = {bflo(w.x), bfhi(w.x), bflo(w.y), bfhi(w.y)};
        f32x4 e[4]; const float* lbl = A.in[8];
#pragma unroll
        for (int q = 0; q < 4; ++q) e[q] = *(const f32x4*)(lbl + q * 256 + 4 * lane);
        f32x4 o;
#pragma unroll
        for (int i = 0; i < 4; ++i) { const float mx = fmaxf(fmaxf(e[0][i], e[1][i]), fmaxf(e[2][i], e[3][i]));
            float ex[4], sum = 0.f, part = 0.f;
#pragma unroll
            for (int q = 0; q < 4; ++q) { ex[q] = __builtin_amdgcn_exp2f(1.4426950408889634f * (e[q][i] - mx)); sum += ex[q]; }
#pragma unroll
            for (int q = 1; q < 4; ++q) if (q <= l) part += ex[q];
            const float lb = part / sum; o[i] = lb + (1.f - lb) * sigmoidf_(fl[i]); }
        const int hh = lane >> 4, d0 = (4 * lane) & 63; const int b = m >> 12;
        unsigned char* hr = ws + WS_HREC + ((size_t)((b * NH + hh) * T + t)) * HRECB;
        *(f32x4*)(hr + d0 * 4) = o;
        const u32x2 qw = *(const u32x2*)(prow + 4 * lane);
        *(f32x4*)(hr + 256 + d0 * 4) = (f32x4){bflo(qw.x), bfhi(qw.x), bflo(qw.y), bfhi(qw.y)};
        *(u32x2*)(hr + 512 + d0 * 2) = *(const u32x2*)(prow + 512 + 4 * lane);
        const u32x2 gw = *(const u32x2*)(prow + 768 + 4 * lane);
        const float g0 = bflo(gw.x), g1 = bfhi(gw.x), g2 = bflo(gw.y), g3 = bfhi(gw.y);
        *(u32x2*)((bf16*)(ws + WS_HGATE) + (size_t)m * 256 + 4 * lane) = (u32x2){pk2(g0 * sigmoidf_(g0), g1 * sigmoidf_(g1)), pk2(g2 * sigmoidf_(g2), g3 * sigmoidf_(g3))};
        if (lane < 8) ((float*)(ws + WS_WI))[(size_t)m * 8 + lane] = srow[160 + lane];
    }
    {
        const int hh = lane >> 4, j0 = (lane & 15) * 2;
        const float tf = (float)t;
        const float a0 = tf * __builtin_amdgcn_exp2f(-(float)j0 * (13.287712379549449f / 32.f)), a1 = tf * __builtin_amdgcn_exp2f(-(float)(j0 + 1) * (13.287712379549449f / 32.f));
#pragma unroll
        for (int which = 0; which < 2; ++which) {
            const bf16* src = prow + (which ? 1280 : 1024) + hh * 64 + j0;
            bf16* dst = (bf16*)(ws + (which ? WS_BK : WS_BQ)) + (size_t)m * 256 + hh * 64 + j0;
            const unsigned w1 = *(const unsigned*)src, w2 = *(const unsigned*)(src + 32);
            float o1a, o2a, o1b, o2b; rope_pair(bflo(w1), bflo(w2), a0, o1a, o2a); rope_pair(bfhi(w1), bfhi(w2), a1, o1b, o2b);
            *(unsigned*)dst = pk2(o1a, o1b); *(unsigned*)(dst + 32) = pk2(o2a, o2b);
        }
    }
    {
        const int ih = lane >> 3, j0 = (lane & 7) * 2; const float tf = (float)t;
        const float a0 = tf * __builtin_amdgcn_exp2f(-(float)j0 * (13.287712379549449f / 16.f)), a1 = tf * __builtin_amdgcn_exp2f(-(float)(j0 + 1) * (13.287712379549449f / 16.f));
        const bf16* src = prow + 1792 + ih * 32 + j0; bf16* dst = (bf16*)(ws + WS_QI) + (size_t)m * 256 + ih * 32 + j0;
        const unsigned w1 = *(const unsigned*)src, w2 = *(const unsigned*)(src + 16);
        float o1a, o2a, o1b, o2b; rope_pair(bflo(w1), bflo(w2), a0, o1a, o2a); rope_pair(bfhi(w1), bfhi(w2), a1, o1b, o2b);
        *(unsigned*)dst = pk2(o1a, o1b); *(unsigned*)(dst + 16) = pk2(o2a, o2b);
        if (lane < 16) {
            const float ang = tf * __builtin_amdgcn_exp2f(-(float)lane * (13.287712379549449f / 16.f));
            float oa, ob; rope_pair(srow[128 + lane], srow[128 + lane + 16], ang, oa, ob);
            bf16* kd = (bf16*)(ws + WS_KI) + (size_t)m * 32; kd[lane] = (bf16)f2bf(oa); kd[lane + 16] = (bf16)f2bf(ob);
        }
        if (lane < 4) {
            const float x = srow[168 + lane] + A.in[10][l * 4 + lane];
            ((float*)(ws + WS_FL))[(size_t)m * 4 + lane] = fminf(x, 0.f) - 0.6931471805599453f * __builtin_amdgcn_logf(1.f + __builtin_amdgcn_exp2f(-1.4426950408889634f * fabsf(x)));
        }
    }
    {
        *(u32x2*)((bf16*)(ws + WS_DQ) + (size_t)m * 256 + 4 * lane) = *(const u32x2*)(prow + 3072 + 4 * lane);
        *(u32x2*)((bf16*)(ws + WS_DK) + (size_t)m * 256 + 4 * lane) = *(const u32x2*)(prow + 3328 + 4 * lane);
        *(u32x2*)((bf16*)(ws + WS_BVT) + (size_t)m * 256 + 4 * lane) = *(const u32x2*)(prow + 1536 + 4 * lane);
        *(u32x2*)((bf16*)(ws + WS_DVT) + (size_t)m * 256 + 4 * lane) = *(const u32x2*)(prow + 3584 + 4 * lane);
    }
}
__device__ __forceinline__ void prep_vt(unsigned char* ws, int item, LAS unsigned char* scr, int lane) {
    const int which = item >> 10, r = item & 1023, b = r >> 8, tb = (r >> 2) & 63, hh = r & 3;
    const bf16* src = (const bf16*)(ws + WS_P) + (size_t)(b * T + 64 * tb) * PP + (which ? 3584 : 1536) + hh * 64;
    bf16* dst = (bf16*)(ws + (which ? WS_DVT : WS_BVT)) + (size_t)((b * NH + hh) * 64) * T + 64 * tb;
#pragma unroll
    for (int i = 0; i < 8; ++i) { const int rr = 8 * i + (lane >> 3), ch = lane & 7; const v4u v = *(const v4u*)(src + (size_t)rr * PP + ch * 8);
        LAS unsigned* p = (LAS unsigned*)(scr + rr * 132 + ch * 16); p[0] = v.x; p[1] = v.y; p[2] = v.z; p[3] = v.w; }
    LDS_WAIT(); asm volatile("" ::: "memory");
#pragma unroll
    for (int i = 0; i < 8; ++i) { const int d = 8 * i + (lane >> 3), tc = lane & 7; unsigned short e[8];
#pragma unroll
        for (int k = 0; k < 8; ++k) e[k] = *(const LAS unsigned short*)(scr + (tc * 8 + k) * 132 + d * 2);
        v4u o; o.x = e[0] | ((unsigned)e[1] << 16); o.y = e[2] | ((unsigned)e[3] << 16); o.z = e[4] | ((unsigned)e[5] << 16); o.w = e[6] | ((unsigned)e[7] << 16);
        *(v4u*)(dst + (size_t)d * T + tc * 8) = o; }
    LDS_WAIT(); asm volatile("" ::: "memory");
}
__device__ __forceinline__ void prep_rwkv(const Args& A, unsigned char* ws, int l, LAS unsigned char* lds, const int tid, const int bx, const int G) {
    const int c = tid & 255, grp = tid >> 8, lane = tid & 63, hh = c >> 6;
    LAS float* g2s = (LAS float*)lds;
    LAS float* w2s = (LAS float*)(lds + 65536);
    LAS float* a2s = (LAS float*)(lds + 98304);
    LAS f32x4* sm = (LAS f32x4*)(lds + 131072 + 1024) + grp * 544;
    LAS f32x4* tws = sm; LAS f32x4* ains = sm + 32; LAS f32x4* sgs = sm + 64; LAS f32x4* vs = sm + 128; LAS f32x4* vvp = sm + 384; LAS f32x4* vvs = sm + 512;
    const float* mu = A.in[11] + l * 896; const float* w2 = A.in[13] + (size_t)l * 32 * 256; const float* a2 = A.in[15] + (size_t)l * 32 * 256; const float* g2 = A.in[16] + (size_t)l * 64 * 256;
    for (int i = tid; i < 64 * 256; i += 512) g2s[i] = g2[i];
    for (int i = tid; i < 32 * 256; i += 512) { w2s[i] = w2[i]; a2s[i] = a2[i]; }
    float v2c[32], v1p[32];
    const int jq = c & 31, sq = c >> 5;
    if (l > 0) { const float* v1 = A.in[23] + (size_t)(l - 1) * 256 * 32; const float* v2 = A.in[24] + (size_t)(l - 1) * 32 * 256;
#pragma unroll
        for (int j = 0; j < 32; ++j) { v2c[j] = v2[j * 256 + c]; v1p[j] = v1[(32 * sq + j) * 32 + jq]; } }
    else {
#pragma unroll
        for (int j = 0; j < 32; ++j) { v2c[j] = 0.f; v1p[j] = 0.f; } }
    const float mur = mu[c], muk = mu[256 + c], muv = mu[512 + c], mus = (c < 128) ? mu[768 + c] : 0.f;
    const float w0 = A.in[12][l * 256 + c], a0 = A.in[14][l * 256 + c], v0 = (l > 0) ? A.in[22][(l - 1) * 256 + c] : 0.f;
    const float kkc = A.in[17][l * 256 + c], kac = A.in[18][l * 256 + c], rkc = A.in[19][l * 256 + c];
    __syncthreads();
    const bf16* P = (const bf16*)(ws + WS_P); const float* SM = (const float*)(ws + WS_SMALL);
    float* VF = (float*)(ws + WS_VFIRST); float* RW = (float*)(ws + WS_RW); bf16* RG = (bf16*)(ws + WS_RG); float* RB = (float*)(ws + WS_RB);
    for (int it = bx; it < M / 8; it += G) {
        const int m0 = it * 8 + grp * 4, t0 = m0 & (T - 1), b = m0 >> 12;
        const bf16* pr = P + (size_t)m0 * PP + 2048 + c; const float* sr = SM + (size_t)m0 * 256 + c;
        float rr[5], kr[5], vr[5], ss[5], vf[4];
#pragma unroll
        for (int i = 0; i < 5; ++i) { const bool ok = (i > 0) || (t0 > 0); const long off = (long)(i - 1) * PP;
            rr[i] = ok ? bf2f(pr[off]) : 0.f; kr[i] = ok ? bf2f(pr[off + 256]) : 0.f; vr[i] = ok ? bf2f(pr[off + 512]) : 0.f;
            ss[i] = (ok && c < 128) ? sr[(long)(i - 1) * 256] : 0.f; }
        if (l > 0) {
#pragma unroll
            for (int i = 0; i < 4; ++i) vf[i] = VF[(size_t)(m0 + i) * 256 + c]; }
        float r[4], k[4], v[4];
#pragma unroll
        for (int i = 0; i < 4; ++i) { r[i] = rr[i + 1] + (rr[i] - rr[i + 1]) * mur; k[i] = kr[i + 1] + (kr[i] - kr[i + 1]) * muk; v[i] = vr[i + 1] + (vr[i] - vr[i + 1]) * muv; }
        if (c < 128) { f32x4 x;
#pragma unroll
            for (int i = 0; i < 4; ++i) { const float xs = ss[i + 1] + (ss[i] - ss[i + 1]) * mus; x[i] = (c < 32) ? (1.f - 2.f * __builtin_amdgcn_rcpf(1.f + __builtin_amdgcn_exp2f(2.8853900817779268f * xs))) : (c < 64) ? xs : sigmoidf_(xs); }
            if (c < 32) tws[c] = x; else if (c < 64) ains[c - 32] = x; else sgs[c - 64] = x; }
        if (l > 0) vs[c] = (f32x4){v[0], v[1], v[2], v[3]};
        __syncthreads();
        float wl[4], al[4], g[4];
#pragma unroll
        for (int i = 0; i < 4; ++i) { wl[i] = w0; al[i] = a0; g[i] = 0.f; }
#pragma unroll 8
        for (int j = 0; j < 32; ++j) { const float w2v = w2s[j * 256 + c], a2v = a2s[j * 256 + c]; const f32x4 t4 = tws[j], n4 = ains[j];
#pragma unroll
            for (int i = 0; i < 4; ++i) { wl[i] += t4[i] * w2v; al[i] += n4[i] * a2v; } }
#pragma unroll 8
        for (int j = 0; j < 64; ++j) { const float g2v = g2s[j * 256 + c]; const f32x4 s4 = sgs[j];
#pragma unroll
            for (int i = 0; i < 4; ++i) g[i] += s4[i] * g2v; }
        if (l > 0) { float part[4] = {0.f, 0.f, 0.f, 0.f};
#pragma unroll
            for (int j = 0; j < 32; ++j) { const f32x4 v4 = vs[32 * sq + j];
#pragma unroll
                for (int i = 0; i < 4; ++i) part[i] += v4[i] * v1p[j]; }
#pragma unroll
            for (int i = 0; i < 4; ++i) part[i] = half_sum(part[i]);
            if (lane < 32) vvp[hh * 32 + lane] = (f32x4){part[0], part[1], part[2], part[3]}; }
        __syncthreads();
        if (l > 0) {
            if (c < 32) vvs[c] = vvp[c] + vvp[32 + c] + vvp[64 + c] + vvp[96 + c];
            __syncthreads();
            float vg[4] = {v0, v0, v0, v0};
#pragma unroll
            for (int j = 0; j < 32; ++j) { const f32x4 q4 = vvs[j];
#pragma unroll
                for (int i = 0; i < 4; ++i) vg[i] += q4[i] * v2c[j]; }
#pragma unroll
            for (int i = 0; i < 4; ++i) v[i] = v[i] + (vf[i] - v[i]) * sigmoidf_(vg[i]);
        } else {
#pragma unroll
            for (int i = 0; i < 4; ++i) VF[(size_t)(m0 + i) * 256 + c] = v[i]; }
#pragma unroll
        for (int i = 0; i < 4; ++i) {
            const float a = sigmoidf_(al[i]);
            const float decay = __builtin_amdgcn_exp2f(-0.8750387749273232f * sigmoidf_(wl[i]));
            float kk = k[i] * kkc; const float s2 = wave_sum(kk * kk); kk *= rsqrtf(fmaxf(s2, 1e-24f));
            const float k2 = k[i] * (1.f + (a - 1.f) * kac);
            const float bon = wave_sum(r[i] * k2 * rkc);
            float* rec = RW + ((size_t)((b * NH + hh) * T + t0 + i)) * (RREC / 4);
            rec[lane] = decay; rec[64 + lane] = kk; rec[128 + lane] = kk * a; rec[192 + lane] = k2; rec[256 + lane] = r[i]; rec[320 + lane] = v[i];
            RG[(size_t)(m0 + i) * 256 + c] = (bf16)f2bf(g[i]);
            if (lane == 0) RB[(size_t)(m0 + i) * 4 + hh] = bon;
        }
        __syncthreads();
    }
}

__device__ __forceinline__ void rwkv_pass1(unsigned char* ws, LAS unsigned char* buf, int u, int lane) {
    asm volatile("" : "+v"(lane));
    const int bh = u >> 6, seg = u & 63, b = bh >> 2, hh = bh & 3;
    f32x2 SL[32], SI[32];
#pragma unroll
    for (int i = 0; i < 32; ++i) { SL[i] = (f32x2){0.f, 0.f}; SI[i] = (f32x2){(2 * i == lane) ? 1.f : 0.f, (2 * i + 1 == lane) ? 1.f : 0.f}; }
    const unsigned char* rec = ws + WS_RW + ((size_t)(bh * T + seg * 64)) * RREC;
    bf16* ylp = (bf16*)(ws + WS_YL) + ((size_t)(b * T + seg * 64)) * 256 + hh * 64 + lane;
    bf16* prp = (bf16*)(ws + WS_PR) + ((size_t)(b * T + seg * 64)) * 256 + hh * 64 + lane;
#define R1_DMA(sub) do { _Pragma("unroll") for (int c_ = 0; c_ < 6; ++c_) \
        __builtin_amdgcn_global_load_lds((const unsigned*)(rec + (size_t)(sub) * 6144 + c_ * 1024 + lane * 16), (LAS unsigned*)(buf + ((sub) & 1) * 6144 + c_ * 1024), 16, 0, 0); } while (0)
    R1_DMA(0);
#pragma unroll 1
    for (int sub = 0; sub < 16; ++sub) {
        asm volatile("s_waitcnt vmcnt(0)" ::: "memory");
        if (sub + 1 < 16) R1_DMA(sub + 1);
        const LAS unsigned char* cur = buf + (sub & 1) * 6144;
#pragma unroll 1
        for (int tl = 0; tl < 4; ++tl) {
            const LAS f32x4* W4 = (const LAS f32x4*)(cur + tl * RREC);
            const float vv = *(const LAS float*)(cur + tl * RREC + 1280 + lane * 4);
            f32x2 aL = (f32x2){0.f, 0.f}, aI = (f32x2){0.f, 0.f};
#pragma unroll
            for (int i = 0; i < 16; ++i) { const f32x4 kq = W4[16 + i]; const f32x2 k0 = (f32x2){kq.x, kq.y}, k1 = (f32x2){kq.z, kq.w};
                aL += SL[2 * i] * k0; aL += SL[2 * i + 1] * k1; aI += SI[2 * i] * k0; aI += SI[2 * i + 1] * k1;
                if ((i & 3) == 3) __builtin_amdgcn_sched_barrier(0); }
            const float saL = aL.x + aL.y, saI = aI.x + aI.y;
            f32x2 yL = (f32x2){0.f, 0.f}, yI = (f32x2){0.f, 0.f};
#pragma unroll
            for (int i = 0; i < 16; ++i) { const f32x4 w4 = W4[i], b4 = W4[32 + i], k4 = W4[48 + i], r4 = W4[64 + i];
                const f32x2 w0 = (f32x2){w4.x, w4.y}, w1 = (f32x2){w4.z, w4.w}, b0 = (f32x2){b4.x, b4.y}, b1 = (f32x2){b4.z, b4.w};
                const f32x2 kp0 = (f32x2){k4.x, k4.y}, kp1 = (f32x2){k4.z, k4.w}, r0 = (f32x2){r4.x, r4.y}, r1 = (f32x2){r4.z, r4.w};
                f32x2 s0 = SL[2 * i] * w0; s0 -= saL * b0; s0 += vv * kp0; SL[2 * i] = s0; yL += s0 * r0;
                f32x2 s1 = SL[2 * i + 1] * w1; s1 -= saL * b1; s1 += vv * kp1; SL[2 * i + 1] = s1; yL += s1 * r1;
                f32x2 t0 = SI[2 * i] * w0; t0 -= saI * b0; SI[2 * i] = t0; yI += t0 * r0;
                f32x2 t1 = SI[2 * i + 1] * w1; t1 -= saI * b1; SI[2 * i + 1] = t1; yI += t1 * r1;
                if (i & 1) __builtin_amdgcn_sched_barrier(0); }
            const int t = sub * 4 + tl;
            ylp[(size_t)t * 256] = (bf16)f2bf(yL.x + yL.y); prp[(size_t)t * 256] = (bf16)f2bf(yI.x + yI.y);
        }
    }
#undef R1_DMA
    unsigned char* sg = ws + WS_RSEG + (size_t)u * RSEGB;
    bf16* PT = (bf16*)(sg + RS_PT); float* LT = (float*)(sg + RS_LT);
#pragma unroll
    for (int i = 0; i < 32; ++i) { LT[(2 * i) * 64 + lane] = SL[i].x; LT[(2 * i + 1) * 64 + lane] = SL[i].y; PT[(2 * i) * 64 + lane] = (bf16)f2bf(SI[i].x); PT[(2 * i + 1) * 64 + lane] = (bf16)f2bf(SI[i].y); }
}
__device__ __forceinline__ void hgrn_pass1(unsigned char* ws, LAS unsigned char* buf, int u, int lane) {
    const int bh = u >> 6, seg = u & 63, b = bh >> 2, hh = bh & 3;
    f32x2 S[32];
#pragma unroll
    for (int i = 0; i < 32; ++i) S[i] = (f32x2){0.f, 0.f};
    float cf = 1.f;
    const unsigned char* rec = ws + WS_HREC + ((size_t)(bh * T + seg * 64)) * HRECB;
    bf16* olp = (bf16*)(ws + WS_OL) + ((size_t)(b * T + seg * 64)) * 256 + hh * 64 + lane;
    bf16* qdp = (bf16*)(ws + WS_QD) + ((size_t)(b * T + seg * 64)) * 256 + hh * 64 + lane;
#define H1_DMA(sub) do { _Pragma("unroll") for (int c_ = 0; c_ < 5; ++c_) \
        __builtin_amdgcn_global_load_lds((const unsigned*)(rec + (size_t)(sub) * 5120 + c_ * 1024 + lane * 16), (LAS unsigned*)(buf + ((sub) & 1) * 5120 + c_ * 1024), 16, 0, 0); } while (0)
    H1_DMA(0);
#pragma unroll 1
    for (int sub = 0; sub < 8; ++sub) {
        asm volatile("s_waitcnt vmcnt(0)" ::: "memory");
        if (sub + 1 < 8) H1_DMA(sub + 1);
        const LAS unsigned char* cur = buf + (sub & 1) * 5120;
#pragma unroll 1
        for (int tl = 0; tl < 8; ++tl) {
            const LAS unsigned char* rp = cur + tl * HRECB;
            const LAS f32x4* F4 = (const LAS f32x4*)rp; const LAS f32x4* Q4 = (const LAS f32x4*)(rp + 256);
            const float iv = bf2f(*(const LAS unsigned short*)(rp + 512 + lane * 2));
            const float fl = *(const LAS float*)(rp + lane * 4), ql = *(const LAS float*)(rp + 256 + lane * 4);
            cf *= fl;
            const f32x2 iv2 = (f32x2){iv, iv};
            f32x2 o = (f32x2){0.f, 0.f};
#pragma unroll
            for (int i = 0; i < 16; ++i) { const f32x4 f4 = F4[i], q4 = Q4[i];
                f32x2 s0 = S[2 * i] - iv2; s0 = s0 * (f32x2){f4.x, f4.y} + iv2; S[2 * i] = s0; o += s0 * (f32x2){q4.x, q4.y};
                f32x2 s1 = S[2 * i + 1] - iv2; s1 = s1 * (f32x2){f4.z, f4.w} + iv2; S[2 * i + 1] = s1; o += s1 * (f32x2){q4.z, q4.w}; }
            const int t = sub * 8 + tl;
            olp[(size_t)t * 256] = (bf16)f2bf(o.x + o.y); qdp[(size_t)t * 256] = (bf16)f2bf(ql * cf);
        }
    }
#undef H1_DMA
    float* LT = (float*)(ws + WS_HSEG + (size_t)u * HSEGB + HS_LT) + lane * 64;
#pragma unroll
    for (int i = 0; i < 16; ++i) *(f32x4*)(LT + 4 * i) = (f32x4){S[2 * i].x, S[2 * i].y, S[2 * i + 1].x, S[2 * i + 1].y};
    ((float*)(ws + WS_HF))[(size_t)u * 64 + lane] = cf;
}
__device__ __forceinline__ void scan_carry(unsigned char* ws, LAS unsigned char* lds, int bh, const int tid) {
    const int lane = tid & 63, r32 = lane & 31, hi = lane >> 5; const int wid = __builtin_amdgcn_readfirstlane(tid >> 6);
    LAS unsigned char* Sb = lds;
    for (int i = tid; i < 64 * 36; i += 512) ((LAS unsigned*)Sb)[i] = 0u;
    const int ti = (wid >> 1) & 1, tv = wid & 1;
    __syncthreads();
#define CARRY_BAR() do { asm volatile("s_waitcnt lgkmcnt(0)" ::: "memory"); __builtin_amdgcn_s_barrier(); asm volatile("" ::: "memory"); } while (0)
    if (wid < 4) {
        f32x16 cw[3]; bf16x8 aw[3][4];
#define RC_LOAD(slot, g_) do { const unsigned char* sg_ = ws + WS_RSEG + ((size_t)bh * 64 + (g_)) * RSEGB; const float* LT_ = (const float*)(sg_ + RS_LT); const bf16* PT_ = (const bf16*)(sg_ + RS_PT); \
        _Pragma("unroll") for (int r = 0; r < 16; ++r) cw[slot][r] = LT_[(32 * ti + crow(r, hi)) * 64 + 32 * tv + r32]; \
        _Pragma("unroll") for (int ks = 0; ks < 4; ++ks) aw[slot][ks] = *(const bf16x8*)(PT_ + (32 * ti + r32) * 64 + 16 * ks + 8 * hi); } while (0)
#define RC_STEP(slot, g_) do { unsigned char* sg_ = ws + WS_RSEG + ((size_t)bh * 64 + (g_)) * RSEGB; \
        _Pragma("unroll") for (int k = 0; k < 2; ++k) { const int idx = tid * 2 + k, row = idx >> 3, ch = idx & 7; *(v4u*)(sg_ + RS_SS + row * 128 + ch * 16) = *(const LAS v4u*)(Sb + row * 144 + ch * 16); } \
        f32x16 acc = cw[slot]; \
        _Pragma("unroll") for (int ks = 0; ks < 4; ++ks) { const bf16x8 bb = *(const LAS bf16x8*)(Sb + (32 * tv + r32) * 144 + (16 * ks + 8 * hi) * 2); acc = __builtin_amdgcn_mfma_f32_32x32x16_bf16(aw[slot][ks], bb, acc, 0, 0, 0); } \
        if ((g_) + 3 < 64) RC_LOAD(slot, (g_) + 3); \
        CARRY_BAR(); \
        _Pragma("unroll") for (int q = 0; q < 4; ++q) *(LAS u32x2*)(Sb + (32 * tv + r32) * 144 + (32 * ti + 8 * q + 4 * hi) * 2) = (u32x2){pk2(acc[4 * q], acc[4 * q + 1]), pk2(acc[4 * q + 2], acc[4 * q + 3])}; \
        CARRY_BAR(); } while (0)
        RC_LOAD(0, 0); RC_LOAD(1, 1); RC_LOAD(2, 2);
#pragma unroll 1
        for (int g = 0; g < 63; g += 3) { RC_STEP(0, g); RC_STEP(1, g + 1); RC_STEP(2, g + 2); }
        RC_STEP(0, 63);
#undef RC_LOAD
#undef RC_STEP
    } else {
        const int e = tid - 256;
        float hs[16];
#pragma unroll
        for (int i = 0; i < 16; ++i) hs[i] = 0.f;
        f32x4 lw[3][4], fw[3][4];
#define HC_LOAD(slot, g_) do { const size_t u_ = (size_t)bh * 64 + (g_); const float* LT_ = (const float*)(ws + WS_HSEG + u_ * HSEGB + HS_LT) + e * 16; const float* F_ = (const float*)(ws + WS_HF) + u_ * 64 + (e & 3) * 16; \
        _Pragma("unroll") for (int q = 0; q < 4; ++q) { lw[slot][q] = *(const f32x4*)(LT_ + 4 * q); fw[slot][q] = *(const f32x4*)(F_ + 4 * q); } } while (0)
#define HC_STEP(slot, g_) do { unsigned char* sg_ = ws + WS_HSEG + ((size_t)bh * 64 + (g_)) * HSEGB; \
        { u32x4 o0, o1; o0.x = pk2(hs[0], hs[1]); o0.y = pk2(hs[2], hs[3]); o0.z = pk2(hs[4], hs[5]); o0.w = pk2(hs[6], hs[7]); \
          o1.x = pk2(hs[8], hs[9]); o1.y = pk2(hs[10], hs[11]); o1.z = pk2(hs[12], hs[13]); o1.w = pk2(hs[14], hs[15]); \
          *(u32x4*)(sg_ + HS_SS + e * 32) = o0; *(u32x4*)(sg_ + HS_SS + e * 32 + 16) = o1; } \
        _Pragma("unroll") for (int q = 0; q < 4; ++q) _Pragma("unroll") for (int k = 0; k < 4; ++k) hs[4 * q + k] = hs[4 * q + k] * fw[slot][q][k] + lw[slot][q][k]; \
        if ((g_) + 3 < 64) HC_LOAD(slot, (g_) + 3); \
        CARRY_BAR(); CARRY_BAR(); } while (0)
        HC_LOAD(0, 0); HC_LOAD(1, 1); HC_LOAD(2, 2);
#pragma unroll 1
        for (int g = 0; g < 63; g += 3) { HC_STEP(0, g); HC_STEP(1, g + 1); HC_STEP(2, g + 2); }
        HC_STEP(0, 63);
#undef HC_LOAD
#undef HC_STEP
    }
#undef CARRY_BAR
    __syncthreads();
}
template <int MIXER>
__device__ __forceinline__ void scan_fixup(const Args& A, unsigned char* ws, int l, int u, int lane) {
    const int bh = u >> 6, seg = u & 63, b = bh >> 2, hh = bh & 3, r32 = lane & 31, hi = lane >> 5;
    const bf16* SS = (const bf16*)(MIXER == 0 ? ws + WS_RSEG + (size_t)u * RSEGB + RS_SS : ws + WS_HSEG + (size_t)u * HSEGB + HS_SS);
    const size_t row0 = (size_t)b * T + seg * 64;
    const bf16* PRp = (const bf16*)(ws + (MIXER == 0 ? WS_PR : WS_QD)) + row0 * 256 + hh * 64;
    const bf16* LOC = (const bf16*)(ws + (MIXER == 0 ? WS_YL : WS_OL)) + row0 * 256 + hh * 64;
    f32x16 acc[2][2];
#pragma unroll
    for (int a = 0; a < 2; ++a)
#pragma unroll
        for (int c = 0; c < 2; ++c)
#pragma unroll
            for (int r = 0; r < 16; ++r) acc[a][c][r] = 0.f;
#pragma unroll
    for (int ks = 0; ks < 4; ++ks) {
        bf16x8 af[2], bfr[2];
#pragma unroll
        for (int x = 0; x < 2; ++x) { af[x] = *(const bf16x8*)(SS + (32 * x + r32) * 64 + 16 * ks + 8 * hi); bfr[x] = *(const bf16x8*)(PRp + (size_t)(32 * x + r32) * 256 + 16 * ks + 8 * hi); }
#pragma unroll
        for (int tv = 0; tv < 2; ++tv)
#pragma unroll
            for (int tt = 0; tt < 2; ++tt) acc[tv][tt] = __builtin_amdgcn_mfma_f32_32x32x16_bf16(af[tv], bfr[tt], acc[tv][tt], 0, 0, 0);
    }
    bf16* Yp = (bf16*)(ws + WS_Y) + row0 * 1024 + (MIXER == 0 ? 512 : 0) + hh * 64;
#pragma unroll
    for (int tt = 0; tt < 2; ++tt) {
        const int t = 32 * tt + r32;
        float y[2][16]; float sum = 0.f;
#pragma unroll
        for (int tv = 0; tv < 2; ++tv)
#pragma unroll
            for (int q = 0; q < 4; ++q) { const u32x2 w = *(const u32x2*)(LOC + (size_t)t * 256 + 32 * tv + 8 * q + 4 * hi);
                y[tv][4 * q] = acc[tv][tt][4 * q] + bflo(w.x); y[tv][4 * q + 1] = acc[tv][tt][4 * q + 1] + bfhi(w.x); y[tv][4 * q + 2] = acc[tv][tt][4 * q + 2] + bflo(w.y); y[tv][4 * q + 3] = acc[tv][tt][4 * q + 3] + bfhi(w.y); }
        if (MIXER == 0) {
#pragma unroll
            for (int tv = 0; tv < 2; ++tv)
#pragma unroll
                for (int r = 0; r < 16; ++r) sum += y[tv][r];
            const float mean = half_sum(sum) * (1.f / 64.f); float q2 = 0.f;
#pragma unroll
            for (int tv = 0; tv < 2; ++tv)
#pragma unroll
                for (int r = 0; r < 16; ++r) { y[tv][r] -= mean; q2 += y[tv][r] * y[tv][r]; }
            const float rstd = rsqrtf(half_sum(q2) * (1.f / 64.f) + 64e-5f);
            const float bon = ((const float*)(ws + WS_RB))[(row0 + t) * 4 + hh];
            const float* vp = (const float*)(ws + WS_RW + ((size_t)(bh * T + seg * 64 + t)) * RREC + 1280);
            const bf16* gp = (const bf16*)(ws + WS_RG) + (row0 + t) * 256 + hh * 64;
#pragma unroll
            for (int tv = 0; tv < 2; ++tv)
#pragma unroll
                for (int q = 0; q < 4; ++q) { const int v0 = 32 * tv + 8 * q + 4 * hi;
                    const f32x4 lw = *(const f32x4*)(A.in[20] + l * 256 + hh * 64 + v0), lb = *(const f32x4*)(A.in[21] + l * 256 + hh * 64 + v0), v4 = *(const f32x4*)(vp + v0);
                    const u32x2 gw = *(const u32x2*)(gp + v0); const float gg[4] = {bflo(gw.x), bfhi(gw.x), bflo(gw.y), bfhi(gw.y)};
                    float o[4];
#pragma unroll
                    for (int k = 0; k < 4; ++k) { o[k] = (y[tv][4 * q + k] * rstd * lw[k] + lb[k] + bon * v4[k]) * gg[k]; if (DBG_ZERO & 4) o[k] = 0.f; }
                    *(u32x2*)(Yp + (size_t)t * 1024 + v0) = (u32x2){pk2(o[0], o[1]), pk2(o[2], o[3])}; }
        } else {
#pragma unroll
            for (int tv = 0; tv < 2; ++tv)
#pragma unroll
                for (int r = 0; r < 16; ++r) sum += y[tv][r] * y[tv][r];
            const float rstd = rsqrtf(half_sum(sum) * (1.f / 64.f) + 1e-6f);
            const bf16* gp = (const bf16*)(ws + WS_HGATE) + (row0 + t) * 256 + hh * 64;
#pragma unroll
            for (int tv = 0; tv < 2; ++tv)
#pragma unroll
                for (int q = 0; q < 4; ++q) { const int v0 = 32 * tv + 8 * q + 4 * hi;
                    const f32x4 nw = *(const f32x4*)(A.in[9] + l * 64 + v0);
                    const u32x2 gw = *(const u32x2*)(gp + v0); const float gg[4] = {bflo(gw.x), bfhi(gw.x), bflo(gw.y), bfhi(gw.y)};
                    float o[4];
#pragma unroll
                    for (int k = 0; k < 4; ++k) { o[k] = y[tv][4 * q + k] * rstd * nw[k] * gg[k]; if (DBG_ZERO & 1) o[k] = 0.f; }
                    *(u32x2*)(Yp + (size_t)t * 1024 + v0) = (u32x2){pk2(o[0], o[1]), pk2(o[2], o[3])}; }
        }
    }
}
__device__ __forceinline__ void fox_cumsum_wave(unsigned char* ws, int bh, int lane) {
    const int b = bh >> 2, hh = bh & 3;
    const float* fl = (const float*)(ws + WS_FL) + (size_t)(b * T + 64 * lane) * 4 + hh;
    float s = 0.f;
    for (int i = 0; i < 64; ++i) s += fl[i * 4];
    float incl = s;
#pragma unroll
    for (int o = 1; o < 64; o <<= 1) { const float n = __int_as_float(__builtin_amdgcn_ds_bpermute(((lane - o) & 63) << 2, __float_as_int(incl))); if (lane >= o) incl += n; }
    float run = incl - s;
    float* fbp = (float*)(ws + WS_FB) + (size_t)bh * T + 64 * lane;
    for (int i = 0; i < 64; ++i) { run += fl[i * 4]; fbp[i] = -run * LOG2E; }
}

__device__ __forceinline__ void dsa_scores_unit(unsigned char* ws, int v, int lane) {
    const int b = v / 576, r = v - b * 576;
    int g8 = 1;
#pragma unroll
    for (int g = 2; g <= 8; ++g) if (r >= 8 * g * (g - 1)) g8 = g;
    const int rr = r - 8 * g8 * (g8 - 1); const int qg = 16 * (g8 - 1) + rr / g8, kc = rr % g8;
    const int nkvb = 2 * ((qg >> 1) + 1);
    const int q = lane & 31, hi = lane >> 5; const int trow = 32 * qg + q; const size_t grow = (size_t)b * T + trow;
    const bf16* QI = (const bf16*)(ws + WS_QI); const bf16* KI = (const bf16*)(ws + WS_KI); const float* WIp = (const float*)(ws + WS_WI);
    bf16x8 qf[8][2]; float wq[8];
#pragma unroll
    for (int h = 0; h < 8; ++h) { qf[h][0] = *(const bf16x8*)(QI + grow * 256 + h * 32 + hi * 8); qf[h][1] = *(const bf16x8*)(QI + grow * 256 + h * 32 + 16 + hi * 8); wq[h] = WIp[grow * 8 + h]; }
    float* srow = (float*)(ws + WS_SC) + sc_rowoff(b, trow);
    const int kb1 = (kc * 16 + 16 < nkvb) ? kc * 16 + 16 : nkvb;
#pragma unroll 1
    for (int kb = kc * 16; kb < kb1; ++kb) {
        const bf16* kp = KI + ((size_t)b * T + 32 * kb + q) * 32 + hi * 8;
        const bf16x8 k0 = *(const bf16x8*)kp, k1 = *(const bf16x8*)(kp + 16);
        f32x16 acc;
#pragma unroll
        for (int r = 0; r < 16; ++r) acc[r] = 0.f;
#pragma unroll
        for (int h = 0; h < 8; ++h) { f32x16 d;
#pragma unroll
            for (int r = 0; r < 16; ++r) d[r] = 0.f;
            d = __builtin_amdgcn_mfma_f32_32x32x16_bf16(k0, qf[h][0], d, 0, 0, 0);
            d = __builtin_amdgcn_mfma_f32_32x32x16_bf16(k1, qf[h][1], d, 0, 0, 0);
#pragma unroll
            for (int r = 0; r < 16; ++r) acc[r] += wq[h] * fmaxf(d[r], 0.f);
            if (h & 1) __builtin_amdgcn_sched_barrier(0); }
#pragma unroll
        for (int j = 0; j < 4; ++j) *(f32x4*)(srow + 32 * kb + 8 * j + 4 * hi) = (f32x4){acc[4 * j], acc[4 * j + 1], acc[4 * j + 2], acc[4 * j + 3]};
    }
}

__device__ __forceinline__ void dsa_select_row(unsigned char* ws, int row, int lane) {
    const int b = row >> 12, t = row & (T - 1); const int nreg = (t >> 6) + 1;
    const float* src = (const float*)(ws + WS_SC) + sc_rowoff(b, t);
    unsigned key[64];
#pragma unroll
    for (int g = 0; g < 4; ++g) {
        if (16 * g < nreg) {
#pragma unroll
            for (int jj = 0; jj < 16; ++jj) key[16 * g + jj] = __float_as_uint(src[64 * (16 * g + jj) + lane]);
        } else {
#pragma unroll
            for (int jj = 0; jj < 16; ++jj) key[16 * g + jj] = 0u;
        }
    }
#pragma unroll
    for (int j = 0; j < 64; ++j) { const unsigned bits = key[j]; unsigned u = bits ^ ((bits >> 31) ? 0xffffffffu : 0x80000000u); if (64 * j + lane > t) u = 0u; key[j] = u; }
    unsigned thr = 0u; int need = 0, neq = 0;
#define CNT8(G_, OP_, REF_, ACC_) do { unsigned long long m0_, m1_, m2_, m3_, m4_, m5_, m6_, m7_; \
        asm volatile(OP_ " %0, %8, %16\n\t" OP_ " %1, %9, %16\n\t" OP_ " %2, %10, %16\n\t" OP_ " %3, %11, %16\n\t" OP_ " %4, %12, %16\n\t" OP_ " %5, %13, %16\n\t" OP_ " %6, %14, %16\n\t" OP_ " %7, %15, %16" \
            : "=&s"(m0_), "=&s"(m1_), "=&s"(m2_), "=&s"(m3_), "=&s"(m4_), "=&s"(m5_), "=&s"(m6_), "=&s"(m7_) \
            : "v"(key[8 * (G_)]), "v"(key[8 * (G_) + 1]), "v"(key[8 * (G_) + 2]), "v"(key[8 * (G_) + 3]), "v"(key[8 * (G_) + 4]), "v"(key[8 * (G_) + 5]), "v"(key[8 * (G_) + 6]), "v"(key[8 * (G_) + 7]), "s"(REF_)); \
        ACC_ += (__builtin_popcountll(m0_) + __builtin_popcountll(m1_)) + (__builtin_popcountll(m2_) + __builtin_popcountll(m3_)) + (__builtin_popcountll(m4_) + __builtin_popcountll(m5_)) + (__builtin_popcountll(m6_) + __builtin_popcountll(m7_)); } while (0)
    if (t >= 256) {
        bool exact = false;
        REP(43) { thr = 0u; exact = false; for (int bit = 31; bit >= 0; --bit) {
            const unsigned cand = thr | (1u << bit); int cnt = 0;
#pragma unroll
            for (int g = 0; g < 8; ++g) if (8 * g < nreg) CNT8(g, "v_cmp_ge_u32_e64", cand, cnt);
            if (cnt >= 256) { thr = cand; if (cnt == 256) { exact = true; break; } }
        } }
        if (exact) { need = 0; neq = 0; }
        else { int gt = 0, ge = 0;
#pragma unroll
            for (int g = 0; g < 8; ++g) if (8 * g < nreg) { CNT8(g, "v_cmp_gt_u32_e64", thr, gt); CNT8(g, "v_cmp_ge_u32_e64", thr, ge); }
            need = 256 - gt; neq = ge - gt; }
    }
#undef CNT8
    unsigned mylo = 0u, myhi = 0u;
    REP(44) {
    if (t < 256 || neq == need) {
        const unsigned ref = thr > 1u ? thr : 1u;
#pragma unroll
        for (int j = 0; j < 64; ++j) { unsigned long long m_; asm volatile("v_cmp_ge_u32_e64 %0, %1, %2" : "=s"(m_) : "v"(key[j]), "s"(ref));
            const unsigned wl_ = (unsigned)m_, wh_ = (unsigned)(m_ >> 32);
            asm volatile("s_nop 4\n\tv_writelane_b32 %0, %1, %2" : "+v"(mylo) : "s"(wl_), "n"(j)); asm volatile("v_writelane_b32 %0, %1, %2" : "+v"(myhi) : "s"(wh_), "n"(j)); }
    } else {
#pragma unroll
        for (int j = 0; j < 64; ++j) {
            const bool eq = key[j] == thr; const unsigned long long eqm = __ballot(eq);
            const int rank = (int)__builtin_amdgcn_mbcnt_hi((unsigned)(eqm >> 32), __builtin_amdgcn_mbcnt_lo((unsigned)eqm, 0u));
            const bool sel = (key[j] > thr) || (eq && rank < need);
            need -= __popcll(eqm);
            const unsigned long long word = __ballot(sel);
            { const unsigned wl_ = (unsigned)word, wh_ = (unsigned)(word >> 32);
              asm volatile("s_nop 4\n\tv_writelane_b32 %0, %1, %2" : "+v"(mylo) : "s"(wl_), "n"(j)); asm volatile("v_writelane_b32 %0, %1, %2" : "+v"(myhi) : "s"(wh_), "n"(j)); }
            if ((j & 3) == 3) __builtin_amdgcn_sched_barrier(0);
        }
    }
    ((unsigned long long*)(ws + WS_MASK))[((size_t)b * 64 + lane) * T + t] = ((unsigned long long)myhi << 32) | mylo;
    }
}

constexpr int AT_KS = 0, AT_VS = 9216, AT_WSF = 9216 + 8704, AT_BYTES = AT_WSF + 8 * 256;
template <int MODE>
__device__ __forceinline__ void attn_unit(LAS unsigned char* lds, int b, int hh, int qb, const bf16* Q, const bf16* K, const bf16* VT, const float* FBp, const unsigned long long* MT, bf16* Y, int ycol, const int tid) {
    const int lane = tid & 63, r32 = lane & 31, hi = lane >> 5; const int wid = __builtin_amdgcn_readfirstlane(tid >> 6);
    const int q0 = qb * 256, qw0 = q0 + wid * 32; const size_t rowbase = (size_t)b * T;
    bf16x8 qr[4];
#pragma unroll
    for (int d0 = 0; d0 < 4; ++d0) qr[d0] = *(const bf16x8*)(Q + (rowbase + qw0 + r32) * 256 + hh * 64 + d0 * 16 + hi * 8);
    f32x16 o0, o1;
#pragma unroll
    for (int r = 0; r < 16; ++r) { o0[r] = 0.f; o1[r] = 0.f; }
    float m_run = -1e30f, l_run = 0.f;
    const int NT = (q0 + 256) / 64;
    const int lrow = tid >> 3, lch = tid & 7;
    const bf16* kg = K + (rowbase + lrow) * 256 + hh * 64 + lch * 8;
    const bf16* vg = VT + ((size_t)((b * NH + hh) * 64 + lrow)) * T + lch * 8;
    v4u kreg = *(const v4u*)kg, vreg = *(const v4u*)vg;
    LAS unsigned char* Ks = lds + AT_KS; LAS unsigned char* Vs = lds + AT_VS; LAS float* wsf = (LAS float*)(lds + AT_WSF) + wid * 64;
    const float* fbh = FBp + (size_t)(b * NH + hh) * T;
    const int qabs = qw0 + r32;
    for (int t = 0; t < NT; ++t) {
        __syncthreads();
        *(LAS v4u*)(Ks + lrow * 144 + lch * 16) = kreg;
        *(LAS u32x2*)(Vs + lrow * 136 + lch * 16) = (u32x2){vreg.x, vreg.y}; *(LAS u32x2*)(Vs + lrow * 136 + lch * 16 + 8) = (u32x2){vreg.z, vreg.w};
        __syncthreads();
        if (t + 1 < NT) { kreg = *(const v4u*)(kg + (size_t)(t + 1) * 64 * 256); vreg = *(const v4u*)(vg + (t + 1) * 64); }
        if (64 * t <= qw0 + 31) {
            f32x16 p0, p1;
#pragma unroll
            for (int r = 0; r < 16; ++r) { p0[r] = 0.f; p1[r] = 0.f; }
#pragma unroll
            for (int d0 = 0; d0 < 4; ++d0) {
                const bf16x8 kf0 = *(const LAS bf16x8*)(Ks + r32 * 144 + d0 * 32 + hi * 16), kf1 = *(const LAS bf16x8*)(Ks + (r32 + 32) * 144 + d0 * 32 + hi * 16);
                p0 = __builtin_amdgcn_mfma_f32_32x32x16_bf16(kf0, qr[d0], p0, 0, 0, 0);
                p1 = __builtin_amdgcn_mfma_f32_32x32x16_bf16(kf1, qr[d0], p1, 0, 0, 0);
            }
            if (MODE == 0) {
#pragma unroll
                for (int j = 0; j < 4; ++j) { const f32x4 b0 = *(const f32x4*)(fbh + 64 * t + 8 * j + 4 * hi), b1 = *(const f32x4*)(fbh + 64 * t + 32 + 8 * j + 4 * hi);
#pragma unroll
                    for (int e = 0; e < 4; ++e) { p0[4 * j + e] += b0[e]; p1[4 * j + e] += b1[e]; } }
            } else {
                const unsigned long long word = MT[((size_t)b * 64 + t) * T + qabs];
                const unsigned wlo = (unsigned)word, whi = (unsigned)(word >> 32);
#pragma unroll
                for (int r = 0; r < 16; ++r) { const int kv = crow(r, hi); if (!((wlo >> kv) & 1u)) p0[r] = NEGBIG; if (!((whi >> kv) & 1u)) p1[r] = NEGBIG; }
            }
            if (64 * t + 63 > qw0) {
#pragma unroll
                for (int r = 0; r < 16; ++r) { const int kv = 64 * t + crow(r, hi); if (kv > qabs) p0[r] = NEGBIG; if (kv + 32 > qabs) p1[r] = NEGBIG; }
            }
            float mx = p0[0];
#pragma unroll
            for (int r = 1; r < 16; ++r) mx = fmaxf(mx, p0[r]);
#pragma unroll
            for (int r = 0; r < 16; ++r) mx = fmaxf(mx, p1[r]);
            mx = half_max(mx);
            const float m_new = fmaxf(m_run, mx); const float f = __builtin_amdgcn_exp2f(m_run - m_new); m_run = m_new;
            float rs = 0.f;
#pragma unroll
            for (int r = 0; r < 16; ++r) { p0[r] = __builtin_amdgcn_exp2f(p0[r] - m_new); p1[r] = __builtin_amdgcn_exp2f(p1[r] - m_new); rs += p0[r] + p1[r]; }
            l_run = l_run * f + rs;
            if (hi == 0) wsf[r32] = f;
            __builtin_amdgcn_wave_barrier(); LDS_WAIT();
#pragma unroll
            for (int r = 0; r < 16; ++r) { const float fr_ = wsf[crow(r, hi)]; o0[r] *= fr_; o1[r] *= fr_; }
            __builtin_amdgcn_wave_barrier();
            u32x4 pw[4];
            pw[0] = (u32x4){pk2(p0[0], p0[1]), pk2(p0[2], p0[3]), pk2(p0[4], p0[5]), pk2(p0[6], p0[7])};
            pw[1] = (u32x4){pk2(p0[8], p0[9]), pk2(p0[10], p0[11]), pk2(p0[12], p0[13]), pk2(p0[14], p0[15])};
            pw[2] = (u32x4){pk2(p1[0], p1[1]), pk2(p1[2], p1[3]), pk2(p1[4], p1[5]), pk2(p1[6], p1[7])};
            pw[3] = (u32x4){pk2(p1[8], p1[9]), pk2(p1[10], p1[11]), pk2(p1[12], p1[13]), pk2(p1[14], p1[15])};
#pragma unroll
            for (int k = 0; k < 4; ++k) {
                const bf16x8 pa = __builtin_bit_cast(bf16x8, pw[k]);
                { const LAS unsigned char* vp = Vs + r32 * 136 + (16 * k + 4 * hi) * 2; const u32x2 lo = *(const LAS u32x2*)vp, h2 = *(const LAS u32x2*)(vp + 16);
                  const bf16x8 vb = __builtin_bit_cast(bf16x8, (u32x4){lo.x, lo.y, h2.x, h2.y}); o0 = __builtin_amdgcn_mfma_f32_32x32x16_bf16(pa, vb, o0, 0, 0, 0); }
                { const LAS unsigned char* vp = Vs + (r32 + 32) * 136 + (16 * k + 4 * hi) * 2; const u32x2 lo = *(const LAS u32x2*)vp, h2 = *(const LAS u32x2*)(vp + 16);
                  const bf16x8 vb = __builtin_bit_cast(bf16x8, (u32x4){lo.x, lo.y, h2.x, h2.y}); o1 = __builtin_amdgcn_mfma_f32_32x32x16_bf16(pa, vb, o1, 0, 0, 0); }
            }
        }
    }
    const float l_tot = half_sum(l_run);
    __builtin_amdgcn_wave_barrier();
    if (hi == 0) wsf[r32] = 1.f / l_tot;
    __builtin_amdgcn_wave_barrier(); LDS_WAIT();
#pragma unroll
    for (int r = 0; r < 16; ++r) { const int qr_ = crow(r, hi); const float rl = wsf[qr_];
        bf16* yp = Y + (rowbase + qw0 + qr_) * 1024 + ycol + hh * 64 + r32;
        float y0 = o0[r] * rl, y1 = o1[r] * rl; if (DBG_ZERO & (MODE == 0 ? 8 : 2)) { y0 = 0.f; y1 = 0.f; }
        yp[0] = (bf16)f2bf(y0); yp[32] = (bf16)f2bf(y1); }
    __builtin_amdgcn_wave_barrier();
}

namespace attn_body {
using bf16=unsigned short;
using bf16x8=__attribute__((ext_vector_type(8)))short;
using s16x4=__attribute__((ext_vector_type(4)))short;
using f32x16=__attribute__((ext_vector_type(16)))float;
using u32x4=__attribute__((ext_vector_type(4)))unsigned;
typedef float f32x4_t __attribute__((ext_vector_type(4)));
constexpr int SEQ=4096,D=64,DM=256,OPITCH=1024;
constexpr int NW=8,QBLK=32,QB=QBLK*NW,KVBLK=64,NQB=SEQ/QB;
constexpr int ATTN_UNIT_ROWS=QB;
__device__ __forceinline__ int crow(int r,int hi){return (r&3)+8*(r>>2)+4*hi;}
#define SBAR() __builtin_amdgcn_sched_barrier(0)
__device__ __forceinline__ void cmask(f32x16&p0,f32x16&p1,int jb,int qrel,int hi){
  const float NEG=-INFINITY; int kb=64*jb+4*hi;
  #pragma unroll
  for(int r=0;r<16;++r){int kv=kb+(r&3)+8*(r>>2); if(kv>qrel)p0[r]=NEG; if(kv+32>qrel)p1[r]=NEG;}
}

constexpr int NSLOT=3, SLOTB=8192;
constexpr int LDS_K=0, LDS_V=NSLOT*SLOTB, LDS_WS=2*NSLOT*SLOTB, LDS_OST=LDS_WS+NW*64*4, LDS_BYTES=LDS_OST+NW*4096;
constexpr float C2=0.125f*1.4426950408889634f;
__device__ __forceinline__ void glds16(const void*sbase,unsigned voff,unsigned lds_dst){unsigned keep;
  asm volatile("s_mov_b32 %0, m0\n\ts_mov_b32 m0, %3\n\ts_nop 0\n\tglobal_load_lds_dwordx4 %1, %2\n\ts_mov_b32 m0, %0":"=&s"(keep):"v"(voff),"s"(sbase),"s"(lds_dst):"memory");}
__device__ __forceinline__ float max3f(float a,float b,float c){float r;asm("v_max3_f32 %0, %1, %2, %3":"=v"(r):"v"(a),"v"(b),"v"(c));return r;}
__device__ __forceinline__ float max2f(float a,float b){float r;asm("v_max_f32_e32 %0, %1, %2":"=v"(r):"v"(a),"v"(b));return r;}
__device__ __forceinline__ float fadd_s(float a,float b){float r;asm("v_add_f32_e32 %0, %1, %2":"=v"(r):"v"(a),"v"(b));return r;}
__device__ __forceinline__ float fsub_s(float a,float b){float r;asm("v_sub_f32_e32 %0, %1, %2":"=v"(r):"v"(a),"v"(b));return r;}
typedef float f32x2_t __attribute__((ext_vector_type(2))); typedef __bf16 bf16x2_t __attribute__((ext_vector_type(2)));
__device__ __forceinline__ unsigned cvtpk_s(float lo,float hi){f32x2_t v={lo,hi};bf16x2_t b=__builtin_convertvector(v,bf16x2_t);return __builtin_bit_cast(unsigned,b);}
#define WAIT_BAR(N) asm volatile("s_waitcnt vmcnt(" #N ") lgkmcnt(0)\n\ts_barrier":::"memory")

__device__ __forceinline__ void qkt(f32x16&p0,f32x16&p1,const char*Kslot,const bf16x8*qr,int r32,int hi){
  const char*kb=Kslot+hi*1024+r32*16;
  #pragma unroll
  for(int d0=0;d0<4;++d0){
    const bf16x8 b0=*reinterpret_cast<const bf16x8*>(kb+d0*2048);
    const bf16x8 b1=*reinterpret_cast<const bf16x8*>(kb+d0*2048+512);
    {p0=__builtin_amdgcn_mfma_f32_32x32x16_bf16(b0,qr[d0],p0,0,0,0);p1=__builtin_amdgcn_mfma_f32_32x32x16_bf16(b1,qr[d0],p1,0,0,0);}}
}
typedef __attribute__((address_space(3))) const char* lds_cptr;
typedef short v4i16_t __attribute__((ext_vector_type(4)));
__device__ __forceinline__ void kload8(bf16x8*kf,lds_cptr kp){
  kf[0]=*(const __attribute__((address_space(3))) bf16x8*)(kp);      kf[1]=*(const __attribute__((address_space(3))) bf16x8*)(kp+512);
  kf[2]=*(const __attribute__((address_space(3))) bf16x8*)(kp+2048); kf[3]=*(const __attribute__((address_space(3))) bf16x8*)(kp+2560);
  kf[4]=*(const __attribute__((address_space(3))) bf16x8*)(kp+4096); kf[5]=*(const __attribute__((address_space(3))) bf16x8*)(kp+4608);
  kf[6]=*(const __attribute__((address_space(3))) bf16x8*)(kp+6144); kf[7]=*(const __attribute__((address_space(3))) bf16x8*)(kp+6656);
}
__device__ __forceinline__ void kload2(bf16x8*kf,lds_cptr kp,int j){ kf[2*j]=*(const __attribute__((address_space(3))) bf16x8*)(kp+j*2048); kf[2*j+1]=*(const __attribute__((address_space(3))) bf16x8*)(kp+j*2048+512); }
__device__ __forceinline__ s16x4 vtr(lds_cptr p){ return __builtin_bit_cast(s16x4,__builtin_amdgcn_ds_read_tr16_b64_v4i16((__attribute__((address_space(3))) v4i16_t*)p)); }
__device__ __forceinline__ float rowmax(const f32x16&p0,const f32x16&p1){
  float a=max3f(p0[0],p0[1],p1[0]),b=max3f(p0[2],p0[3],p1[1]);a=max3f(a,p1[2],p1[3]);
  #pragma unroll
  for(int r=4;r<16;r+=4){a=max3f(a,p0[r],p0[r+1]);b=max3f(b,p0[r+2],p0[r+3]);a=max3f(a,p1[r],p1[r+1]);b=max3f(b,p1[r+2],p1[r+3]);}
  const float m=max2f(a,b);
  auto rr=__builtin_amdgcn_permlane32_swap(__float_as_uint(m),__float_as_uint(m),false,false);
  return max2f(__uint_as_float(rr[0]),__uint_as_float(rr[1]));
}
__device__ __forceinline__ void pv(f32x16*o,int vb,bf16x8 pa0,bf16x8 pa1,bf16x8 pa2,bf16x8 pa3){
  #pragma unroll
  for(int d0=0;d0<2;++d0){s16x4 lo[4],hi[4];
    #pragma unroll
    for(int ks=0;ks<4;++ks){
      asm volatile("ds_read_b64_tr_b16 %0,%1 offset:%c2":"=&v"(lo[ks]):"v"(vb),"i"(d0*4096+ks*1024):"memory");
      asm volatile("ds_read_b64_tr_b16 %0,%1 offset:%c2":"=&v"(hi[ks]):"v"(vb),"i"(d0*4096+ks*1024+512):"memory");}
    asm volatile("s_waitcnt lgkmcnt(0)":::"memory");SBAR();
    #define PK(k) (bf16x8){lo[k][0],lo[k][1],lo[k][2],lo[k][3],hi[k][0],hi[k][1],hi[k][2],hi[k][3]}
    o[d0]=__builtin_amdgcn_mfma_f32_32x32x16_bf16(pa0,PK(0),o[d0],0,0,0);
    o[d0]=__builtin_amdgcn_mfma_f32_32x32x16_bf16(pa1,PK(1),o[d0],0,0,0);
    o[d0]=__builtin_amdgcn_mfma_f32_32x32x16_bf16(pa2,PK(2),o[d0],0,0,0);
    o[d0]=__builtin_amdgcn_mfma_f32_32x32x16_bf16(pa3,PK(3),o[d0],0,0,0);
    #undef PK
  }
}

#ifndef ATTN_STORE16
#define ATTN_STORE16(p,v) (*(u32x4*)(p)=(v))
#endif
template<int THRL,int MODE> __device__ __forceinline__ void attn_unit(int b,int h,int qb,const bf16*Q,const bf16*__restrict__ K,const bf16*__restrict__ V,bf16*O,const float*FBh,const unsigned long long*MTb,char*shm,const int tid){
  const int lane=tid&63,r32=lane&31,hi=lane>>5; const int wid=__builtin_amdgcn_readfirstlane(tid>>6);
  const long rowbase=(long)b*SEQ; const int q0=qb*QB;
  const bf16*Qw=Q+(rowbase+q0+wid*QBLK)*DM+h*D;
  const bf16*Kh=K+rowbase*DM+h*D,*Vh=V+rowbase*DM+h*D;
  const unsigned lds0=(unsigned)(uintptr_t)shm;
  float*wsf=(float*)(shm+LDS_WS)+wid*64;
  const bf16*ksrc=Kh+wid*8;
  const bf16*vsrc=Vh+(long)(16*(wid&3))*DM+(wid>>2)*32;
  const unsigned koff=(unsigned)(lane*DM)*2u, voff=(unsigned)((lane>>2)*DM+(lane&3)*8)*2u;
  const unsigned kdst=lds0+LDS_K+wid*1024, vdst=lds0+LDS_V+wid*1024;
  #define DMA_K(t,slot) glds16(ksrc+(long)(t)*KVBLK*DM,koff,(unsigned)__builtin_amdgcn_readfirstlane(kdst+(slot)))
  #define DMA_V(t,slot) glds16(vsrc+(long)(t)*KVBLK*DM,voff,(unsigned)__builtin_amdgcn_readfirstlane(vdst+(slot)))
  const int vb0=(int)(lds0+LDS_V)+((lane>>4)&1)*32+(lane&3)*8+(4*hi+((lane&15)>>2))*64;
  const char*Kbase=shm+LDS_K; bf16x8 kf[8];
  const lds_cptr shm3=(lds_cptr)shm; const lds_cptr kp0=shm3+LDS_K+hi*1024+r32*16; const lds_cptr vp0=shm3+LDS_V+((lane>>4)&1)*32+(lane&3)*8+(4*hi+((lane&15)>>2))*64;
  const int NT=(q0+QB)/KVBLK;
  if(MODE==0){ __attribute__((address_space(3))) f32x4_t*fw=(__attribute__((address_space(3))) f32x4_t*)((lds_cptr)shm+LDS_BYTES);
    for(int i=tid;i<(q0+QB)/4;i+=NW*64)fw[i]=((const f32x4_t*)FBh)[i]; asm volatile("s_waitcnt vmcnt(0) lgkmcnt(0)":::"memory"); }
  DMA_K(0,0);DMA_V(0,0);DMA_K(1,SLOTB);
  const lds_cptr qsp=shm3+LDS_OST+wid*4096+lane*16;
  { bf16x8 qr[4];
  #pragma unroll
  for(int d0=0;d0<4;++d0)qr[d0]=*reinterpret_cast<const bf16x8*>(&Qw[(long)r32*DM+d0*16+hi*8]);
  #pragma unroll
  for(int d0=0;d0<4;++d0)*(__attribute__((address_space(3))) bf16x8*)((__attribute__((address_space(3))) char*)qsp+d0*1024)=qr[d0]; }
  bf16x8 qf;
  #define QLD(d) qf=*(const __attribute__((address_space(3))) bf16x8*)(qsp+(d)*1024)
  float mhat=0.f,l_reg=0.f;f32x16 o[2];o[0]=f32x16{};o[1]=f32x16{};
  const __attribute__((address_space(3))) float*fbs=(const __attribute__((address_space(3))) float*)(shm3+LDS_BYTES)+4*hi;
  const unsigned mq_off=(unsigned)(q0+wid*QBLK+r32)*8u;
  unsigned long long mw_next=0ull; if(MODE==1)mw_next=*(const unsigned long long*)((const char*)MTb+mq_off);
  #define BIAS(C0,C1,t) do{ if(MODE==0){ const __attribute__((address_space(3))) float*fp_=fbs+64*(t); \
      _Pragma("unroll") for(int j_=0;j_<4;++j_){ const f32x4_t a_=*(const __attribute__((address_space(3))) f32x4_t*)(fp_+8*j_), b_=*(const __attribute__((address_space(3))) f32x4_t*)(fp_+32+8*j_); \
        _Pragma("unroll") for(int e_=0;e_<4;++e_){C0[4*j_+e_]=a_[e_];C1[4*j_+e_]=b_[e_];} } } \
    else{ const unsigned lo_=(unsigned)mw_next,hi_=(unsigned)(mw_next>>32); \
      _Pragma("unroll") for(int r_=0;r_<16;++r_){ const int kv_=(r_&3)+8*(r_>>2); C0[r_]=((lo_>>kv_)&(1u<<(4*hi)))?0.f:-30000.f; C1[r_]=((hi_>>kv_)&(1u<<(4*hi)))?0.f:-30000.f; } } }while(0)
  #define MASKNEXT(t) do{ if(MODE==1){ mw_next=*(const unsigned long long*)((const char*)(MTb+(long)(t)*SEQ)+mq_off); } }while(0)
  const int qrel=wid*QBLK+r32;
  #define CMASK(P0,P1,t) do{int jb_=(t)-(NT-4); if(jb_>=0)cmask(P0,P1,jb_,qrel,hi);}while(0)
  bool resc=false;
  #define START(P0,P1) do{ const float rm=rowmax(P0,P1); resc=false; \
    { mhat=rm; } \
    _Pragma("unroll") for(int r=0;r<16;++r)P0[r]=__builtin_amdgcn_exp2f(fsub_s(P0[r],mhat)); }while(0)
  #define RESC() do{ if(resc){ asm volatile("s_waitcnt lgkmcnt(0)":::"memory"); \
      _Pragma("unroll") for(int d_=0;d_<2;++d_) _Pragma("unroll") for(int r=0;r<16;++r)o[d_][r]*=wsf[crow(r,hi)]; } }while(0)
  f32x16 pA0,pA1,pB0,pB1;
  int sl_prev=0,sl_cur=0,sl_next=SLOTB;
  #define ROT() do{sl_prev=sl_cur;sl_cur=sl_next;sl_next=(sl_next==(NSLOT-1)*SLOTB)?0:sl_next+SLOTB;}while(0)
  DMA_K(2,2*SLOTB);
  WAIT_BAR(3);
  BIAS(pA0,pA1,0); MASKNEXT(1);
  { bf16x8 qr[4]; _Pragma("unroll") for(int d0=0;d0<4;++d0)qr[d0]=*(const __attribute__((address_space(3))) bf16x8*)(qsp+d0*1024); qkt(pA0,pA1,Kbase,qr,r32,hi); }asm volatile("s_nop 15\n\ts_nop 7":"+v"(pA0),"+v"(pA1));CMASK(pA0,pA1,0);
  START(pA0,pA1);
  _Pragma("unroll") for(int r=0;r<16;++r)pA1[r]=__builtin_amdgcn_exp2f(fsub_s(pA1[r],mhat));
  WAIT_BAR(0);
  DMA_K(3,0);DMA_V(1,SLOTB);
  ROT();
  kload8(kf,kp0+sl_cur);
  WAIT_BAR(2);
  s16x4 vlo[8],vhi[8]; u32x4 pw0,pw1,pw2,pw3;
  #define PKW(P,B) cvtpk_s(P[B],P[B+1])
  #define PAF(k) __builtin_bit_cast(bf16x8,pw##k)
  #define VFR(i) (bf16x8){vlo[i][0],vlo[i][1],vlo[i][2],vlo[i][3],vhi[i][0],vhi[i][1],vhi[i][2],vhi[i][3]}
  #define PIN(x) asm volatile("":"+v"(x))
  #define MX3(a,b,c) __builtin_fmaxf(__builtin_fmaxf((a),(b)),(c))
  #define GAPA(MF,A0,A1,A2,A3,W0,W1,PW) do{ MF; sacc+=A0; sacc+=A1; sacc+=A2; sacc+=A3; PIN(sacc); W0; W1; PIN(PW); SBAR(); }while(0)
  #define EX(v) __builtin_amdgcn_exp2f((v)-mhat)
  #define GAPB(MF,X,B) do{ MF; X[B]=EX(X[B]); X[B+1]=EX(X[B+1]); X[B+2]=EX(X[B+2]); X[B+3]=EX(X[B+3]); PIN(X); SBAR(); }while(0)
  #define VRD(i) do{ vlo[i]=vtr(vp_+(((i)>>2)*4096+((i)&3)*1024)); vhi[i]=vtr(vp_+(((i)>>2)*4096+((i)&3)*1024+512)); }while(0)
  #define KRD(G,j) do{ if(G){ kload2(kf,kp0+sl_next,j); SBAR(); } }while(0)
  #define STEP(C0,C1,P0,P1,t,GK,GV,GL) do{ SBAR(); \
    BIAS(C0,C1,t); if((t)+1<NT)MASKNEXT((t)+1); SBAR(); \
    const lds_cptr vp_=vp0+sl_prev; \
    VRD(0); QLD(0); SBAR(); float sacc=(P0[0]+P0[1]); \
    GAPA(C0=__builtin_amdgcn_mfma_f32_32x32x16_bf16(kf[0],qf,C0,0,0,0), P0[2],P0[3],P0[4],P0[5],     pw0[0]=PKW(P0,0), pw0[1]=PKW(P0,2), pw0); \
    VRD(4); SBAR(); GAPA(C1=__builtin_amdgcn_mfma_f32_32x32x16_bf16(kf[1],qf,C1,0,0,0), P0[6],P0[7],P0[8],P0[9],     pw0[2]=PKW(P0,4), pw0[3]=PKW(P0,6), pw0); \
    VRD(1); QLD(1); SBAR(); GAPA(C0=__builtin_amdgcn_mfma_f32_32x32x16_bf16(kf[2],qf,C0,0,0,0),   P0[10],P0[11],P0[12],P0[13], pw1[0]=PKW(P0,8), pw1[1]=PKW(P0,10), pw1); \
    VRD(5); SBAR(); GAPA(C1=__builtin_amdgcn_mfma_f32_32x32x16_bf16(kf[3],qf,C1,0,0,0),   P0[14],P0[15],P1[0],P1[1],   pw1[2]=PKW(P0,12),pw1[3]=PKW(P0,14), pw1); \
    VRD(2); QLD(2); SBAR(); GAPA(C0=__builtin_amdgcn_mfma_f32_32x32x16_bf16(kf[4],qf,C0,0,0,0),   P1[2],P1[3],P1[4],P1[5],     pw2[0]=PKW(P1,0), pw2[1]=PKW(P1,2), pw2); \
    VRD(6); SBAR(); GAPA(C1=__builtin_amdgcn_mfma_f32_32x32x16_bf16(kf[5],qf,C1,0,0,0),   P1[6],P1[7],P1[8],P1[9],     pw2[2]=PKW(P1,4), pw2[3]=PKW(P1,6), pw2); \
    VRD(3); QLD(3); SBAR(); GAPA(C0=__builtin_amdgcn_mfma_f32_32x32x16_bf16(kf[6],qf,C0,0,0,0),   P1[10],P1[11],P1[12],P1[13], pw3[0]=PKW(P1,8), pw3[1]=PKW(P1,10), pw3); \
    VRD(7); SBAR(); GAPA(C1=__builtin_amdgcn_mfma_f32_32x32x16_bf16(kf[7],qf,C1,0,0,0),   P1[14],P1[15],0.f,0.f,       pw3[2]=PKW(P1,12),pw3[3]=PKW(P1,14), pw3); \
    l_reg+=sacc; \
    if(GK){DMA_K((t)+3,sl_cur);} if(GV){DMA_V((t)+1,sl_next);} \
    CMASK(C0,C1,t); \
    { float a=MX3(C0[0],C0[1],C1[0]),b=MX3(C0[2],C0[3],C1[1]); a=MX3(a,C1[2],C1[3]); \
      _Pragma("unroll") for(int r=4;r<16;r+=4){a=MX3(a,C0[r],C0[r+1]);b=MX3(b,C0[r+2],C0[r+3]);a=MX3(a,C1[r],C1[r+1]);b=MX3(b,C1[r+2],C1[r+3]);} \
      float rm=__builtin_fmaxf(a,b); { auto rr=__builtin_amdgcn_permlane32_swap(__float_as_uint(rm),__float_as_uint(rm),false,false); rm=__builtin_fmaxf(__uint_as_float(rr[0]),__uint_as_float(rr[1])); } \
      resc=false; \
      rm-=mhat; \
      if(__builtin_expect(__any(rm>(float)THRL),0)){ const float dl=__builtin_fmaxf(rm,0.f); mhat+=dl; \
        const float f=__builtin_amdgcn_exp2f(-dl); l_reg*=f; if(hi==0)wsf[r32]=f; resc=true; } } \
    SBAR(); \
    GAPB(o[0]=__builtin_amdgcn_mfma_f32_32x32x16_bf16(PAF(0),VFR(0),o[0],0,0,0), C0,0); \
    GAPB(o[1]=__builtin_amdgcn_mfma_f32_32x32x16_bf16(PAF(0),VFR(4),o[1],0,0,0), C0,4); \
    KRD(GL,0); GAPB(o[0]=__builtin_amdgcn_mfma_f32_32x32x16_bf16(PAF(1),VFR(1),o[0],0,0,0), C0,8); \
    KRD(GL,1); GAPB(o[1]=__builtin_amdgcn_mfma_f32_32x32x16_bf16(PAF(1),VFR(5),o[1],0,0,0), C0,12); \
    KRD(GL,2); GAPB(o[0]=__builtin_amdgcn_mfma_f32_32x32x16_bf16(PAF(2),VFR(2),o[0],0,0,0), C1,0); \
    KRD(GL,3); GAPB(o[1]=__builtin_amdgcn_mfma_f32_32x32x16_bf16(PAF(2),VFR(6),o[1],0,0,0), C1,4); \
    GAPB(o[0]=__builtin_amdgcn_mfma_f32_32x32x16_bf16(PAF(3),VFR(3),o[0],0,0,0), C1,8); \
    GAPB(o[1]=__builtin_amdgcn_mfma_f32_32x32x16_bf16(PAF(3),VFR(7),o[1],0,0,0), C1,12); \
    }while(0)
  int t=1;
  #undef CMASK
  #define CMASK(P0,P1,t) do{}while(0)
  for(;t+5<NT;t+=2){
    STEP(pB0,pB1,pA0,pA1,t,true,true,true);     WAIT_BAR(2); RESC(); ROT();
    STEP(pA0,pA1,pB0,pB1,t+1,true,true,true);   WAIT_BAR(2); RESC(); ROT();
  }
  #undef CMASK
  #define CMASK(P0,P1,t) do{int jb_=(t)-(NT-4); if(jb_>=0)cmask(P0,P1,jb_,qrel,hi);}while(0)
  #define ENDW(tt) do{ if((tt)+3<NT){WAIT_BAR(2);} else if((tt)+2<NT){WAIT_BAR(1);} else {WAIT_BAR(0);} }while(0)
  for(;t+1<NT;t+=2){
    STEP(pB0,pB1,pA0,pA1,t,(t+3<NT),(t+1<NT),(t+1<NT));       ENDW(t);   RESC(); ROT();
    STEP(pA0,pA1,pB0,pB1,t+1,(t+4<NT),(t+2<NT),(t+2<NT));     ENDW(t+1); RESC(); ROT();
  }
  STEP(pB0,pB1,pA0,pA1,NT-1,false,false,false); RESC();
  { float sacc=pB0[0]+pB0[1]; _Pragma("unroll") for(int r=2;r<16;++r)sacc+=pB0[r]; _Pragma("unroll") for(int r=0;r<16;++r)sacc+=pB1[r]; l_reg+=sacc;
    pw0=(u32x4){PKW(pB0,0),PKW(pB0,2),PKW(pB0,4),PKW(pB0,6)};pw1=(u32x4){PKW(pB0,8),PKW(pB0,10),PKW(pB0,12),PKW(pB0,14)};pw2=(u32x4){PKW(pB1,0),PKW(pB1,2),PKW(pB1,4),PKW(pB1,6)};pw3=(u32x4){PKW(pB1,8),PKW(pB1,10),PKW(pB1,12),PKW(pB1,14)};
    SBAR(); pv(o,vb0+sl_cur,PAF(0),PAF(1),PAF(2),PAF(3)); }
  #undef PKW
  #undef PAF
  #undef VFR
  #undef PIN
  #undef MX3
  #undef GAPA
  #undef GAPB
  #undef EX
  #undef VRD
  #undef KRD
  #undef STEP
  #undef ENDW
  {auto rr=__builtin_amdgcn_permlane32_swap(__float_as_uint(l_reg),__float_as_uint(l_reg),false,false);l_reg=__uint_as_float(rr[0])+__uint_as_float(rr[1]);}
  if(hi==0)wsf[32+r32]=l_reg;asm volatile("s_waitcnt lgkmcnt(0)":::"memory");
  float rli[16];
  #pragma unroll
  for(int r=0;r<16;++r)rli[r]=__builtin_amdgcn_rcpf(wsf[32+crow(r,hi)]);
  bf16*Ow=O+(rowbase+q0+wid*QBLK)*OPITCH+h*D;
  { bf16*stg=(bf16*)(shm+LDS_OST)+wid*2048;
    #pragma unroll
    for(int r=0;r<16;++r){const int orow=crow(r,hi);
      #pragma unroll
      for(int d0=0;d0<2;++d0)stg[orow*64+d0*32+r32]=(bf16)(cvtpk_s(o[d0][r]*rli[r],0.f)&0xffffu);}
    asm volatile("s_waitcnt lgkmcnt(0)":::"memory");
    #pragma unroll
    for(int i=0;i<4;++i){const int row=i*8+(lane>>3),ch=lane&7; const u32x4 v=*(const u32x4*)(stg+row*64+ch*8); ATTN_STORE16(Ow+(long)row*OPITCH+ch*8,v);} }
  asm volatile("s_waitcnt lgkmcnt(0)\n\ts_barrier":::"memory");
  #undef DMA_K
  #undef DMA_V
  #undef CMASK
  #undef START
  #undef RESC
  #undef ROT
}
constexpr int ATTN_LDS_BYTES=LDS_BYTES+16384;
#undef SBAR
#undef WAIT_BAR
}

__device__ __forceinline__ void load_args(Args& A) {
#if defined(__HIP_DEVICE_COMPILE__)
    const __attribute__((address_space(4))) unsigned long long* p = (const __attribute__((address_space(4))) unsigned long long*)__builtin_amdgcn_kernarg_segment_ptr();
    asm volatile("" : "+s"(p));
#pragma unroll
    for (int i = 0; i < 27; ++i) A.in[i] = (const float*)(const GAS float*)p[i];
    A.out = (float*)(GAS float*)p[27]; A.ws = (unsigned char*)(GAS unsigned char*)p[28];
    A.l_lo = 0; A.l_hi = 0;
#endif
}
#ifndef MK_MULTI
#define MK_MULTI 0
#endif
constexpr int NPH = 13;
constexpr int LDS_BYTES = 155648;
constexpr int RING_BYTES = 131072, MISC_OFF = RING_BYTES + 320;

template <int PLO, int PHI> __global__ void __launch_bounds__(NWAVES * 64, 2) mk_fwd(Args KA) {
    extern __shared__ __attribute__((aligned(16))) unsigned char lds_raw[];
    LAS unsigned char* lds = (LAS unsigned char*)lds_raw;
    volatile LAS unsigned* MISC = (volatile LAS unsigned*)(lds + MISC_OFF);
    for (int u = threadIdx.x; u < (LDS_BYTES - RING_BYTES) / 4; u += NWAVES * 64) ((LAS unsigned*)(lds + RING_BYTES))[u] = 0u;
    __syncthreads();
    int wave_s = __builtin_amdgcn_readfirstlane((int)(threadIdx.x >> 6)); asm volatile("" : "+s"(wave_s));
#if MK_MULTI
#define GRID_BAR() do { } while (0)
#else
    XcdBarrier bar = xcd_barrier_post((unsigned*)(KA.ws + WS_CTL) + CW_BAR, MISC + 8);
#define GRID_BAR() do { XcdBarrier b_ = bar; asm volatile("" : "+s"(b_.bar), "+s"(b_.x)); xcd_barrier(b_); } while (0)
#endif
#ifdef ONLY_PH
#define IN(k) ((k) == ONLY_PH && PLO <= (k) && (k) < PHI)
#else
#define IN(k) (PLO <= (k) && (k) < PHI)
#endif
#define PHASE_IDS() unsigned ones_ = ~0u; asm volatile("" : "+s"(ones_)); int tid = wave_s * 64 + (int)__builtin_amdgcn_mbcnt_hi(ones_, __builtin_amdgcn_mbcnt_lo(ones_, 0u)), bx = blockIdx.x, G = gridDim.x; asm volatile("" : "+v"(tid), "+s"(bx), "+s"(G)); Args A; load_args(A); unsigned char* ws = A.ws; \
    const int lane = tid & 63, wave = __builtin_amdgcn_readfirstlane(tid >> 6); const int gw = bx * NWAVES + wave, NGW = G * NWAVES; bf16* XN = (bf16*)(ws + WS_XN); (void)lane; (void)gw; (void)NGW; (void)XN
    for (int l = KA.l_lo; l < KA.l_hi; ++l) {
        for (int rep_ = 0; rep_ < ((PROBE_DUP == 0) ? 2 : 1); ++rep_) if (IN(0)) { PHASE_IDS();
            LAS float* scr = (LAS float*)(lds + wave * 16384);
            const float* gpre = A.in[1] + l * D; const float* gmlp = A.in[3] + l * D;
            const float* win = A.in[5] + (size_t)l * D * IN_COLS; const float* wbr = A.in[6] + (size_t)l * 4 * 256 * 1024; const float* wout = A.in[7] + (size_t)l * D * D;
            const float* wup = A.in[25] + (size_t)l * D * FF; const float* wdn = A.in[26] + (size_t)l * FF * D;
            constexpr int I_IN = 16 * 120, I_G = 16 * 128, I_B = 4 * 32, I_O = 16 * 32, I_UP = 16 * 128, I_DN = 64 * 32;
            constexpr int NIT = I_IN + I_G + 4 * I_B + I_O + I_UP + I_DN;
            for (int it = gw; it < NIT; it += NGW) {
                int r = it;
                if (r < I_IN) { wt_item(win, IN_COLS, 1, 0, gpre, (bf16*)(ws + WS_WIN), D, r / 120, r % 120, scr, lane); continue; } r -= I_IN;
                if (r < I_G) { wt_item(win, IN_COLS, 0, 3756, gpre, (bf16*)(ws + WS_WG), D, r / 128, r % 128, scr, lane); continue; } r -= I_G;
                if (r < 4 * I_B) { const int n = r / I_B, q = r % I_B; wt_item(wbr + (size_t)n * 256 * 1024, 1024, 0, 0, nullptr, (bf16*)(ws + WS_WB) + (size_t)n * 1024 * 256, 256, q / 32, q % 32, scr, lane); continue; } r -= 4 * I_B;
                if (r < I_O) { wt_item(wout, D, 0, 0, nullptr, (bf16*)(ws + WS_WO), D, r / 32, r % 32, scr, lane); continue; } r -= I_O;
                if (r < I_UP) { wt_item(wup, FF, 0, 0, gmlp, (bf16*)(ws + WS_WUP), D, r / 128, r % 128, scr, lane); continue; } r -= I_UP;
                wt_item(wdn, D, 0, 0, nullptr, (bf16*)(ws + WS_WDN), FF, r / 32, r % 32, scr, lane);
            }
            if (l == 0) for (int m = gw; m < M; m += 4 * NGW) rms_rows_to_bf16<4>(A.in[0] + (size_t)m * D, XN + (size_t)m * D, (size_t)NGW, lane);
            GRID_BAR();
        }
        for (int rep_ = 0; rep_ < ((PROBE_DUP == 1) ? 2 : 1); ++rep_) if (IN(1)) { PHASE_IDS();
            pg8::Gemm g{XN, (const bf16*)(ws + WS_WIN), M, PP, D, D, D, 0, 0}; pg8::StaticOrder S; S.init(M, PP, G, bx);
            pg8::EpiIn E{(bf16*)(ws + WS_P), (float*)(ws + WS_SMALL)};
            pg8::gemm_phase<pg8::EpiIn, pg8::StaticOrder, true, true>(lds, g, S, E, tid);
            GRID_BAR();
        }
        for (int rep_ = 0; rep_ < ((PROBE_DUP == 2) ? 2 : 1); ++rep_) if (IN(2)) { PHASE_IDS();
            REP(21) for (int m = gw; m < M; m += NGW) prep_token(A, ws, l, m, lane);
            __syncthreads();
            REP(23) prep_rwkv(A, ws, l, lds, tid, bx, G);
            GRID_BAR();
        }
        for (int rep_ = 0; rep_ < ((PROBE_DUP == 3) ? 2 : 1); ++rep_) if (IN(3)) { PHASE_IDS();
            const int w4 = wave & 3;
            if (wave < 4) { REP(31) for (int u = bx * 4 + w4; u < 1024; u += G * 4) rwkv_pass1(ws, lds + w4 * 12288, u, lane); }
            else {
                REP(32) for (int u = bx * 4 + w4; u < 1024; u += G * 4) hgrn_pass1(ws, lds + 49152 + w4 * 10240, u, lane);
                REP(33) for (int u = bx * 4 + w4; u < 2304; u += G * 4) dsa_scores_unit(ws, u, lane);
                if (bx * 4 + w4 < 16) fox_cumsum_wave(ws, bx * 4 + w4, lane);
            }
            GRID_BAR();
        }
        for (int rep_ = 0; rep_ < ((PROBE_DUP == 4) ? 2 : 1); ++rep_) if (IN(4)) { PHASE_IDS();
            if (bx < 16) { REP(41) for (int bh = bx; bh < 16; bh += G) scan_carry(ws, lds, bh, tid); }
            if (G <= 16) { for (int row = gw; row < M; row += NGW) dsa_select_row(ws, row, lane); }
            else if (bx >= 16) { REP(42) for (int row = (bx - 16) * NWAVES + wave; row < M; row += (G - 16) * NWAVES) dsa_select_row(ws, row, lane); }
            GRID_BAR();
        }
        for (int rep_ = 0; rep_ < ((PROBE_DUP == 5) ? 2 : 1); ++rep_) if (IN(5)) { PHASE_IDS();
            REP(51) for (int u = gw; u < 2048; u += NGW) { if (u < 1024) scan_fixup<0>(A, ws, l, u, lane); else scan_fixup<1>(A, ws, l, u - 1024, lane); }
            REP(52) { const float* xs = (l == 0) ? A.in[0] : A.out; for (int m = gw; m < M; m += 4 * NGW) rms_rows_to_bf16<4>(xs + (size_t)m * D, XN + (size_t)m * D, (size_t)NGW, lane); }
            for (int u = bx; u < 256; u += G) {
                const int bh = u >> 4, s = u & 15;
                REP(53) attn_body::attn_unit<8, 0>(bh >> 2, bh & 3, s, (const bf16*)(ws + WS_DQ), (const bf16*)(ws + WS_DK), (const bf16*)(ws + WS_DVT), (bf16*)(ws + WS_Y) + 768, (const float*)(ws + WS_FB) + (size_t)bh * T, nullptr, (char*)lds_raw, tid);
                REP(54) attn_body::attn_unit<8, 1>(bh >> 2, bh & 3, 15 - s, (const bf16*)(ws + WS_BQ), (const bf16*)(ws + WS_BK), (const bf16*)(ws + WS_BVT), (bf16*)(ws + WS_Y) + 256, nullptr, (const unsigned long long*)(ws + WS_MASK) + (size_t)(bh >> 2) * 64 * T, (char*)lds_raw, tid);
            }
            __syncthreads();
            GRID_BAR();
        }
        for (int rep_ = 0; rep_ < ((PROBE_DUP == 6) ? 2 : 1); ++rep_) if (IN(6)) { PHASE_IDS();
            pg8::Gemm g{XN, (const bf16*)(ws + (DBG_MERGE == 4 ? WS_WUP : WS_WG)), M, NG, D, D, D, 0, 0}; pg8::StaticOrder S; S.init(M, NG, G, bx);
            pg8::EpiAct<0> E{(bf16*)(ws + WS_G), NG};
            pg8::gemm_phase<pg8::EpiAct<0>, pg8::StaticOrder, true, true>(lds, g, S, E, tid);
            GRID_BAR();
        }
        for (int rep_ = 0; rep_ < ((PROBE_DUP == 7) ? 2 : 1); ++rep_) if (IN(7)) { PHASE_IDS();
            int kmerge = 256; asm volatile("" : "+s"(kmerge));
            pg8::Gemm g{(const bf16*)(ws + WS_Y), (const bf16*)(ws + WS_WB), M, 4096, kmerge, 1024, 256, 4, 512}; pg8::MergeOrder S{G, bx};
            pg8::EpiMerge E{(const bf16*)(ws + WS_G), (bf16*)(ws + WS_Z)};
            pg8::gemm_phase<pg8::EpiMerge, pg8::MergeOrder, true, true>(lds, g, S, E, tid);
            GRID_BAR();
        }
        for (int rep_ = 0; rep_ < ((PROBE_DUP == 8) ? 2 : 1); ++rep_) if (IN(8)) { PHASE_IDS();
            pg8::Gemm g{(const bf16*)(ws + WS_Z), (const bf16*)(ws + WS_WO), M, D, D, D, D, 0, 0}; pg8::StaticOrder S; S.init(M, D, G, bx);
            pg8::EpiF32 E{(float*)(ws + WS_MIX), D};
            pg8::gemm_phase<pg8::EpiF32, pg8::StaticOrder, true, true>(lds, g, S, E, tid);
            GRID_BAR();
        }
        for (int rep_ = 0; rep_ < ((PROBE_DUP == 9) ? 2 : 1); ++rep_) if (IN(9)) { PHASE_IDS();
            const float* xold = (l == 0) ? A.in[0] : A.out;
            for (int m = gw; m < M; m += 2 * NGW) post_rows<2>((const float*)(ws + WS_MIX) + (size_t)m * D, xold + (size_t)m * D, A.in[2] + l * D, A.out + (size_t)m * D, XN + (size_t)m * D, (size_t)NGW, lane);
            GRID_BAR();
        }
        for (int rep_ = 0; rep_ < ((PROBE_DUP == 10) ? 2 : 1); ++rep_) if (IN(10)) { PHASE_IDS();
            pg8::Gemm g{XN, (const bf16*)(ws + WS_WUP), M, FF, D, D, D, 0, 0}; pg8::StaticOrder S; S.init(M, FF, G, bx);
            pg8::EpiAct<1> E{(bf16*)(ws + WS_U), FF};
            pg8::gemm_phase<pg8::EpiAct<1>, pg8::StaticOrder, true, true>(lds, g, S, E, tid);
            GRID_BAR();
        }
        for (int rep_ = 0; rep_ < ((PROBE_DUP == 11) ? 2 : 1); ++rep_) if (IN(11)) { PHASE_IDS();
            pg8::Gemm g{(const bf16*)(ws + WS_U), (const bf16*)(ws + WS_WDN), M, D, FF, FF, FF, 0, 0}; pg8::StaticOrder S; S.init(M, D, G, bx);
            pg8::EpiF32 E{(float*)(ws + WS_MIX), D};
            pg8::gemm_phase<pg8::EpiF32, pg8::StaticOrder, true, true>(lds, g, S, E, tid);
            GRID_BAR();
        }
        for (int rep_ = 0; rep_ < ((PROBE_DUP == 12) ? 2 : 1); ++rep_) if (IN(12)) { PHASE_IDS();
            for (int m = gw; m < M; m += 2 * NGW) post_rows<2>((const float*)(ws + WS_MIX) + (size_t)m * D, A.out + (size_t)m * D, A.in[4] + l * D, A.out + (size_t)m * D, (l + 1 < DEPTH) ? XN + (size_t)m * D : nullptr, (size_t)NGW, lane);
            GRID_BAR();
        }
    }
#undef IN
}

template <int PH> static void launch_ph(int grid, hipStream_t stream, const Args& a) { hipLaunchKernelGGL((mk_fwd<PH, PH + 1>), dim3(grid), dim3(NWAVES * 64), LDS_BYTES, stream, a); }
template <int PH> static void set_lds_ph() { (void)hipFuncSetAttribute((const void*)mk_fwd<PH, PH + 1>, hipFuncAttributeMaxDynamicSharedMemorySize, LDS_BYTES); }
extern "C" void kernel_launch(void* const* d_in, const int* in_sizes, int n_in, void* d_out, int out_size, void* d_ws, size_t ws_size, hipStream_t stream) {
    static int grid = 0;
    if (grid == 0) {
        if (n_in != 27 || out_size != M * D || ws_size < WS_END) { fprintf(stderr, "kernel_launch: unexpected shapes (n_in %d, out %d, ws %zu < %zu)\n", n_in, out_size, ws_size, (size_t)WS_END); grid = -1; return; }
        int dev = 0, cus = 0, per_cu = 0;
        if (hipGetDevice(&dev) != hipSuccess || hipDeviceGetAttribute(&cus, hipDeviceAttributeMultiprocessorCount, dev) != hipSuccess) { grid = -1; return; }
#if MK_MULTI
        set_lds_ph<0>(); set_lds_ph<1>(); set_lds_ph<2>(); set_lds_ph<3>(); set_lds_ph<4>(); set_lds_ph<5>(); set_lds_ph<6>(); set_lds_ph<7>(); set_lds_ph<8>(); set_lds_ph<9>(); set_lds_ph<10>(); set_lds_ph<11>(); set_lds_ph<12>();
#else
        if (hipFuncSetAttribute((const void*)mk_fwd<0, NPH>, hipFuncAttributeMaxDynamicSharedMemorySize, LDS_BYTES) != hipSuccess) { fprintf(stderr, "kernel_launch: hipFuncSetAttribute failed\n"); grid = -1; return; }
        if (hipOccupancyMaxActiveBlocksPerMultiprocessor(&per_cu, (const void*)mk_fwd<0, NPH>, NWAVES * 64, LDS_BYTES) != hipSuccess || per_cu < 1) fprintf(stderr, "kernel_launch: occupancy query reports %d\n", per_cu);
#endif
        (void)hipGetLastError();
        grid = cus;
    }
    if (grid < 0) return;
    if (hipMemsetAsync((char*)d_ws + WS_CTL, 0, CTL_ZERO_BYTES, stream) != hipSuccess) return;
    Args a{};
    for (int i = 0; i < 27; ++i) a.in[i] = (const float*)d_in[i];
    a.out = (float*)d_out; a.ws = (unsigned char*)d_ws;
#if MK_MULTI
    for (int l = 0; l < DEPTH; ++l) { a.l_lo = l; a.l_hi = l + 1;
        launch_ph<0>(grid, stream, a); launch_ph<1>(grid, stream, a); launch_ph<2>(grid, stream, a); launch_ph<3>(grid, stream, a); launch_ph<4>(grid, stream, a); launch_ph<5>(grid, stream, a); launch_ph<6>(grid, stream, a);
        launch_ph<7>(grid, stream, a); launch_ph<8>(grid, stream, a); launch_ph<9>(grid, stream, a); launch_ph<10>(grid, stream, a); launch_ph<11>(grid, stream, a); launch_ph<12>(grid, stream, a); }
#else
    a.l_lo = 0; a.l_hi = DEPTH;
    hipLaunchKernelGGL((mk_fwd<0, NPH>), dim3(grid), dim3(NWAVES * 64), LDS_BYTES, stream, a);
#endif
}
```
